# Optimizing an MI355X kernel written in HIP

```python
import jax, jax.numpy as jnp
from jax import lax
import numpy as np

D_MODEL = 1024
BATCH = 8
SEQ = 2048
DEPTH = 2

GRID_W = 64
CTX_LEN = 256
N_EVEN = (DEPTH + 1) // 2
N_ODD = DEPTH // 2
NORM_EPS = 1e-6
F32 = jnp.float32

GLA_HEADS = 4
GLA_DK = 64
GLA_DV = 128
GLA_LOWRANK = 16
GLA_TAU = 16.0
GLA_CHUNK = 64

SWA_HEADS = 8
SWA_KV_HEADS = 2
SWA_HEAD_DIM = 64
WINDOW = 128
SWA_BLOCK = 128
ROPE_BASE = 10000.0

PROJ_SPLITS = (GLA_HEADS * GLA_DK, GLA_HEADS * GLA_DK, GLA_HEADS * GLA_DV, GLA_HEADS * GLA_DV,
               2 * GLA_LOWRANK, SWA_HEADS * SWA_HEAD_DIM, SWA_KV_HEADS * SWA_HEAD_DIM, SWA_KV_HEADS * SWA_HEAD_DIM)
PROJ_DIM = 2 * GLA_HEADS * GLA_DK + 2 * GLA_HEADS * GLA_DV + 2 * GLA_LOWRANK + (SWA_HEADS + 2 * SWA_KV_HEADS) * SWA_HEAD_DIM
MIX_DIM = GLA_HEADS * GLA_DV + SWA_HEADS * SWA_HEAD_DIM

RW_HEAD_DIM = 64
RW_HEADS = D_MODEL // RW_HEAD_DIM
RW_DECAY_LORA = 64
RW_AAA_LORA = 64
RW_GATE_LORA = 160
RW_GN_EPS = 64e-5

PEER_HEADS = 8
PEER_NKEYS = 128
PEER_EXPERTS = PEER_NKEYS * PEER_NKEYS
PEER_KEY_DIM = 256
PEER_TOPK = 16
PEER_BLOCK = 128

kernel_name = 'hybrid_gla_swa_rwkv7_peer_dit'


def flip(t):
    return t[:, ::-1]


def ident(t):
    return t


def rms_norm(x, g):
    xf = x.astype(F32)
    y = xf * lax.rsqrt(jnp.mean(xf * xf, axis=-1, keepdims=True) + NORM_EPS)
    return (y * g.astype(F32)).astype(x.dtype)


def modulate(x, g, shift, scale):
    return rms_norm(x, g) * (1 + scale) + shift


def axial_rope_tables(T):
    rows = T // GRID_W
    row = jnp.broadcast_to(jnp.arange(rows, dtype=F32)[:, None], (rows, GRID_W)).reshape(-1)
    col = jnp.broadcast_to(jnp.arange(GRID_W, dtype=F32)[None, :], (rows, GRID_W)).reshape(-1)
    n_freq = SWA_HEAD_DIM // 4
    inv_freq = ROPE_BASE ** (-jnp.arange(n_freq, dtype=F32) / n_freq)
    ang = jnp.stack([row[:, None] * inv_freq, col[:, None] * inv_freq], axis=1)
    return jnp.cos(ang), jnp.sin(ang)


def apply_axial_rope(x, cos, sin):
    B, T, H, dh = x.shape
    xr = x.astype(F32).reshape(B, T, H, 2, 2, dh // 4)
    a, b = xr[..., 0, :], xr[..., 1, :]
    cs, sn = cos[None, :, None], sin[None, :, None]
    out = jnp.stack([a * cs - b * sn, b * cs + a * sn], axis=-2)
    return out.reshape(B, T, H, dh).astype(x.dtype)


def gla_prepare(q, k, v, lr, dec_w2, dec_b):
    B, T = q.shape[:2]
    lr = lr.reshape(B, T, 2, GLA_LOWRANK).astype(F32)
    log_a = jax.nn.log_sigmoid(jnp.einsum('btzr,zre->btze', lr, dec_w2.astype(F32)) + dec_b.astype(F32)) / GLA_TAU
    log_a = log_a.reshape(B, T, 2, GLA_HEADS, GLA_DK)
    q = q.reshape(B, T, GLA_HEADS, GLA_DK) * GLA_DK ** -0.5
    return (q, k.reshape(B, T, GLA_HEADS, GLA_DK), v.reshape(B, T, GLA_HEADS, GLA_DV),
            log_a[:, :, 0], log_a[:, :, 1])


def gla_chunked(q, k, v, log_a, s0, exclusive):
    B, T, H, dk = q.shape
    dv = v.shape[-1]
    n = T // GLA_CHUNK

    def blk(t):
        return t.astype(F32).reshape(B, n, GLA_CHUNK, H, -1).transpose(1, 0, 3, 2, 4)

    q, k, v, la = blk(q), blk(k), blk(v), blk(log_a)
    b = jnp.cumsum(la, axis=3)
    total = b[:, :, :, -1]
    q_in = q * jnp.exp(b)
    k_in = k * jnp.exp(-b)
    k_out = k * jnp.exp(total[:, :, :, None] - b)
    idx = jnp.arange(GLA_CHUNK)
    mask = (idx[:, None] > idx[None, :]) if exclusive else (idx[:, None] >= idx[None, :])
    att = jnp.where(mask, jnp.einsum('nbhid,nbhjd->nbhij', q_in, k_in), 0.0)
    o_intra = jnp.einsum('nbhij,nbhjv->nbhiv', att, v)
    d_state = jnp.einsum('nbhjd,nbhjv->nbhdv', k_out, v)

    def step(S, inp):
        dS, dec = inp
        return S * dec[..., None] + dS, S

    s_fin, s_prev = lax.scan(step, s0.astype(F32), (d_state, jnp.exp(total)))
    o = o_intra + jnp.einsum('nbhid,nbhdv->nbhiv', q_in, s_prev)
    return o.transpose(1, 0, 3, 2, 4).reshape(B, T, H, dv), s_fin


def gla_final_state(k, v, log_a):
    b = jnp.cumsum(log_a.astype(F32), axis=1)
    k_out = k.astype(F32) * jnp.exp(b[:, -1:] - b)
    return jnp.einsum('bthd,bthv->bhdv', k_out, v.astype(F32))


def gla_bidirectional(lat, ctx, ctx_out):
    ql, kl, vl, lfl, lbl = lat
    qc, kc, vc, lfc, lbc = ctx
    zeros = jnp.zeros((ql.shape[0], GLA_HEADS, GLA_DK, GLA_DV), F32)
    if ctx_out:
        oc_f, sc_f = gla_chunked(qc, kc, vc, lfc, zeros, False)
        oc_b, sc_b = gla_chunked(flip(qc), flip(kc), flip(vc), flip(lbc), zeros, True)
        o_ctx = oc_f + flip(oc_b)
    else:
        sc_f = gla_final_state(kc, vc, lfc)
        sc_b = gla_final_state(flip(kc), flip(vc), flip(lbc))
        o_ctx = None
    ol_f, _ = gla_chunked(ql, kl, vl, lfl, sc_f, False)
    ol_b, _ = gla_chunked(flip(ql), flip(kl), flip(vl), flip(lbl), sc_b, True)
    return ol_f + flip(ol_b), o_ctx


def gla_output(o, gate, g):
    B, T = o.shape[:2]
    on = o * lax.rsqrt(jnp.mean(o * o, axis=-1, keepdims=True) + NORM_EPS)
    return (on.reshape(B, T, -1) * g.astype(F32) * jax.nn.silu(gate.astype(F32))).astype(gate.dtype)


def swa_latent(q, k, v, kc, vc, sink):
    B, T, Hq, dh = q.shape
    G = k.shape[2]
    R = Hq // G
    W = SWA_BLOCK
    n = T // W
    L = kc.shape[1]
    scale = dh ** -0.5
    qb = q.reshape(B, n, W, G, R, dh)

    def band(t):
        tp = jnp.pad(t, ((0, 0), (W, W), (0, 0), (0, 0))).reshape(B, n + 2, W, G, dh)
        return jnp.concatenate([tp[:, :-2], tp[:, 1:-1], tp[:, 2:]], axis=2)

    kb, vb = band(k), band(v)
    s_loc = jnp.einsum('bnigrd,bnjgd->bngrij', qb, kb).astype(F32) * scale
    qpos = jnp.arange(n)[:, None, None] * W + jnp.arange(W)[None, :, None]
    kpos = (jnp.arange(n)[:, None, None] - 1) * W + jnp.arange(3 * W)[None, None, :]
    valid = (jnp.abs(qpos - kpos) <= WINDOW) & (kpos >= 0) & (kpos < T)
    s_loc = jnp.where(valid[None, :, None, None], s_loc, -jnp.inf)
    s_ctx = jnp.einsum('bnigrd,bjgd->bngrij', qb, kc).astype(F32) * scale
    s_sink = jnp.broadcast_to(sink.astype(F32).reshape(G, R)[None, None, :, :, None, None], (B, n, G, R, W, 1))
    p = jax.nn.softmax(jnp.concatenate([s_loc, s_ctx, s_sink], axis=-1), axis=-1)
    o = (jnp.einsum('bngrij,bnjgd->bnigrd', p[..., :3 * W].astype(v.dtype), vb)
         + jnp.einsum('bngrij,bjgd->bnigrd', p[..., 3 * W:3 * W + L].astype(v.dtype), vc))
    return o.reshape(B, T, Hq * dh)


def ctx_attention(qc, kc, vc, sink):
    B, L, Hq, dh = qc.shape
    G = kc.shape[2]
    R = Hq // G
    s = jnp.einsum('bigrd,bjgd->bgrij', qc.reshape(B, L, G, R, dh), kc).astype(F32) * dh ** -0.5
    s_sink = jnp.broadcast_to(sink.astype(F32).reshape(G, R)[None, :, :, None, None], (B, G, R, L, 1))
    p = jax.nn.softmax(jnp.concatenate([s, s_sink], axis=-1), axis=-1)
    o = jnp.einsum('bgrij,bjgd->bigrd', p[..., :L].astype(vc.dtype), vc)
    return o.reshape(B, L, Hq * dh)


def even_mixer(u_lat, u_ctx, w_in, dec_w2, dec_b, gla_g, sink, w_out, cos, sin, ctx_out):
    B, T, _ = u_lat.shape
    L = u_ctx.shape[1]
    cuts = np.cumsum(PROJ_SPLITS)[:-1].tolist()
    gq, gk, gv, gg, glr, sq, sk, sv = jnp.split(u_lat @ w_in, cuts, axis=-1)
    cq, ck, cv, cg, clr, csq, csk, csv = jnp.split(u_ctx @ w_in, cuts, axis=-1)
    o_lat, o_ctx = gla_bidirectional(gla_prepare(gq, gk, gv, glr, dec_w2, dec_b),
                                     gla_prepare(cq, ck, cv, clr, dec_w2, dec_b), ctx_out)
    q = apply_axial_rope(sq.reshape(B, T, SWA_HEADS, SWA_HEAD_DIM), cos, sin)
    k = apply_axial_rope(sk.reshape(B, T, SWA_KV_HEADS, SWA_HEAD_DIM), cos, sin)
    v = sv.reshape(B, T, SWA_KV_HEADS, SWA_HEAD_DIM)
    kc = csk.reshape(B, L, SWA_KV_HEADS, SWA_HEAD_DIM)
    vc = csv.reshape(B, L, SWA_KV_HEADS, SWA_HEAD_DIM)
    a_lat = swa_latent(q, k, v, kc, vc, sink)
    out_lat = jnp.concatenate([gla_output(o_lat, gg, gla_g), a_lat], axis=-1) @ w_out
    if not ctx_out:
        return out_lat, None
    a_ctx = ctx_attention(csq.reshape(B, L, SWA_HEADS, SWA_HEAD_DIM), kc, vc, sink)
    out_ctx = jnp.concatenate([gla_output(o_ctx, cg, gla_g), a_ctx], axis=-1) @ w_out
    return out_lat, out_ctx


def token_shift(x):
    prev = jnp.pad(x[:, :-1], ((0, 0), (1, 0), (0, 0)))
    nxt = jnp.pad(x[:, 1:], ((0, 0), (0, 1), (0, 0)))
    return 0.5 * (prev + nxt)


def rwkv_prepare(h, mu, w_rkv, w0, w1, w2, a0, a1, a2, g1, g2, k_k, k_a, full):
    B, T, D = h.shape
    xx = token_shift(h) - h
    xs = h[None] + xx[None] * mu[:, None, None, :]
    k = xs[2] @ w_rkv[1]
    v = xs[3] @ w_rkv[2]
    lw = w0 + jnp.einsum('btzr,zrd->btzd', jnp.tanh(jnp.einsum('btd,zdr->btzr', xs[1], w1)), w2)
    decay = jnp.exp(-jnp.exp(-jax.nn.softplus(-lw.astype(F32)) - 0.5))
    a = jax.nn.sigmoid((a0 + jnp.einsum('btzr,zrd->btzd', jnp.einsum('btd,zdr->btzr', xs[4], a1), a2)).astype(F32))
    kk = (k * k_k).astype(F32).reshape(B, T, RW_HEADS, RW_HEAD_DIM)
    kk = kk * lax.rsqrt(jnp.maximum(jnp.sum(kk * kk, axis=-1, keepdims=True), 1e-24))
    k_dir = k.astype(F32)[:, :, None] * (1 + (a - 1) * k_a.astype(F32))

    def heads(t):
        return t.reshape(t.shape[:-1] + (RW_HEADS, RW_HEAD_DIM))

    r = heads(xs[0] @ w_rkv[0]) if full else None
    g = (jax.nn.sigmoid(xs[5] @ g1) @ g2) if full else None
    return r, heads(decay), heads(k_dir), heads(v), kk, heads(a), g


def rwkv7_scan(r, decay, k, v, kk, a, s0):
    emit = r is not None
    seq = [t.astype(F32).transpose(1, 0, 2, 3) for t in (decay, k, v, kk, a)]
    if emit:
        seq.append(r.astype(F32).transpose(1, 0, 2, 3))

    def step(S, inp):
        w_t, k_t, v_t, kk_t, a_t = inp[:5]
        S = (S * w_t[:, :, None, :]
             - jnp.einsum('bhvk,bhk->bhv', S, kk_t)[..., None] * (kk_t * a_t)[:, :, None, :]
             + v_t[..., None] * k_t[:, :, None, :])
        y = jnp.einsum('bhvk,bhk->bhv', S, inp[5]) if emit else None
        return S, y

    s_fin, ys = lax.scan(step, s0, tuple(seq))
    return (ys.transpose(1, 0, 2, 3) if emit else None), s_fin


def rwkv_output(y, r, k_dir, v, g, r_k, ln_g, ln_b, w_o):
    B, T = y.shape[:2]
    mean = jnp.mean(y, axis=-1, keepdims=True)
    var = jnp.mean((y - mean) ** 2, axis=-1, keepdims=True)
    yn = ((y - mean) * lax.rsqrt(var + RW_GN_EPS)).reshape(B, T, -1) * ln_g.astype(F32) + ln_b.astype(F32)
    bonus = jnp.einsum('bthn,btzhn,hn->bth', r.astype(F32), k_dir, r_k.astype(F32))[..., None] * v.astype(F32)
    out = (yn + bonus.reshape(B, T, -1)) * g.astype(F32)
    return out.astype(g.dtype) @ w_o


def odd_mixer(u_lat, u_ctx, mu, w_rkv, w_o, w0, w1, w2, a0, a1, a2, g1, g2, k_k, k_a, r_k, ln_g, ln_b, ctx_out):
    p = (mu, w_rkv, w0, w1, w2, a0, a1, a2, g1, g2, k_k, k_a)
    r_l, dec_l, kd_l, v_l, kk_l, a_l, g_l = rwkv_prepare(u_lat, *p, True)
    r_c, dec_c, kd_c, v_c, kk_c, a_c, g_c = rwkv_prepare(u_ctx, *p, ctx_out)
    zeros = jnp.zeros((u_lat.shape[0], RW_HEADS, RW_HEAD_DIM, RW_HEAD_DIM), F32)
    ys_lat, ys_ctx = [], []
    for z in range(2):
        d = flip if z == 1 else ident
        yc, sc = rwkv7_scan(d(r_c) if ctx_out else None, d(dec_c[:, :, z]), d(kd_c[:, :, z]), d(v_c),
                            d(kk_c), d(a_c[:, :, z]), zeros)
        yl, _ = rwkv7_scan(d(r_l), d(dec_l[:, :, z]), d(kd_l[:, :, z]), d(v_l), d(kk_l), d(a_l[:, :, z]), sc)
        ys_lat.append(d(yl))
        if ctx_out:
            ys_ctx.append(d(yc))
    out_lat = rwkv_output(ys_lat[0] + ys_lat[1], r_l, kd_l, v_l, g_l, r_k, ln_g, ln_b, w_o)
    if not ctx_out:
        return out_lat, None
    out_ctx = rwkv_output(ys_ctx[0] + ys_ctx[1], r_c, kd_c, v_c, g_c, r_k, ln_g, ln_b, w_o)
    return out_lat, out_ctx


def peer_ffn(t, w_q, k1, k2, u, v):
    M, D = t.shape
    half = PEER_KEY_DIM // 2
    q = (t @ w_q).astype(F32).reshape(M, PEER_HEADS, 2, half)
    s1 = jnp.einsum('mhd,hnd->mhn', q[:, :, 0], k1.astype(F32))
    s2 = jnp.einsum('mhd,hnd->mhn', q[:, :, 1], k2.astype(F32))
    v1, i1 = lax.top_k(s1, PEER_TOPK)
    v2, i2 = lax.top_k(s2, PEER_TOPK)
    cand = (v1[..., :, None] + v2[..., None, :]).reshape(M, PEER_HEADS, PEER_TOPK * PEER_TOPK)
    cand_idx = (i1[..., :, None] * PEER_NKEYS + i2[..., None, :]).reshape(M, PEER_HEADS, PEER_TOPK * PEER_TOPK)
    top_s, pos = lax.top_k(cand, PEER_TOPK)
    idx = jnp.take_along_axis(cand_idx, pos, axis=-1)
    gate = jax.nn.softmax(top_s, axis=-1)
    nb = M // PEER_BLOCK

    def block(args):
        tb, ib, gb = args
        ue = u[ib]
        ve = v[ib]
        act = jax.nn.gelu(jnp.einsum('phkd,pd->phk', ue, tb).astype(F32), approximate=False)
        return jnp.einsum('phk,phkd->pd', (gb * act).astype(ve.dtype), ve)

    out = lax.map(block, (t.reshape(nb, PEER_BLOCK, D), idx.reshape(nb, PEER_BLOCK, PEER_HEADS, PEER_TOPK),
                          gate.reshape(nb, PEER_BLOCK, PEER_HEADS, PEER_TOPK)))
    return out.reshape(M, D)


def setup_inputs(seed: int = 0) -> dict:
    key = jax.random.key(seed)
    keys = iter(jax.random.split(key, 48))
    D = D_MODEL

    def nrm(shape, scale):
        return jax.random.normal(next(keys), shape, jnp.float32) * scale

    def gain(shape):
        return 1.0 + nrm(shape, 0.02)

    return {
        'x': nrm((BATCH, SEQ, D), 1.0),
        'c': nrm((BATCH, D), 1.0),
        'ctx': nrm((BATCH, CTX_LEN, D), 1.0),
        'c_ctx': nrm((D,), 1.0),
        'ada_w': nrm((DEPTH, D, 6 * D), 0.5 * D ** -0.5),
        'ada_b': nrm((DEPTH, 6 * D), 0.02),
        'norm1_g': gain((DEPTH, D)),
        'norm2_g': gain((DEPTH, D)),
        'ab_w_in': nrm((N_EVEN, D, PROJ_DIM), D ** -0.5),
        'gla_dec_w2': nrm((N_EVEN, 2, GLA_LOWRANK, GLA_HEADS * GLA_DK), GLA_LOWRANK ** -0.5),
        'gla_dec_b': nrm((N_EVEN, 2, GLA_HEADS * GLA_DK), 0.1),
        'gla_norm_g': gain((N_EVEN, GLA_HEADS * GLA_DV)),
        'swa_sink': nrm((N_EVEN, SWA_HEADS), 0.5),
        'ab_w_out': nrm((N_EVEN, MIX_DIM, D), MIX_DIM ** -0.5),
        'rw_mu': jax.random.uniform(next(keys), (N_ODD, 6, D), jnp.float32),
        'rw_w_rkv': nrm((N_ODD, 3, D, D), D ** -0.5),
        'rw_w_o': nrm((N_ODD, D, D), D ** -0.5),
        'rw_w0': nrm((N_ODD, 2, D), 1.0) - 1.0,
        'rw_w1': nrm((N_ODD, 2, D, RW_DECAY_LORA), 0.5 * D ** -0.5),
        'rw_w2': nrm((N_ODD, 2, RW_DECAY_LORA, D), 0.5 * RW_DECAY_LORA ** -0.5),
        'rw_a0': nrm((N_ODD, 2, D), 0.1),
        'rw_a1': nrm((N_ODD, 2, D, RW_AAA_LORA), 0.5 * D ** -0.5),
        'rw_a2': nrm((N_ODD, 2, RW_AAA_LORA, D), 0.5 * RW_AAA_LORA ** -0.5),
        'rw_g1': nrm((N_ODD, D, RW_GATE_LORA), D ** -0.5),
        'rw_g2': nrm((N_ODD, RW_GATE_LORA, D), RW_GATE_LORA ** -0.5),
        'rw_k_k': 0.85 + nrm((N_ODD, D), 0.02),
        'rw_k_a': gain((N_ODD, D)),
        'rw_r_k': nrm((N_ODD, RW_HEADS, RW_HEAD_DIM), 0.1),
        'rw_ln_g': gain((N_ODD, D)),
        'rw_ln_b': nrm((N_ODD, D), 0.02),
        'peer_w_q': nrm((DEPTH, D, PEER_HEADS * PEER_KEY_DIM), D ** -0.5),
        'peer_k1': nrm((DEPTH, PEER_HEADS, PEER_NKEYS, PEER_KEY_DIM // 2), (PEER_KEY_DIM // 2) ** -0.5),
        'peer_k2': nrm((DEPTH, PEER_HEADS, PEER_NKEYS, PEER_KEY_DIM // 2), (PEER_KEY_DIM // 2) ** -0.5),
        'peer_u': nrm((DEPTH, PEER_EXPERTS, D), D ** -0.5),
        'peer_v': nrm((DEPTH, PEER_EXPERTS, D), 1.0),
        'final_g': gain((D,)),
    }


def reference(x, c, ctx, c_ctx, ada_w, ada_b, norm1_g, norm2_g,
              ab_w_in, gla_dec_w2, gla_dec_b, gla_norm_g, swa_sink, ab_w_out,
              rw_mu, rw_w_rkv, rw_w_o, rw_w0, rw_w1, rw_w2, rw_a0, rw_a1, rw_a2,
              rw_g1, rw_g2, rw_k_k, rw_k_a, rw_r_k, rw_ln_g, rw_ln_b,
              peer_w_q, peer_k1, peer_k2, peer_u, peer_v, final_g):
    B, T, D = x.shape
    cos, sin = axial_rope_tables(T)
    s_lat = jax.nn.silu(c)
    s_ctx = jax.nn.silu(c_ctx)
    for i in range(DEPTH):
        last = i == DEPTH - 1
        j = i // 2
        mod_l = jnp.split((s_lat @ ada_w[i] + ada_b[i])[:, None, :], 6, axis=-1)
        mod_c = jnp.split(s_ctx @ ada_w[i] + ada_b[i], 6, axis=-1)
        u_lat = modulate(x, norm1_g[i], mod_l[0], mod_l[1])
        u_ctx = modulate(ctx, norm1_g[i], mod_c[0], mod_c[1])
        if i % 2 == 0:
            m_lat, m_ctx = even_mixer(u_lat, u_ctx, ab_w_in[j], gla_dec_w2[j], gla_dec_b[j], gla_norm_g[j],
                                      swa_sink[j], ab_w_out[j], cos, sin, not last)
        else:
            m_lat, m_ctx = odd_mixer(u_lat, u_ctx, rw_mu[j], rw_w_rkv[j], rw_w_o[j], rw_w0[j], rw_w1[j], rw_w2[j],
                                     rw_a0[j], rw_a1[j], rw_a2[j], rw_g1[j], rw_g2[j], rw_k_k[j], rw_k_a[j],
                                     rw_r_k[j], rw_ln_g[j], rw_ln_b[j], not last)
        x = x + mod_l[2] * m_lat
        f_lat = modulate(x, norm2_g[i], mod_l[3], mod_l[4])
        if last:
            f = peer_ffn(f_lat.reshape(-1, D), peer_w_q[i], peer_k1[i], peer_k2[i], peer_u[i], peer_v[i])
            x = x + mod_l[5] * f.reshape(B, T, D)
        else:
            ctx = ctx + mod_c[2] * m_ctx
            f_ctx = modulate(ctx, norm2_g[i], mod_c[3], mod_c[4])
            f = peer_ffn(jnp.concatenate([f_lat.reshape(-1, D), f_ctx.reshape(-1, D)], axis=0),
                         peer_w_q[i], peer_k1[i], peer_k2[i], peer_u[i], peer_v[i])
            x = x + mod_l[5] * f[:B * T].reshape(B, T, D)
            ctx = ctx + mod_c[5] * f[B * T:].reshape(B, -1, D)
    return rms_norm(x, final_g)
```

```cpp
#ifndef CPU_EMU
#include <hip/hip_runtime.h>
#define LAUNCH(sync, kern, grid, block, stream, ...) hipLaunchKernelGGL(kern, dim3(grid), dim3(block), 0, stream, __VA_ARGS__)
#define DUMP(name, ptr, count)
#define DUMPD(name, ptr, count)
#endif
#include <stdint.h>
#include <string.h>
#include <stdio.h>

#ifndef CFG_B
#define CFG_B 8
#define CFG_T 2048
#define CFG_L 256
#endif
constexpr int B_ = CFG_B, T_ = CFG_T, L_ = CFG_L, D_ = 1024;
constexpr int NLAT = B_ * T_, NCTX = B_ * L_, NTOK = NLAT + NCTX;
constexpr int PROJW = 2336;
constexpr int C_GQ = 0, C_GK = 256, C_GV = 512, C_GG = 1024, C_LR = 1536, C_SQ = 1568, C_SK = 2080, C_SV = 2208;
constexpr int D6 = 6 * D_;

struct bf16 { unsigned short v; };
#ifdef AT_F32
typedef float AT;
#else
typedef bf16 AT;
#endif
#ifdef CPU_EMU
typedef float DT;
#else
typedef _Float16 DT;
#endif
__device__ __forceinline__ float ldf(const float* p) { return *p; }
__device__ __forceinline__ void stf(float* p, float v) { *p = v; }
__device__ __forceinline__ float ldf(const bf16* p) { unsigned u = (unsigned)p->v << 16; float f; memcpy(&f, &u, 4); return f; }
__device__ __forceinline__ void stf(bf16* p, float f) { unsigned u; memcpy(&u, &f, 4); u = (u + 0x7fffu + ((u >> 16) & 1u)) >> 16; p->v = (unsigned short)u; }
__device__ __forceinline__ float sigmoidf_(float x) { return 1.f / (1.f + expf(-x)); }

struct TokInfo { int b, pos, len; };
__device__ __forceinline__ TokInfo tokinfo(int m) {
    TokInfo t; if (m < NLAT) { t.b = m / T_; t.pos = m % T_; t.len = T_; } else { int c = m - NLAT; t.b = c / L_; t.pos = c % L_; t.len = L_; } return t; }
__device__ __forceinline__ int tok_row(int m) { return m < NLAT ? m / T_ : B_; }

constexpr size_t al_(size_t x) { return (x + 255) & ~(size_t)255; }
constexpr size_t SA = sizeof(AT), SD = sizeof(DT);
constexpr size_t OFF_MOD = 0;
constexpr size_t OFF_XC = al_(OFF_MOD + (size_t)2 * (B_ + 1) * D6 * 4);
constexpr size_t OFF_U = al_(OFF_XC + (size_t)NTOK * D_ * 4);
constexpr size_t OFF_MIX = al_(OFF_U + (size_t)NTOK * D_ * SA);
constexpr size_t OFF_BIG = al_(OFF_MIX + (size_t)NTOK * D_ * SA);
constexpr size_t OFF_PROJ = OFF_BIG;
constexpr size_t OFF_LOGA = al_(OFF_PROJ + (size_t)NTOK * PROJW * SA);
constexpr size_t OFF_GLAO = al_(OFF_LOGA + (size_t)NTOK * 512 * 4);
constexpr size_t END_L0 = al_(OFF_GLAO + (size_t)2 * NTOK * 512 * 4);
constexpr size_t OFF_PQ = OFF_BIG;
constexpr size_t OFF_PIDX = al_(OFF_PQ + (size_t)NTOK * 2048 * SA);
constexpr size_t OFF_PGATE = al_(OFF_PIDX + (size_t)NTOK * 128 * 4);
constexpr size_t END_PEER = al_(OFF_PGATE + (size_t)NTOK * 128 * 4);
constexpr size_t OFF_R = OFF_BIG;
constexpr size_t OFF_K = al_(OFF_R + (size_t)NTOK * D_ * SA);
constexpr size_t OFF_V = al_(OFF_K + (size_t)NTOK * D_ * SA);
constexpr size_t OFF_KK = al_(OFF_V + (size_t)NTOK * D_ * SA);
constexpr size_t OFF_G = al_(OFF_KK + (size_t)NTOK * D_ * SA);
constexpr size_t OFF_A = al_(OFF_G + (size_t)NTOK * D_ * SA);
constexpr size_t OFF_DEC = al_(OFF_A + (size_t)NTOK * 2 * D_ * SA);
constexpr size_t OFF_TW = al_(OFF_DEC + (size_t)NTOK * 2 * D_ * (SD > SA ? SD : SA));
constexpr size_t OFF_TA = al_(OFF_TW + (size_t)NTOK * 128 * SA);
constexpr size_t OFF_TG = al_(OFF_TA + (size_t)NTOK * 128 * SA);
constexpr size_t END_L1 = al_(OFF_TG + (size_t)NTOK * 160 * SA);
constexpr size_t WS_END = (END_L0 > END_L1 ? (END_L0 > END_PEER ? END_L0 : END_PEER) : (END_L1 > END_PEER ? END_L1 : END_PEER));

__global__ void k_adaln(const float* c, const float* c_ctx, const float* ada_w, const float* ada_b, float* MOD) {
    int idx = blockIdx.x * blockDim.x + threadIdx.x; if (idx >= 2 * (B_ + 1) * D6) return;
    int col = idx % D6, row = (idx / D6) % (B_ + 1), layer = idx / (D6 * (B_ + 1));
    const float* cv = row < B_ ? c + row * D_ : c_ctx;
    const float* w = ada_w + (size_t)layer * D_ * D6;
    float acc = ada_b[layer * D6 + col];
    for (int k = 0; k < D_; ++k) { float x = cv[k]; acc += x * sigmoidf_(x) * w[(size_t)k * D6 + col]; }
    MOD[idx] = acc;
}
__global__ void k_init_xc(const float* x, const float* ctx, float* XC) {
    size_t idx = (size_t)blockIdx.x * blockDim.x + threadIdx.x; if (idx >= (size_t)NTOK * D_) return;
    XC[idx] = idx < (size_t)NLAT * D_ ? x[idx] : ctx[idx - (size_t)NLAT * D_];
}
__global__ void k_modnorm(const float* XC, const float* g, const float* MODL, int ishift, int iscale, AT* out) {
    __shared__ float red[256];
    int m = blockIdx.x, tid = threadIdx.x;
    const float* xr = XC + (size_t)m * D_;
    float v[4], ss = 0.f;
#pragma unroll
    for (int i = 0; i < 4; ++i) { v[i] = xr[tid + 256 * i]; ss += v[i] * v[i]; }
    red[tid] = ss; __syncthreads();
    float tot = 0.f; for (int i = 0; i < 256; ++i) tot += red[i];
    float rs = rsqrtf(tot / D_ + 1e-6f);
    const float* mr = MODL + (size_t)tok_row(m) * D6;
#pragma unroll
    for (int i = 0; i < 4; ++i) { int d = tid + 256 * i; float y = v[i] * rs * g[d] * (1.f + mr[iscale * D_ + d]) + mr[ishift * D_ + d]; stf(out + (size_t)m * D_ + d, y); }
}
__global__ void k_final(const float* XC, const float* g, float* out) {
    __shared__ float red[256];
    int m = blockIdx.x, tid = threadIdx.x;
    const float* xr = XC + (size_t)m * D_;
    float v[4], ss = 0.f;
#pragma unroll
    for (int i = 0; i < 4; ++i) { v[i] = xr[tid + 256 * i]; ss += v[i] * v[i]; }
    red[tid] = ss; __syncthreads();
    float tot = 0.f; for (int i = 0; i < 256; ++i) tot += red[i];
    float rs = rsqrtf(tot / D_ + 1e-6f);
#pragma unroll
    for (int i = 0; i < 4; ++i) { int d = tid + 256 * i; out[(size_t)m * D_ + d] = v[i] * rs * g[d]; }
}

struct ALPlain { const AT* p; int lda; int pad; __device__ __forceinline__ float operator()(int m, int k) const { return ldf(p + (size_t)m * lda + k); } };
struct ALMix { const AT* h; const float* mu;
    __device__ __forceinline__ float operator()(int m, int k) const {
        TokInfo ti = tokinfo(m); float cur = ldf(h + (size_t)m * D_ + k);
        float prev = ti.pos > 0 ? ldf(h + (size_t)(m - 1) * D_ + k) : 0.f;
        float nxt = ti.pos < ti.len - 1 ? ldf(h + (size_t)(m + 1) * D_ + k) : 0.f;
        return cur + (0.5f * (prev + nxt) - cur) * mu[k]; } };
struct EPStore { AT* o; int ldo; int act;
    __device__ __forceinline__ void operator()(int m, int n, float a) const { if (act == 1) a = tanhf(a); if (act == 2) a = sigmoidf_(a); stf(o + (size_t)m * ldo + n, a); } };
struct EPResid { float* XC; const float* MODL; int igate; int pad;
    __device__ __forceinline__ void operator()(int m, int n, float a) const { XC[(size_t)m * D_ + n] += MODL[(size_t)tok_row(m) * D6 + igate * D_ + n] * a; } };
struct EPDecay { DT* o; const float* w0z; int z; int pad;
    __device__ __forceinline__ void operator()(int m, int n, float a) const { float lw = w0z[n] + a; o[((size_t)m * 2 + z) * D_ + n] = (DT)expf(-0.6065306597f * sigmoidf_(lw)); } };
struct EPAgate { AT* o; const float* a0z; int z; int pad;
    __device__ __forceinline__ void operator()(int m, int n, float a) const { stf(o + ((size_t)m * 2 + z) * D_ + n, sigmoidf_(a0z[n] + a)); } };

template <class AL, class EP>
__global__ void k_gemm(int M, int N, int K, AL al, const float* Bm, int ldb, EP ep) {
    size_t idx = (size_t)blockIdx.x * blockDim.x + threadIdx.x; int n4 = N / 4; if (idx >= (size_t)(M / 4) * n4) return;
    int m0 = (int)(idx / n4) * 4, n0 = (int)(idx % n4) * 4;
    float acc[4][4];
#pragma unroll
    for (int i = 0; i < 4; ++i)
#pragma unroll
        for (int j = 0; j < 4; ++j) acc[i][j] = 0.f;
    for (int k = 0; k < K; ++k) {
        float a[4], b[4];
#pragma unroll
        for (int i = 0; i < 4; ++i) a[i] = al(m0 + i, k);
#pragma unroll
        for (int j = 0; j < 4; ++j) b[j] = Bm[(size_t)k * ldb + n0 + j];
#pragma unroll
        for (int i = 0; i < 4; ++i)
#pragma unroll
            for (int j = 0; j < 4; ++j) acc[i][j] += a[i] * b[j];
    }
#pragma unroll
    for (int i = 0; i < 4; ++i)
#pragma unroll
        for (int j = 0; j < 4; ++j) ep(m0 + i, n0 + j, acc[i][j]);
}

__global__ void k_rope(AT* PROJ) {
    size_t idx = (size_t)blockIdx.x * blockDim.x + threadIdx.x; if (idx >= (size_t)NLAT * 10 * 32) return;
    int f = idx % 32, hd = (idx / 32) % 10; int m = (int)(idx / 320);
    int t = m % T_; int axis = f / 16, fr = f % 16;
    float pos = axis == 0 ? (float)(t / 64) : (float)(t % 64);
    float inv = expf(-(float)fr * (9.210340371976184f / 16.f));
    float ang = pos * inv, cs = cosf(ang), sn = sinf(ang);
    AT* p = PROJ + (size_t)m * PROJW + (hd < 8 ? C_SQ + hd * 64 : C_SK + (hd - 8) * 64) + axis * 32 + fr;
    float a = ldf(p), b = ldf(p + 16);
    stf(p, a * cs - b * sn); stf(p + 16, b * cs + a * sn);
}
__global__ void k_gla_loga(const AT* PROJ, const float* dec_w2, const float* dec_b, float* LOGA) {
    size_t idx = (size_t)blockIdx.x * blockDim.x + threadIdx.x; if (idx >= (size_t)NTOK * 512) return;
    int e = idx % 256, z = (idx / 256) % 2; int m = (int)(idx / 512);
    float acc = dec_b[z * 256 + e];
    for (int r = 0; r < 16; ++r) acc += ldf(PROJ + (size_t)m * PROJW + C_LR + z * 16 + r) * dec_w2[(z * 16 + r) * 256 + e];
    float ls = fminf(acc, 0.f) - log1pf(expf(-fabsf(acc)));
    LOGA[idx] = ls * (1.f / 16.f);
}
__device__ __forceinline__ int scan_token(int b, int z, int step) {
    if (step < L_) { int p = z == 0 ? step : L_ - 1 - step; return NLAT + b * L_ + p; }
    int s2 = step - L_; int p = z == 0 ? s2 : T_ - 1 - s2; return b * T_ + p;
}
__global__ void __launch_bounds__(128) k_gla_scan(const AT* PROJ, const float* LOGA, float* GLAO) {
    int idx = blockIdx.x * blockDim.x + threadIdx.x; if (idx >= B_ * 4 * 2 * 128) return;
    int vv = idx % 128, z = (idx / 128) % 2, h = (idx / 256) % 4, b = idx / 1024;
    float S[64];
#pragma unroll
    for (int d = 0; d < 64; ++d) S[d] = 0.f;
    for (int step = 0; step < L_ + T_; ++step) {
        int m = scan_token(b, z, step);
        const AT* pr = PROJ + (size_t)m * PROJW; const float* la = LOGA + ((size_t)m * 2 + z) * 256 + h * 64;
        float vval = ldf(pr + C_GV + h * 128 + vv), o = 0.f;
#pragma unroll
        for (int d = 0; d < 64; ++d) {
            float a = expf(la[d]); float q = ldf(pr + C_GQ + h * 64 + d) * 0.125f, k = ldf(pr + C_GK + h * 64 + d);
            float s = S[d] * a; if (z == 1) o += q * s; s += k * vval; if (z == 0) o += q * s; S[d] = s;
        }
        GLAO[((size_t)z * NTOK + m) * 512 + h * 128 + vv] = o;
    }
}
__global__ void k_gla_out(const AT* PROJ, const float* GLAO, const float* gn, AT* MIX) {
    int idx = blockIdx.x * blockDim.x + threadIdx.x; if (idx >= NTOK * 4) return;
    int h = idx % 4, m = idx / 4;
    const float* o0 = GLAO + (size_t)m * 512 + h * 128; const float* o1 = GLAO + ((size_t)NTOK + m) * 512 + h * 128;
    float ss = 0.f; for (int v = 0; v < 128; ++v) { float o = o0[v] + o1[v]; ss += o * o; }
    float rs = rsqrtf(ss / 128.f + 1e-6f);
    for (int v = 0; v < 128; ++v) { float o = o0[v] + o1[v]; float gt = ldf(PROJ + (size_t)m * PROJW + C_GG + h * 128 + v);
        stf(MIX + (size_t)m * D_ + h * 128 + v, o * rs * gn[h * 128 + v] * gt * sigmoidf_(gt)); }
}
__global__ void __launch_bounds__(256) k_swa(const AT* PROJ, const float* sink, AT* MIX) {
    int idx = blockIdx.x * blockDim.x + threadIdx.x; if (idx >= NTOK * 8) return;
    int hq = idx % 8, m = idx / 8, g = hq / 4;
    TokInfo ti = tokinfo(m);
    float q[64], acc[64];
#pragma unroll
    for (int d = 0; d < 64; ++d) { q[d] = ldf(PROJ + (size_t)m * PROJW + C_SQ + hq * 64 + d) * 0.125f; acc[d] = 0.f; }
    float mx = sink[hq], l = 1.f;
    int nloc = 0, j0 = 0;
    if (m < NLAT) { j0 = ti.pos - 128 < 0 ? 0 : ti.pos - 128; int j1 = ti.pos + 128 > T_ - 1 ? T_ - 1 : ti.pos + 128; nloc = j1 - j0 + 1; }
    for (int jj = 0; jj < nloc + L_; ++jj) {
        int row = jj < nloc ? ti.b * T_ + j0 + jj : NLAT + ti.b * L_ + (jj - nloc);
        const AT* kp = PROJ + (size_t)row * PROJW + C_SK + g * 64; const AT* vp = PROJ + (size_t)row * PROJW + C_SV + g * 64;
        float s = 0.f;
#pragma unroll
        for (int d = 0; d < 64; ++d) s += q[d] * ldf(kp + d);
        if (s > mx) { float sc = expf(mx - s); l *= sc;
#pragma unroll
            for (int d = 0; d < 64; ++d) acc[d] *= sc;
            mx = s; }
        float p = expf(s - mx); l += p;
#pragma unroll
        for (int d = 0; d < 64; ++d) acc[d] += p * ldf(vp + d);
    }
    float il = 1.f / l;
#pragma unroll
    for (int d = 0; d < 64; ++d) stf(MIX + (size_t)m * D_ + 512 + hq * 64 + d, acc[d] * il);
}

__global__ void k_peer_topk(const AT* PQ, const float* k1, const float* k2, int* PIDX, float* PGATE) {
    __shared__ float sc[16][128];
    __shared__ float tv[16][16]; __shared__ int ti[16][16];
    __shared__ float cv[8][256];
    __shared__ float ss[8][16]; __shared__ int si[8][16];
    int m = blockIdx.x, tid = threadIdx.x;
    for (int i = 0; i < 8; ++i) { int e = tid + 256 * i; int list = e / 128, n = e % 128, h = list / 2, side = list % 2;
        const float* kr = (side ? k2 : k1) + ((size_t)h * 128 + n) * 128; const AT* qp = PQ + (size_t)m * 2048 + h * 256 + side * 128;
        float s = 0.f; for (int d = 0; d < 128; ++d) s += ldf(qp + d) * kr[d];
        sc[list][n] = s; }
    __syncthreads();
    for (int i = 0; i < 8; ++i) { int e = tid + 256 * i; int list = e / 128, n = e % 128; float s = sc[list][n]; int r = 0;
        for (int j = 0; j < 128; ++j) { float o = sc[list][j]; r += (o > s || (o == s && j < n)) ? 1 : 0; }
        if (r < 16) { tv[list][r] = s; ti[list][r] = n; } }
    __syncthreads();
    for (int i = 0; i < 8; ++i) { int e = tid + 256 * i; int h = e / 256, c = e % 256; cv[h][c] = tv[2 * h][c / 16] + tv[2 * h + 1][c % 16]; }
    __syncthreads();
    for (int i = 0; i < 8; ++i) { int e = tid + 256 * i; int h = e / 256, c = e % 256; float s = cv[h][c]; int r = 0;
        for (int j = 0; j < 256; ++j) { float o = cv[h][j]; r += (o > s || (o == s && j < c)) ? 1 : 0; }
        if (r < 16) { ss[h][r] = s; si[h][r] = ti[2 * h][c / 16] * 128 + ti[2 * h + 1][c % 16]; } }
    __syncthreads();
    if (tid < 128) { int h = tid / 16, r = tid % 16; float mx = ss[h][0], sum = 0.f;
        for (int j = 0; j < 16; ++j) sum += expf(ss[h][j] - mx);
        PIDX[(size_t)m * 128 + tid] = si[h][r]; PGATE[(size_t)m * 128 + tid] = expf(ss[h][r] - mx) / sum; }
}
__global__ void k_peer_apply(const AT* F, const int* PIDX, const float* PGATE, const float* U, const float* V, const float* MODL, float* XC) {
    __shared__ float tvec[1024]; __shared__ float part[256]; __shared__ float coef[128]; __shared__ int eid[128];
    int m = blockIdx.x, tid = threadIdx.x;
    for (int i = 0; i < 4; ++i) tvec[tid + 256 * i] = ldf(F + (size_t)m * D_ + tid + 256 * i);
    if (tid < 128) eid[tid] = PIDX[(size_t)m * 128 + tid];
    __syncthreads();
    { int e = tid / 2, hf = tid % 2; const float* ur = U + (size_t)eid[e] * D_ + hf * 512; float s = 0.f;
      for (int d = 0; d < 512; ++d) s += ur[d] * tvec[hf * 512 + d];
      part[tid] = s; }
    __syncthreads();
    if (tid < 128) { float a = part[2 * tid] + part[2 * tid + 1]; coef[tid] = PGATE[(size_t)m * 128 + tid] * 0.5f * a * (1.f + erff(a * 0.70710678118f)); }
    __syncthreads();
    const float* mr = MODL + (size_t)tok_row(m) * D6 + 5 * D_;
    for (int i = 0; i < 4; ++i) { int col = tid + 256 * i; float acc = 0.f;
        for (int e = 0; e < 128; ++e) acc += coef[e] * V[(size_t)eid[e] * D_ + col];
        XC[(size_t)m * D_ + col] += mr[col] * acc; }
}

__global__ void k_rw_kk(const AT* K, const float* k_k, AT* KK) {
    int idx = blockIdx.x * blockDim.x + threadIdx.x; if (idx >= NTOK * 16) return;
    int h = idx % 16, m = idx / 16; float ss = 0.f;
    for (int n = 0; n < 64; ++n) { float x = ldf(K + (size_t)m * D_ + h * 64 + n) * k_k[h * 64 + n]; ss += x * x; }
    float rs = rsqrtf(fmaxf(ss, 1e-24f));
    for (int n = 0; n < 64; ++n) stf(KK + (size_t)m * D_ + h * 64 + n, ldf(K + (size_t)m * D_ + h * 64 + n) * k_k[h * 64 + n] * rs);
}
__global__ void __launch_bounds__(64) k_rw_scan(const AT* R, const AT* K, const AT* V, const AT* KK, const AT* A, const DT* DEC, const float* k_a, AT* Y0, AT* Y1) {
    int idx = blockIdx.x * blockDim.x + threadIdx.x; if (idx >= B_ * 16 * 2 * 64) return;
    int vv = idx % 64, z = (idx / 64) % 2, h = (idx / 128) % 16, b = idx / 2048;
    float S[64];
#pragma unroll
    for (int d = 0; d < 64; ++d) S[d] = 0.f;
    AT* Y = z == 0 ? Y0 : Y1;
    for (int step = 0; step < L_ + T_; ++step) {
        int m = scan_token(b, z, step);
        size_t o1 = (size_t)m * D_ + h * 64, o2 = ((size_t)m * 2 + z) * D_ + h * 64;
        float sa = 0.f;
#pragma unroll
        for (int d = 0; d < 64; ++d) sa += S[d] * ldf(KK + o1 + d);
        float vval = ldf(V + o1 + vv), y = 0.f;
        bool lat = m < NLAT;
#pragma unroll
        for (int d = 0; d < 64; ++d) {
            float w = (float)DEC[o2 + d], a = ldf(A + o2 + d), k = ldf(K + o1 + d), kk = ldf(KK + o1 + d);
            float kd = k * (1.f + (a - 1.f) * k_a[h * 64 + d]);
            float s = S[d] * w - sa * (kk * a) + vval * kd; S[d] = s;
            if (lat) y += s * ldf(R + o1 + d);
        }
        if (lat) stf(Y + o1 + vv, y);
    }
}
__global__ void k_rw_out(const AT* Y0, const AT* Y1, const AT* R, const AT* K, const AT* V, const AT* A, const AT* G, const float* k_a, const float* r_k,
                         const float* ln_g, const float* ln_b, AT* OUT) {
    int idx = blockIdx.x * blockDim.x + threadIdx.x; if (idx >= NLAT * 16) return;
    int h = idx % 16, m = idx / 16; size_t o1 = (size_t)m * D_ + h * 64;
    float mean = 0.f; for (int n = 0; n < 64; ++n) mean += ldf(Y0 + o1 + n) + ldf(Y1 + o1 + n); mean *= (1.f / 64.f);
    float var = 0.f; for (int n = 0; n < 64; ++n) { float d = ldf(Y0 + o1 + n) + ldf(Y1 + o1 + n) - mean; var += d * d; } var *= (1.f / 64.f);
    float rs = rsqrtf(var + 64e-5f);
    float bonus = 0.f;
    for (int z = 0; z < 2; ++z) for (int n = 0; n < 64; ++n) { float a = ldf(A + ((size_t)m * 2 + z) * D_ + h * 64 + n); float k = ldf(K + o1 + n);
        bonus += ldf(R + o1 + n) * k * (1.f + (a - 1.f) * k_a[h * 64 + n]) * r_k[h * 64 + n]; }
    for (int n = 0; n < 64; ++n) { float y = ldf(Y0 + o1 + n) + ldf(Y1 + o1 + n);
        float o = ((y - mean) * rs * ln_g[h * 64 + n] + ln_b[h * 64 + n] + bonus * ldf(V + o1 + n)) * ldf(G + o1 + n);
        stf(OUT + o1 + n, o); }
}

template <class AL, class EP>
static void gemm(hipStream_t st, int M, int N, int K, AL al, const float* Bm, int ldb, EP ep) {
    size_t nth = (size_t)(M / 4) * (N / 4);
    LAUNCH(false, (k_gemm<AL, EP>), (nth + 255) / 256, 256, st, M, N, K, al, Bm, ldb, ep);
}

extern "C" void kernel_launch(void* const* d_in, const int* in_sizes, int n_in, void* d_out, int out_size, void* d_ws, size_t ws_size, hipStream_t stream) {
    if (ws_size < WS_END) { fprintf(stderr, "ws too small: %zu < %zu\n", ws_size, (size_t)WS_END); return; }
    const float* x = (const float*)d_in[0]; const float* c = (const float*)d_in[1]; const float* ctx = (const float*)d_in[2]; const float* c_ctx = (const float*)d_in[3];
    const float* ada_w = (const float*)d_in[4]; const float* ada_b = (const float*)d_in[5]; const float* norm1_g = (const float*)d_in[6]; const float* norm2_g = (const float*)d_in[7];
    const float* w_in = (const float*)d_in[8]; const float* dec_w2 = (const float*)d_in[9]; const float* dec_b = (const float*)d_in[10]; const float* gla_g = (const float*)d_in[11];
    const float* sink = (const float*)d_in[12]; const float* w_out = (const float*)d_in[13]; const float* rw_mu = (const float*)d_in[14]; const float* w_rkv = (const float*)d_in[15];
    const float* w_o = (const float*)d_in[16]; const float* rw_w0 = (const float*)d_in[17]; const float* rw_w1 = (const float*)d_in[18]; const float* rw_w2 = (const float*)d_in[19];
    const float* rw_a0 = (const float*)d_in[20]; const float* rw_a1 = (const float*)d_in[21]; const float* rw_a2 = (const float*)d_in[22]; const float* rw_g1 = (const float*)d_in[23];
    const float* rw_g2 = (const float*)d_in[24]; const float* k_k = (const float*)d_in[25]; const float* k_a = (const float*)d_in[26]; const float* r_k = (const float*)d_in[27];
    const float* ln_g = (const float*)d_in[28]; const float* ln_b = (const float*)d_in[29]; const float* peer_wq = (const float*)d_in[30]; const float* peer_k1 = (const float*)d_in[31];
    const float* peer_k2 = (const float*)d_in[32]; const float* peer_u = (const float*)d_in[33]; const float* peer_v = (const float*)d_in[34]; const float* final_g = (const float*)d_in[35];
    char* ws = (char*)d_ws;
    float* MOD = (float*)(ws + OFF_MOD); float* XC = (float*)(ws + OFF_XC); AT* U = (AT*)(ws + OFF_U); AT* MIX = (AT*)(ws + OFF_MIX);
    AT* PROJ = (AT*)(ws + OFF_PROJ); float* LOGA = (float*)(ws + OFF_LOGA); float* GLAO = (float*)(ws + OFF_GLAO);
    AT* PQ = (AT*)(ws + OFF_PQ); int* PIDX = (int*)(ws + OFF_PIDX); float* PGATE = (float*)(ws + OFF_PGATE);
    AT* R = (AT*)(ws + OFF_R); AT* K = (AT*)(ws + OFF_K); AT* V = (AT*)(ws + OFF_V); AT* KK = (AT*)(ws + OFF_KK); AT* G = (AT*)(ws + OFF_G); AT* A = (AT*)(ws + OFF_A);
    DT* DEC = (DT*)(ws + OFF_DEC); AT* RWOUT = (AT*)(ws + OFF_DEC); AT* TW = (AT*)(ws + OFF_TW); AT* TA = (AT*)(ws + OFF_TA); AT* TG = (AT*)(ws + OFF_TG);
    const float* MOD0 = MOD; const float* MOD1 = MOD + (size_t)(B_ + 1) * D6;
    const size_t PE = (size_t)16384 * D_;

    LAUNCH(false, k_adaln, (2 * (B_ + 1) * D6 + 255) / 256, 256, stream, c, c_ctx, ada_w, ada_b, MOD);
    LAUNCH(false, k_init_xc, ((size_t)NTOK * D_ + 255) / 256, 256, stream, x, ctx, XC);
    LAUNCH(true, k_modnorm, NTOK, 256, stream, (const float*)XC, norm1_g, MOD0, 0, 1, U);
    DUMP("u0", U, (size_t)NTOK * D_);
    gemm(stream, NTOK, PROJW, D_, ALPlain{U, D_}, w_in, PROJW, EPStore{PROJ, PROJW, 0});
    DUMP("proj0", PROJ, (size_t)NTOK * PROJW);
    LAUNCH(false, k_rope, ((size_t)NLAT * 320 + 255) / 256, 256, stream, PROJ);
    LAUNCH(false, k_gla_loga, ((size_t)NTOK * 512 + 255) / 256, 256, stream, (const AT*)PROJ, dec_w2, dec_b, LOGA);
    LAUNCH(false, k_gla_scan, (B_ * 1024 + 127) / 128, 128, stream, (const AT*)PROJ, (const float*)LOGA, GLAO);
    LAUNCH(false, k_gla_out, (NTOK * 4 + 255) / 256, 256, stream, (const AT*)PROJ, (const float*)GLAO, gla_g, MIX);
    LAUNCH(false, k_swa, (NTOK * 8 + 255) / 256, 256, stream, (const AT*)PROJ, sink, MIX);
    DUMP("mixin0", MIX, (size_t)NTOK * D_);
    gemm(stream, NTOK, D_, D_, ALPlain{MIX, D_}, w_out, D_, EPResid{XC, MOD0, 2});
    DUMP("xmid0", XC, (size_t)NTOK * D_);
    LAUNCH(true, k_modnorm, NTOK, 256, stream, (const float*)XC, norm2_g, MOD0, 3, 4, U);
    gemm(stream, NTOK, 2048, D_, ALPlain{U, D_}, peer_wq, 2048, EPStore{PQ, 2048, 0});
    LAUNCH(true, k_peer_topk, NTOK, 256, stream, (const AT*)PQ, peer_k1, peer_k2, PIDX, PGATE);
    DUMP("peer_idx0", PIDX, (size_t)NTOK * 128); DUMP("peer_gate0", PGATE, (size_t)NTOK * 128);
    LAUNCH(true, k_peer_apply, NTOK, 256, stream, (const AT*)U, (const int*)PIDX, (const float*)PGATE, peer_u, peer_v, MOD0, XC);
    DUMP("xend0", XC, (size_t)NTOK * D_);
    LAUNCH(true, k_modnorm, NTOK, 256, stream, (const float*)XC, norm1_g + D_, MOD1, 0, 1, U);
    DUMP("u1", U, (size_t)NTOK * D_);
    gemm(stream, NLAT, D_, D_, ALMix{U, rw_mu + 0 * D_}, w_rkv, D_, EPStore{R, D_, 0});
    gemm(stream, NTOK, D_, D_, ALMix{U, rw_mu + 2 * D_}, w_rkv + (size_t)D_ * D_, D_, EPStore{K, D_, 0});
    gemm(stream, NTOK, D_, D_, ALMix{U, rw_mu + 3 * D_}, w_rkv + (size_t)2 * D_ * D_, D_, EPStore{V, D_, 0});
    for (int z = 0; z < 2; ++z) {
        gemm(stream, NTOK, 64, D_, ALMix{U, rw_mu + 1 * D_}, rw_w1 + (size_t)z * D_ * 64, 64, EPStore{TW + z * 64, 128, 1});
        gemm(stream, NTOK, 64, D_, ALMix{U, rw_mu + 4 * D_}, rw_a1 + (size_t)z * D_ * 64, 64, EPStore{TA + z * 64, 128, 0});
    }
    gemm(stream, NLAT, 160, D_, ALMix{U, rw_mu + 5 * D_}, rw_g1, 160, EPStore{TG, 160, 2});
    for (int z = 0; z < 2; ++z) {
        gemm(stream, NTOK, D_, 64, ALPlain{TW + z * 64, 128}, rw_w2 + (size_t)z * 64 * D_, D_, EPDecay{DEC, rw_w0 + z * D_, z});
        gemm(stream, NTOK, D_, 64, ALPlain{TA + z * 64, 128}, rw_a2 + (size_t)z * 64 * D_, D_, EPAgate{A, rw_a0 + z * D_, z});
    }
    gemm(stream, NLAT, D_, 160, ALPlain{TG, 160}, rw_g2, D_, EPStore{G, D_, 0});
    LAUNCH(false, k_rw_kk, (NTOK * 16 + 255) / 256, 256, stream, (const AT*)K, k_k, KK);
    DUMP("rw_r", R, (size_t)NLAT * D_); DUMP("rw_v", V, (size_t)NTOK * D_); DUMP("rw_kk", KK, (size_t)NTOK * D_); DUMP("rw_a", A, (size_t)NTOK * 2 * D_); DUMP("rw_g", G, (size_t)NLAT * D_);
    DUMPD("rw_dec", DEC, (size_t)NTOK * 2 * D_);
    LAUNCH(false, k_rw_scan, (B_ * 2048 + 63) / 64, 64, stream, (const AT*)R, (const AT*)K, (const AT*)V, (const AT*)KK, (const AT*)A, (const DT*)DEC, k_a, U, MIX);
    LAUNCH(false, k_rw_out, (NLAT * 16 + 255) / 256, 256, stream, (const AT*)U, (const AT*)MIX, (const AT*)R, (const AT*)K, (const AT*)V, (const AT*)A, (const AT*)G, k_a, r_k, ln_g, ln_b, RWOUT);
    DUMP("rwout", RWOUT, (size_t)NLAT * D_);
    gemm(stream, NLAT, D_, D_, ALPlain{RWOUT, D_}, w_o, D_, EPResid{XC, MOD1, 2});
    DUMP("xmid1", XC, (size_t)NLAT * D_);
    LAUNCH(true, k_modnorm, NLAT, 256, stream, (const float*)XC, norm2_g + D_, MOD1, 3, 4, U);
    gemm(stream, NLAT, 2048, D_, ALPlain{U, D_}, peer_wq + (size_t)D_ * 2048, 2048, EPStore{PQ, 2048, 0});
    LAUNCH(true, k_peer_topk, NLAT, 256, stream, (const AT*)PQ, peer_k1 + (size_t)8 * 128 * 128, peer_k2 + (size_t)8 * 128 * 128, PIDX, PGATE);
    LAUNCH(true, k_peer_apply, NLAT, 256, stream, (const AT*)U, (const int*)PIDX, (const float*)PGATE, peer_u + PE, peer_v + PE, MOD1, XC);
    LAUNCH(true, k_final, NLAT, 256, stream, (const float*)XC, final_g, (float*)d_out);
}
```

```cpp
#ifndef CPU_EMU
#include <hip/hip_runtime.h>
#define DUMP(name, ptr, count)
#define DUMPD(name, ptr, count)
#endif
#include <stdint.h>
#include <string.h>
#include <stdio.h>

#ifndef CFG_B
#define CFG_B 8
#define CFG_T 2048
#define CFG_L 256
#endif
constexpr int B_ = CFG_B, T_ = CFG_T, L_ = CFG_L, D_ = 1024;
constexpr int NLAT = B_ * T_, NCTX = B_ * L_, NTOK = NLAT + NCTX;
constexpr int PROJW = 2560;
constexpr int C_GQ = 0, C_GK = 256, C_GV = 512, C_GG = 1024, C_LR = 1536, C_SQ = 1568, C_SK = 2080, C_SV = 2208;
constexpr int D6 = 6 * D_;

struct bf16 { unsigned short v; };
#ifdef AT_F32
typedef float AT;
#else
typedef bf16 AT;
#endif
#ifdef CPU_EMU
typedef float DT;
#else
typedef _Float16 DT;
#endif
__device__ __forceinline__ float ldf(const float* p) { return *p; }
__device__ __forceinline__ void stf(float* p, float v) { *p = v; }
__device__ __forceinline__ float ldf(const bf16* p) { unsigned u = (unsigned)p->v << 16; float f; memcpy(&f, &u, 4); return f; }
__device__ __forceinline__ void stf(bf16* p, float f) { unsigned u; memcpy(&u, &f, 4); u = (u + 0x7fffu + ((u >> 16) & 1u)) >> 16; p->v = (unsigned short)u; }
__device__ __forceinline__ float sigmoidf_(float x) { return 1.f / (1.f + expf(-x)); }
#ifdef CPU_EMU
__device__ __forceinline__ float fsig(float x) { return sigmoidf_(x); }
__device__ __forceinline__ float ftanh(float x) { return tanhf(x); }
#else
__device__ __forceinline__ float fsig(float x) { return __builtin_amdgcn_rcpf(1.f + __expf(-x)); }
__device__ __forceinline__ float ftanh(float x) { return 2.f * __builtin_amdgcn_rcpf(1.f + __expf(-2.f * x)) - 1.f; }
#endif

struct TokInfo { int b, pos, len; };
__device__ __forceinline__ TokInfo tokinfo(int m) {
    TokInfo t; if (m < NLAT) { t.b = m / T_; t.pos = m % T_; t.len = T_; } else { int c = m - NLAT; t.b = c / L_; t.pos = c % L_; t.len = L_; } return t; }
__device__ __forceinline__ int tok_row(int m) { return m < NLAT ? m / T_ : B_; }

constexpr size_t al_(size_t x) { return (x + 255) & ~(size_t)255; }
constexpr size_t SA = sizeof(AT), SD = sizeof(DT);
constexpr size_t ROWB = al_((size_t)NTOK * D_ * SA);
constexpr size_t OFF_MOD = 0;
constexpr size_t OFF_XC = al_(OFF_MOD + (size_t)2 * (B_ + 1) * D6 * 4);
constexpr size_t OFF_WB = al_(OFF_XC + (size_t)NTOK * D_ * 4);
constexpr size_t WSZ = (size_t)D_ * D_ * SA;
constexpr size_t OFF_WIN = OFF_WB;
constexpr size_t OFF_WOUT = OFF_WIN + (size_t)PROJW * D_ * SA;
constexpr size_t OFF_WQ0 = OFF_WOUT + WSZ;
constexpr size_t OFF_WQ1 = OFF_WQ0 + 2 * WSZ;
constexpr size_t OFF_WRKV = OFF_WQ1 + 2 * WSZ;
constexpr size_t OFF_WO = OFF_WRKV + 3 * WSZ;
constexpr size_t OFF_WL1 = OFF_WO + WSZ;
constexpr size_t OFF_WL2A = OFF_WL1 + (size_t)512 * 2048 * SA;
constexpr size_t OFF_WL2B = OFF_WL2A + (size_t)4096 * 256 * SA;
constexpr size_t OFF_X = al_(OFF_WL2B + (size_t)1024 * 256 * SA);
constexpr size_t OFF_Y = OFF_X + 6 * ROWB;
constexpr size_t SZ_TAB = (size_t)2 * 16384 * D_ * (SA == 4 ? 4 : 1);
constexpr size_t mx_(size_t a, size_t b) { return a > b ? a : b; }
constexpr size_t SZ_Y = mx_(mx_(al_((size_t)NTOK * PROJW * SA), 3 * ROWB + 2 * al_((size_t)NTOK * 256 * SA)), SZ_TAB);
constexpr size_t OFF_Z = OFF_Y + SZ_Y;
constexpr size_t SZ_Z = mx_(mx_(ROWB, 2 * al_((size_t)NLAT * D_ * SA)), SZ_TAB);
constexpr size_t WS_END = OFF_Z + SZ_Z;
constexpr size_t OFF_U = OFF_X;
constexpr size_t OFF_MIX = OFF_X + ROWB;
constexpr size_t OFF_LOGA = OFF_X + 2 * ROWB;
constexpr size_t OFF_GLAO = OFF_LOGA + al_((size_t)NTOK * 512 * 4);
static_assert(OFF_GLAO + (size_t)2 * NTOK * 512 * 4 <= OFF_Y || SA == 4, "layer-0 view overflows region X");
constexpr size_t OFF_PROJ = OFF_Y;
constexpr size_t OFF_SC = OFF_X + ROWB;
constexpr size_t OFF_PIDX = OFF_X + 5 * ROWB;
constexpr size_t OFF_PGATE = OFF_PIDX + al_((size_t)NTOK * 128 * 4);
static_assert(OFF_SC + (size_t)NTOK * 2048 * 4 <= OFF_PIDX && OFF_PGATE + (size_t)NTOK * 128 * 4 <= OFF_X + 6 * ROWB, "peer view overflows region X");
#ifdef CPU_EMU
constexpr size_t OFF_TAB0 = OFF_Z, OFF_TAB1 = OFF_Y;
constexpr size_t OFF_U1 = OFF_U, OFF_SC1 = OFF_SC;
#else
constexpr size_t OFF_TAB0 = OFF_Z, OFF_TAB1 = OFF_X + 4 * ROWB;
constexpr size_t OFF_U1 = OFF_Y, OFF_SC1 = OFF_X;
static_assert((size_t)2 * 16384 * D_ <= ROWB && (size_t)NLAT * 2048 * 4 <= 4 * ROWB, "layer-1 PEER view");
#endif
constexpr size_t OFF_H = OFF_Z;
constexpr size_t OFF_XS = OFF_X;
constexpr size_t OFF_R = OFF_Y, OFF_K = OFF_Y + ROWB, OFF_V = OFF_Y + 2 * ROWB;
constexpr size_t OFF_T1 = OFF_Y + 3 * ROWB;
constexpr size_t OFF_T2 = OFF_T1 + al_((size_t)NTOK * 256 * SA);
constexpr size_t OFF_HX = OFF_X + 3 * ROWB;
constexpr size_t OFF_DEC = OFF_X;
constexpr size_t OFF_A = OFF_X + 2 * ROWB;
constexpr size_t OFF_KK = OFF_A + 2 * ROWB;
constexpr size_t OFF_G = OFF_KK + ROWB;
constexpr size_t OFF_Y0 = OFF_Z, OFF_Y1 = OFF_Z + al_((size_t)NLAT * D_ * SA);
#ifndef CPU_EMU
static_assert(OFF_G + ROWB <= OFF_Y, "layer-1 view overflows region X");
#endif

constexpr int NT = 512;
#ifdef CPU_EMU
__device__ __forceinline__ unsigned tid_now() { return threadIdx.x; }
#else
constexpr int TID_TAB_OFF = 131072 + 512;
__device__ __forceinline__ unsigned hw_slot() { return (unsigned)__builtin_amdgcn_s_getreg((5 << 11) | 4) & 63u; }
__device__ __forceinline__ unsigned tid_now() {
    extern __shared__ __attribute__((aligned(16))) unsigned char lds_dyn_tid_[];
    const unsigned wv = *(volatile __attribute__((address_space(3))) unsigned*)((__attribute__((address_space(3))) unsigned char*)lds_dyn_tid_ + TID_TAB_OFF + 4 * hw_slot());
    const unsigned lane = __builtin_amdgcn_mbcnt_hi(~0u, __builtin_amdgcn_mbcnt_lo(~0u, 0u));
    return ((unsigned)__builtin_amdgcn_readfirstlane((int)wv) << 6) | lane; }
#endif
#define GSTRIDE(idx, N) for (size_t idx = (size_t)blockIdx.x * NT + tid_now(); idx < (size_t)(N); idx += (size_t)gridDim.x * NT)
#define GSTRIDE_SUB(idx, N, wg0, nwg) for (size_t idx = (size_t)((int)blockIdx.x - (wg0)) * NT + tid_now(); idx < (size_t)(N); idx += (size_t)(nwg) * NT)

#ifndef CPU_EMU
namespace pg8 {
#define PG8_LAS __attribute__((address_space(3)))
typedef unsigned short bf16_t;
typedef short bf16x8 __attribute__((ext_vector_type(8)));
typedef float f32x4 __attribute__((ext_vector_type(4)));
typedef unsigned u32x4 __attribute__((ext_vector_type(4)));
constexpr int BM = 256, BK = 64, HALF = 128, HTB = HALF * BK * 2  , STAGE_BYTES = 8 * HTB, NXCD = 8, WGM = 8;

__host__ __device__ __forceinline__ int lds_byte(int r, int c) { const int st = (r >> 4) * 2 + (c >> 5), rr = r & 15, cc = c & 31, ob = rr * 64 + cc * 2; return st * 1024 + (ob ^ (((ob >> 9) & 1) << 5)); }
__host__ __device__ __forceinline__ void stage_rc(int b, int& R, int& C) { const int st = b / 1024, sb = b % 1024, swz = sb ^ (((sb >> 9) & 1) << 5); R = (st >> 1) * 16 + swz / 64; C = (st & 1) * 32 + (swz % 64) / 2; }
__host__ __device__ __forceinline__ int perm32(int rho) { const int n = rho >> 4, i = rho & 15; return 8 * (i >> 2) + 4 * n + (i & 3); }

struct Unit { int pm, pn; };
struct Gemm { const bf16_t* A; const bf16_t* Bt; int M, N, K; };

struct StaticOrder {
    int nM, nN, nwg, G, c;
    __host__ __device__ void init(int M, int N, int G_, int c_) { nM = M / BM; nN = N / BM; nwg = nM * nN; G = G_; c = c_; }
    __host__ __device__ bool next(int i, Unit& u) const {
        const long L = (long)i * G + c; if (L >= nwg) return false;
        int wgid = (int)L; { const int q = nwg / NXCD, r = nwg % NXCD, xcd = wgid % NXCD, off = wgid / NXCD; wgid = (xcd < r ? xcd * (q + 1) : r * (q + 1) + (xcd - r) * q) + off; }
        const int nig = WGM * nN, gid = wgid / nig, fm = gid * WGM, gsz = (nM - fm) < WGM ? (nM - fm) : WGM;
        u.pm = fm + ((wgid % nig) % gsz); u.pn = (wgid % nig) / gsz; return true;
    }
    __device__ __forceinline__ void a_ready(const Unit&) const {}
    __device__ __forceinline__ void done(const Unit&) const {}
};

__device__ __forceinline__ unsigned cvt_pk_bf16(float lo, float hi) { unsigned r; asm volatile("v_cvt_pk_bf16_f32 %0, %1, %2" : "=v"(r) : "v"(lo), "v"(hi)); return r; }
typedef float f32x2 __attribute__((ext_vector_type(2)));
template <class Epi, class Sched, bool ALIGN_EPI = false, bool SP2 = false>
__device__ __forceinline__ void gemm_phase(PG8_LAS unsigned char* lds, const Gemm g, const Sched& S, const Epi& E) {
    const int tid = (int)tid_now(), wid = __builtin_amdgcn_readfirstlane(tid >> 6), lane = tid & 63, wr = wid >> 2, wc = wid & 3, fr = lane & 15, fq = lane >> 4;
    const int K = g.K, nt = K / BK;
    unsigned voffA[2], voffB[2];
#pragma unroll
    for (int i = 0; i < 2; ++i) { int R, C; stage_rc(tid * 16 + i * 8192, R, C); const int Rb = Epi::PERM ? ((R & ~31) + perm32(R & 31)) : R;
        voffA[i] = (unsigned)(R * K + C) * 2u; voffB[i] = (unsigned)(Rb * K + C) * 2u; }
    const size_t kstep = (size_t)(BK * 2);
    const size_t hstep = (size_t)HALF * K * 2;
    const size_t tstep = 2 * hstep;
    const unsigned ldsw = (unsigned)wid * 1024u;
    const int aoff = lds_byte(wr * 64 + fr, fq * 8), boff = lds_byte(wc * 32 + fr, fq * 8);
#define PG8_SA(b, h) (((b) * 2 + (h)) * HTB)
#define PG8_SB(b, h) ((4 + (b) * 2 + (h)) * HTB)
#define PG8_STAGE(bufoff, gbase, voff) do { _Pragma("unroll") for (int _i = 0; _i < 2; ++_i) \
        __builtin_amdgcn_global_load_lds((const unsigned*)((const char*)(gbase) + (voff)[_i]), (PG8_LAS unsigned*)(lds + (bufoff) + ldsw + _i * 8192), 16, 0, 0); } while (0)
#define PG8_LDA(dst, b, h) do { _Pragma("unroll") for (int m = 0; m < 4; ++m) _Pragma("unroll") for (int k = 0; k < 2; ++k) dst[m][k] = *(const PG8_LAS bf16x8*)(lds + PG8_SA(b, h) + aoff + m * 2048 + k * 1024); } while (0)
#define PG8_LDB(dst, b, h) do { _Pragma("unroll") for (int n = 0; n < 2; ++n) _Pragma("unroll") for (int k = 0; k < 2; ++k) dst[n][k] = *(const PG8_LAS bf16x8*)(lds + PG8_SB(b, h) + boff + n * 2048 + k * 1024); } while (0)
#define PG8_MMA(ai, bj, At, Bt) do { __builtin_amdgcn_s_setprio(1); _Pragma("unroll") for (int m = 0; m < 4; ++m) _Pragma("unroll") for (int n = 0; n < 2; ++n) _Pragma("unroll") for (int k = 0; k < 2; ++k) \
        acc[ai][bj][m][n] = __builtin_amdgcn_mfma_f32_16x16x32_bf16(Bt[n][k], At[m][k], acc[ai][bj][m][n], 0, 0, 0); __builtin_amdgcn_s_setprio(0); } while (0)
#define PG8_WAIT_V(n) asm volatile("s_waitcnt vmcnt(" #n ")" ::: "memory")
#define PG8_WAIT_L(n) asm volatile("s_waitcnt lgkmcnt(" #n ")" ::: "memory")
#define PG8_BAR __builtin_amdgcn_s_barrier()
#define PG8_SCHED __builtin_amdgcn_sched_barrier(0)
    Unit cur, nxt; int ui = 0;
    if (!S.next(0, cur)) return;
    f32x4 acc[2][2][4][2];
#pragma unroll
    for (int a = 0; a < 2; ++a)
#pragma unroll
        for (int b = 0; b < 2; ++b)
#pragma unroll
            for (int m = 0; m < 4; ++m)
#pragma unroll
                for (int n = 0; n < 2; ++n) acc[a][b][m][n] = (f32x4){0.f, 0.f, 0.f, 0.f};
    bf16x8 At[4][2], B0[2][2], B1[2][2];
    const char* cA = (const char*)g.A + (size_t)cur.pm * tstep; const char* cB = (const char*)g.Bt + (size_t)cur.pn * tstep;
    S.a_ready(cur);
    if constexpr (SP2) {
        PG8_STAGE(PG8_SB(0, 0), cB, voffB); PG8_STAGE(PG8_SB(0, 1), cB + hstep, voffB); PG8_STAGE(PG8_SA(0, 0), cA, voffA); PG8_STAGE(PG8_SA(0, 1), cA + hstep, voffA);
        if (wr == 1) PG8_BAR;
        PG8_WAIT_V(2); PG8_BAR;
        PG8_STAGE(PG8_SB(1, 0), cB + kstep, voffB); PG8_STAGE(PG8_SA(1, 0), cA + kstep, voffA); PG8_STAGE(PG8_SB(1, 1), cB + hstep + kstep, voffB);
        PG8_WAIT_V(6); PG8_BAR;
    } else {
        PG8_STAGE(PG8_SB(0, 0), cB, voffB); PG8_STAGE(PG8_SA(0, 0), cA, voffA); PG8_STAGE(PG8_SB(0, 1), cB + hstep, voffB); PG8_STAGE(PG8_SA(0, 1), cA + hstep, voffA);
        if (wr == 1) PG8_BAR;
        PG8_WAIT_V(4); PG8_BAR;
        PG8_STAGE(PG8_SB(1, 0), cB + kstep, voffB); PG8_STAGE(PG8_SA(1, 0), cA + kstep, voffA); PG8_STAGE(PG8_SB(1, 1), cB + hstep + kstep, voffB);
        PG8_WAIT_V(6); PG8_BAR;
    }
    for (;;) {
        const bool has_next = S.next(ui + 1, nxt);
        const char* nA = has_next ? (const char*)g.A + (size_t)nxt.pm * tstep : cA; const char* nB = has_next ? (const char*)g.Bt + (size_t)nxt.pn * tstep : cB;
        for (int t = 0; t < nt; t += 2) {
            const bool last = (t == nt - 2);
            const char* a1 = cA + (size_t)(t + 1) * kstep;
            const char* a2 = last ? nA : cA + (size_t)(t + 2) * kstep; const char* b2 = last ? nB : cB + (size_t)(t + 2) * kstep;
            const char* a3 = a2 + kstep; const char* b3 = b2 + kstep;
            if (last && has_next) S.a_ready(nxt);
            if constexpr (SP2) {
            PG8_LDB(B0, 0, 0); PG8_LDB(B1, 0, 1); PG8_SCHED; PG8_LDA(At, 0, 0); PG8_STAGE(PG8_SA(1, 1), a1 + hstep, voffA);
            PG8_WAIT_V(8); PG8_WAIT_L(0); PG8_BAR; PG8_MMA(0, 0, At, B0); PG8_MMA(0, 1, At, B1); PG8_BAR; PG8_SCHED;
            PG8_LDA(At, 0, 1); PG8_STAGE(PG8_SB(0, 0), b2, voffB); PG8_STAGE(PG8_SB(0, 1), b2 + hstep, voffB); PG8_STAGE(PG8_SA(0, 0), a2, voffA);
            PG8_WAIT_V(8); PG8_WAIT_L(0); PG8_BAR; PG8_MMA(1, 0, At, B0); PG8_MMA(1, 1, At, B1); PG8_BAR; PG8_SCHED;
            PG8_LDB(B0, 1, 0); PG8_LDB(B1, 1, 1); PG8_SCHED; PG8_LDA(At, 1, 0); PG8_STAGE(PG8_SA(0, 1), a2 + hstep, voffA);
            PG8_WAIT_V(8); PG8_WAIT_L(0); PG8_BAR; PG8_MMA(0, 0, At, B0); PG8_MMA(0, 1, At, B1); PG8_BAR; PG8_SCHED;
            PG8_LDA(At, 1, 1); PG8_STAGE(PG8_SB(1, 0), b3, voffB); PG8_STAGE(PG8_SB(1, 1), b3 + hstep, voffB); PG8_STAGE(PG8_SA(1, 0), a3, voffA);
            PG8_WAIT_V(8); PG8_WAIT_L(0); PG8_BAR; PG8_MMA(1, 0, At, B0); PG8_MMA(1, 1, At, B1); PG8_BAR; PG8_SCHED;
            } else {
            PG8_LDB(B0, 0, 0); PG8_SCHED; PG8_LDA(At, 0, 0); PG8_STAGE(PG8_SA(1, 1), a1 + hstep, voffA);
            PG8_WAIT_L(8); PG8_BAR; PG8_WAIT_L(0); PG8_MMA(0, 0, At, B0); PG8_BAR; PG8_SCHED;
            PG8_LDB(B1, 0, 1); PG8_STAGE(PG8_SB(0, 0), b2, voffB);
            PG8_BAR; PG8_WAIT_L(0); PG8_MMA(0, 1, At, B1); PG8_BAR;
            PG8_LDA(At, 0, 1); PG8_STAGE(PG8_SA(0, 0), a2, voffA);
            PG8_BAR; PG8_WAIT_L(0); PG8_MMA(1, 0, At, B0); PG8_BAR; PG8_SCHED;
            PG8_STAGE(PG8_SB(0, 1), b2 + hstep, voffB);
            PG8_WAIT_V(6); PG8_BAR; PG8_MMA(1, 1, At, B1); PG8_BAR;
            PG8_LDB(B0, 1, 0); PG8_SCHED; PG8_LDA(At, 1, 0); PG8_STAGE(PG8_SA(0, 1), a2 + hstep, voffA);
            PG8_WAIT_L(8); PG8_BAR; PG8_WAIT_L(0); PG8_MMA(0, 0, At, B0); PG8_BAR; PG8_SCHED;
            PG8_LDB(B1, 1, 1); PG8_STAGE(PG8_SB(1, 0), b3, voffB);
            PG8_BAR; PG8_WAIT_L(0); PG8_MMA(0, 1, At, B1); PG8_BAR;
            PG8_LDA(At, 1, 1); PG8_STAGE(PG8_SA(1, 0), a3, voffA);
            PG8_BAR; PG8_WAIT_L(0); PG8_MMA(1, 0, At, B0); PG8_BAR; PG8_SCHED;
            PG8_STAGE(PG8_SB(1, 1), b3 + hstep, voffB);
            PG8_WAIT_V(6); PG8_BAR; PG8_MMA(1, 1, At, B1); PG8_BAR;
            }
        }
        if constexpr (ALIGN_EPI) { if (wr == 0) PG8_BAR; }
        if constexpr (!Epi::AFTER_DRAIN) { E(acc, cur, wr, wc, fr, fq); S.done(cur); }
        if (!has_next) break;
#pragma unroll
        for (int a = 0; a < 2; ++a)
#pragma unroll
            for (int b = 0; b < 2; ++b)
#pragma unroll
                for (int m = 0; m < 4; ++m)
#pragma unroll
                    for (int n = 0; n < 2; ++n) acc[a][b][m][n] = (f32x4){0.f, 0.f, 0.f, 0.f};
        cur = nxt; cA = nA; cB = nB; ++ui;
        if constexpr (ALIGN_EPI) { if (wr == 1) PG8_BAR; }
    }
    PG8_WAIT_V(0);
    if constexpr (!ALIGN_EPI) { if (wr == 0) PG8_BAR; }
    PG8_BAR;
    if constexpr (Epi::AFTER_DRAIN) { E.fused(acc, cur, wr, wc, fr, fq, lds, wid, lane); S.done(cur); }
#undef PG8_SA
#undef PG8_SB
#undef PG8_STAGE
#undef PG8_LDA
#undef PG8_LDB
#undef PG8_MMA
#undef PG8_WAIT_V
#undef PG8_WAIT_L
#undef PG8_BAR
#undef PG8_SCHED
}
}

#define PG8_SP2 true
#define PG8_ALIGN true
#endif
struct EpiStore16 {
    static constexpr bool PERM = true, AFTER_DRAIN = false; AT* O; int ldc;
#ifndef CPU_EMU
    __device__ __forceinline__ void operator()(const pg8::f32x4 (&acc)[2][2][4][2], const pg8::Unit& u, int wr, int wc, int fr, int fq) const {
        const int row0 = u.pm * 256 + wr * 64 + fr, col0 = u.pn * 256 + wc * 32 + 8 * fq;
#pragma unroll
        for (int ai = 0; ai < 2; ++ai)
#pragma unroll
            for (int m = 0; m < 4; ++m) { pg8::bf16_t* rowp = (pg8::bf16_t*)O + (size_t)(row0 + ai * 128 + m * 16) * ldc + col0;
#pragma unroll
                for (int bj = 0; bj < 2; ++bj) { const pg8::f32x4 v0 = acc[ai][bj][m][0], v1 = acc[ai][bj][m][1]; pg8::u32x4 w;
                    w.x = pg8::cvt_pk_bf16(v0[0], v0[1]); w.y = pg8::cvt_pk_bf16(v0[2], v0[3]); w.z = pg8::cvt_pk_bf16(v1[0], v1[1]); w.w = pg8::cvt_pk_bf16(v1[2], v1[3]);
                    *(pg8::u32x4*)(rowp + bj * 128) = w; } }
    }
#endif
    __device__ __forceinline__ void elem(int m, int n, float v) const { stf(O + (size_t)m * ldc + n, v); }
};
typedef unsigned eu2_t __attribute__((ext_vector_type(2)));
struct EpiResid {
    static constexpr bool PERM = false, AFTER_DRAIN = false; float* XC; const float* gate; const float* xsrc; const float* csrc;
    __device__ __forceinline__ const float* srow(int r) const { return xsrc ? (r < NLAT ? xsrc + (size_t)r * D_ : csrc + (size_t)(r - NLAT) * D_) : XC + (size_t)r * D_; }
#ifndef CPU_EMU
    __device__ __forceinline__ void operator()(const pg8::f32x4 (&acc)[2][2][4][2], const pg8::Unit& u, int wr, int wc, int fr, int fq) const {
        const int row0 = u.pm * 256 + wr * 64 + fr, col0 = u.pn * 256 + wc * 32 + 4 * fq;
#pragma unroll
        for (int ai = 0; ai < 2; ++ai)
#pragma unroll
            for (int m = 0; m < 4; ++m) { const int r = row0 + ai * 128 + m * 16; const float* gr = gate + (size_t)tok_row(r) * D6 + col0; unsigned short* xh = (unsigned short*)XC + (size_t)r * D_ + col0;
                const float* sr = xsrc ? srow(r) + col0 : nullptr;
#pragma unroll
                for (int bj = 0; bj < 2; ++bj)
#pragma unroll
                    for (int n = 0; n < 2; ++n) { const int off = bj * 128 + n * 16; const pg8::f32x4 gv = *(const pg8::f32x4*)(gr + off); pg8::f32x4 sv;
                        if (xsrc) sv = *(const pg8::f32x4*)(sr + off);
                        else { const eu2_t q = *(const eu2_t*)(xh + off); sv[0] = __uint_as_float(q.x << 16); sv[1] = __uint_as_float(q.x & 0xffff0000u); sv[2] = __uint_as_float(q.y << 16); sv[3] = __uint_as_float(q.y & 0xffff0000u); }
                        const pg8::f32x4 rv = sv + gv * acc[ai][bj][m][n]; eu2_t w; w.x = pg8::cvt_pk_bf16(rv[0], rv[1]); w.y = pg8::cvt_pk_bf16(rv[2], rv[3]); *(eu2_t*)(xh + off) = w; }
                __builtin_amdgcn_sched_barrier(0); }
    }
#endif
    __device__ __forceinline__ void elem(int m, int n, float v) const { XC[(size_t)m * D_ + n] = srow(m)[n] + gate[(size_t)tok_row(m) * D6 + n] * v; }
};
template <class Epi>
__device__ __forceinline__ void run_gemm(unsigned char* lds, const AT* A, const AT* Bt, int M, int N, int K, const Epi& E, int coff = 0) {
#ifdef CPU_EMU
    GSTRIDE(idx, (size_t)M * N) { int m = (int)(idx / N), n = (int)(idx % N); float acc = 0.f;
        for (int k = 0; k < K; ++k) acc += ldf(A + (size_t)m * K + k) * ldf(Bt + (size_t)n * K + k);
        E.elem(m, n, acc); }
#else
    pg8::Gemm g{(const pg8::bf16_t*)A, (const pg8::bf16_t*)Bt, M, N, K}; pg8::StaticOrder S; S.init(M, N, (int)gridDim.x, (int)((blockIdx.x + (unsigned)coff) % gridDim.x));
    pg8::gemm_phase<Epi, pg8::StaticOrder, PG8_ALIGN, PG8_SP2>((PG8_LAS unsigned char*)lds, g, S, E);
#endif
}

struct EpiStoreF32 {
    static constexpr bool PERM = false, AFTER_DRAIN = false; float* O; int ldc;
#ifndef CPU_EMU
    __device__ __forceinline__ void operator()(const pg8::f32x4 (&acc)[2][2][4][2], const pg8::Unit& u, int wr, int wc, int fr, int fq) const {
        const int row0 = u.pm * 256 + wr * 64 + fr, col0 = u.pn * 256 + wc * 32 + 4 * fq;
#pragma unroll
        for (int ai = 0; ai < 2; ++ai)
#pragma unroll
            for (int m = 0; m < 4; ++m) { float* rp = O + (size_t)(row0 + ai * 128 + m * 16) * ldc + col0;
#pragma unroll
                for (int bj = 0; bj < 2; ++bj)
#pragma unroll
                    for (int n = 0; n < 2; ++n) *(pg8::f32x4*)(rp + bj * 128 + n * 16) = acc[ai][bj][m][n]; }
    }
#endif
    __device__ __forceinline__ void elem(int m, int n, float v) const { O[(size_t)m * ldc + n] = v; }
};
__device__ __forceinline__ void ph_wc(const float* Wq, const float* k1, const float* k2, AT* WcT) {
    GSTRIDE(idx, (size_t)2048 * D_) { const int gn = (int)(idx / D_), kin = (int)(idx % D_); const int g = gn >> 7, n = gn & 127, h = g >> 1, side = g & 1;
        const float* key = (side ? k2 : k1) + ((size_t)h * 128 + n) * 128; const float* wq = Wq + (size_t)kin * 2048 + g * 128;
        float acc = 0.f; for (int d = 0; d < 128; ++d) acc += key[d] * wq[d];
        stf(WcT + idx, acc); }
}
#ifdef CPU_EMU
typedef float TT;
__device__ __forceinline__ float e4m3_round(float x) { if (x == 0.f) return 0.f; float a = fabsf(x); if (a > 448.f) a = 448.f; int e; frexpf(a, &e); int ex = e - 1; if (ex < -6) ex = -6;
    const float q = ldexpf(1.f, ex - 3); float r = nearbyintf(a / q) * q; return x < 0.f ? -r : r; }
#else
typedef unsigned char TT;
#endif
__device__ __forceinline__ void ph_cvt_tab(const float* src, TT* dst, size_t n, float scale, int wg0 = 0, int nwg = 0) {
#ifdef CPU_EMU
    GSTRIDE(i, n) dst[i] = e4m3_round(src[i] * scale);
#else
    if (nwg == 0) nwg = (int)gridDim.x;
    GSTRIDE_SUB(i, n / 16, wg0, nwg) { const float* sp = src + i * 16; pg8::u32x4 w; unsigned ww[4];
#pragma unroll
        for (int j = 0; j < 4; ++j) { const pg8::f32x4 a = *(const pg8::f32x4*)(sp + 4 * j); int pk = 0;
            pk = __builtin_amdgcn_cvt_pk_fp8_f32(a[0] * scale, a[1] * scale, pk, false); pk = __builtin_amdgcn_cvt_pk_fp8_f32(a[2] * scale, a[3] * scale, pk, true); ww[j] = (unsigned)pk; }
        w.x = ww[0]; w.y = ww[1]; w.z = ww[2]; w.w = ww[3];
        *(pg8::u32x4*)(dst + i * 16) = w; }
#endif
}
struct EpiLora1 {
    static constexpr bool PERM = true, AFTER_DRAIN = false; AT* T1; AT* T2;
    __device__ __forceinline__ static float act(int n, float v) { return n < 128 ? ftanh(v) : (n < 256 ? v : (n < 416 ? fsig(v) : 0.f)); }
#ifndef CPU_EMU
    __device__ __forceinline__ void operator()(const pg8::f32x4 (&acc)[2][2][4][2], const pg8::Unit& u, int wr, int wc, int fr, int fq) const {
        const int row0 = u.pm * 256 + wr * 64 + fr, col0 = wc * 32 + 8 * fq; pg8::bf16_t* O = (pg8::bf16_t*)(u.pn == 0 ? T1 : T2);
#pragma unroll
        for (int ai = 0; ai < 2; ++ai)
#pragma unroll
            for (int m = 0; m < 4; ++m) { pg8::bf16_t* rowp = O + (size_t)(row0 + ai * 128 + m * 16) * 256 + col0;
#pragma unroll
                for (int bj = 0; bj < 2; ++bj) { const int n0 = u.pn * 256 + col0 + bj * 128; const pg8::f32x4 v0 = acc[ai][bj][m][0], v1 = acc[ai][bj][m][1]; pg8::u32x4 w;
                    w.x = pg8::cvt_pk_bf16(act(n0, v0[0]), act(n0 + 1, v0[1])); w.y = pg8::cvt_pk_bf16(act(n0 + 2, v0[2]), act(n0 + 3, v0[3]));
                    w.z = pg8::cvt_pk_bf16(act(n0 + 4, v1[0]), act(n0 + 5, v1[1])); w.w = pg8::cvt_pk_bf16(act(n0 + 6, v1[2]), act(n0 + 7, v1[3]));
                    *(pg8::u32x4*)(rowp + bj * 128) = w; } }
    }
#endif
    __device__ __forceinline__ void elem(int m, int n, float v) const { if (n < 256) stf(T1 + (size_t)m * 256 + n, act(n, v)); else stf(T2 + (size_t)m * 256 + n - 256, act(n, v)); }
};
__device__ __forceinline__ float decay_of(float lw) { return expf(-0.6065306597f * sigmoidf_(lw)); }
__device__ __forceinline__ void ph_wlora(const float* mu, const float* w1, const float* a1, const float* g1, const float* w2, const float* a2, const float* g2, AT* WL1, AT* WL2A, AT* WL2B, int wg0, int nwg) {
    GSTRIDE_SUB(idx, (size_t)512 * 2048, wg0, nwg) { const int j = (int)(idx >> 11), kk = (int)(idx & 2047), kin = kk & 1023; float w = 0.f, m_ = 0.f;
        if (j < 128) { const int z = j >> 6, c = j & 63; w = w1[((size_t)z * 1024 + kin) * 64 + c]; m_ = mu[1 * D_ + kin]; }
        else if (j < 256) { const int z = (j - 128) >> 6, c = (j - 128) & 63; w = a1[((size_t)z * 1024 + kin) * 64 + c]; m_ = mu[4 * D_ + kin]; }
        else if (j < 416) { w = g1[(size_t)kin * 160 + (j - 256)]; m_ = mu[5 * D_ + kin]; }
        stf(WL1 + idx, kk >= 1024 ? w * m_ : w); }
    GSTRIDE_SUB(idx, (size_t)4096 * 256, wg0, nwg) { const int n4 = (int)(idx >> 8), k = (int)(idx & 255); const int which = n4 >> 10, c = n4 & 1023, z = which & 1; float w = 0.f;
        const int kb = (which < 2 ? 0 : 128) + z * 64;
        if (k >= kb && k < kb + 64) w = (which < 2 ? w2 : a2)[((size_t)z * 64 + (k - kb)) * 1024 + c];
        stf(WL2A + idx, w); }
    GSTRIDE_SUB(idx, (size_t)1024 * 256, wg0, nwg) { const int c = (int)(idx >> 8), k = (int)(idx & 255); stf(WL2B + idx, k < 160 ? g2[(size_t)k * 1024 + c] : 0.f); }
}

__device__ __forceinline__ void cvt_tab16(const float* src, TT* dst, size_t i, float scale) {
#ifndef CPU_EMU
    const float* sp = src + i * 16; pg8::u32x4 w; unsigned ww[4];
#pragma unroll
    for (int j = 0; j < 4; ++j) { const pg8::f32x4 a = *(const pg8::f32x4*)(sp + 4 * j); int pk = 0;
        pk = __builtin_amdgcn_cvt_pk_fp8_f32(a[0] * scale, a[1] * scale, pk, false); pk = __builtin_amdgcn_cvt_pk_fp8_f32(a[2] * scale, a[3] * scale, pk, true); ww[j] = (unsigned)pk; }
    w.x = ww[0]; w.y = ww[1]; w.z = ww[2]; w.w = ww[3];
    *(pg8::u32x4*)(dst + i * 16) = w;
#endif
}

#ifndef CPU_EMU
__device__ __forceinline__ float wave_maxf(float v) {
#pragma unroll
    for (int o = 32; o > 0; o >>= 1) v = fmaxf(v, __shfl_xor(v, o));
    return v; }
__device__ __forceinline__ unsigned q8pack(float a, float b, float c, float d, float inv) {
    const unsigned ia = __float_as_uint(a * inv + 12582912.f), ib = __float_as_uint(b * inv + 12582912.f), ic = __float_as_uint(c * inv + 12582912.f), id = __float_as_uint(d * inv + 12582912.f);
    return (ia & 255u) | ((ib & 255u) << 8) | ((ic & 255u) << 16) | (id << 24); }
__device__ __forceinline__ void cvt_row_i8(const float* src, unsigned char* dst, float* usc, size_t row, int lane) {
    const float* sp = src + row * D_ + 16 * lane; pg8::f32x4 a[4]; float mx = 0.f;
#pragma unroll
    for (int j = 0; j < 4; ++j) { a[j] = *(const pg8::f32x4*)(sp + 4 * j); mx = fmaxf(mx, fmaxf(fmaxf(fabsf(a[j][0]), fabsf(a[j][1])), fmaxf(fabsf(a[j][2]), fabsf(a[j][3])))); }
    mx = wave_maxf(mx); const float inv = mx > 0.f ? 127.f / mx : 0.f; pg8::u32x4 w;
    w.x = q8pack(a[0][0], a[0][1], a[0][2], a[0][3], inv); w.y = q8pack(a[1][0], a[1][1], a[1][2], a[1][3], inv); w.z = q8pack(a[2][0], a[2][1], a[2][2], a[2][3], inv); w.w = q8pack(a[3][0], a[3][1], a[3][2], a[3][3], inv);
    *(pg8::u32x4*)(dst + row * D_ + 16 * lane) = w; if (lane == 0) usc[row] = mx * (1.f / 127.f); }
__device__ __forceinline__ void ph_cvt_tab_i8(const float* src, unsigned char* dst, float* usc, int wg0 = 0, int nwg = 0) {
    if (nwg == 0) nwg = (int)gridDim.x;
    const int tn_ = (int)tid_now(), lane = tn_ & 63, gw = ((int)blockIdx.x - wg0) * 8 + (tn_ >> 6), nw = nwg * 8;
    for (int row = gw; row < 16384; row += nw) cvt_row_i8(src, dst, usc, (size_t)row, lane); }
#endif
__device__ __forceinline__ void ph_wprep(const float* W, int K, int N, int Npad, AT* WT) {
    GSTRIDE(idx, (size_t)Npad * K) { int n = (int)(idx / K), k = (int)(idx % K); stf(WT + idx, n < N ? W[(size_t)k * N + n] : 0.f); }
}
__device__ __forceinline__ void ph_xs(const AT* H, const float* mu, AT* XS, AT* HX) {
    GSTRIDE(idx, (size_t)NTOK * D_) { int m = (int)(idx / D_), k = (int)(idx % D_);
        TokInfo ti = tokinfo(m); float cur = ldf(H + idx);
        float prev = ti.pos > 0 ? ldf(H + idx - D_) : 0.f, nxt = ti.pos < ti.len - 1 ? ldf(H + idx + D_) : 0.f;
        float xx = 0.5f * (prev + nxt) - cur;
        stf(HX + (size_t)m * 2048 + k, cur); stf(HX + (size_t)m * 2048 + 1024 + k, xx);
        stf(XS + idx, cur + xx * mu[0 * D_ + k]); stf(XS + (ROWB / SA) + idx, cur + xx * mu[2 * D_ + k]); stf(XS + 2 * (ROWB / SA) + idx, cur + xx * mu[3 * D_ + k]); }
}

__device__ __forceinline__ void ph_adaln(const float* c, const float* c_ctx, const float* ada_w, const float* ada_b, float* MOD) {
    GSTRIDE(i_, 2 * (B_ + 1) * D6) { int idx = (int)i_;
        int col = idx % D6, row = (idx / D6) % (B_ + 1), layer = idx / (D6 * (B_ + 1));
        const float* cv = row < B_ ? c + row * D_ : c_ctx;
        const float* w = ada_w + (size_t)layer * D_ * D6;
        float acc = ada_b[layer * D6 + col];
        for (int k = 0; k < D_; ++k) { float x = cv[k]; acc += x * sigmoidf_(x) * w[(size_t)k * D6 + col]; }
        MOD[idx] = acc; }
}
__device__ __forceinline__ void ph_init_xc(const float* x, const float* ctx, float* XC) {
    GSTRIDE(idx, (size_t)NTOK * D_) XC[idx] = idx < (size_t)NLAT * D_ ? x[idx] : ctx[idx - (size_t)NLAT * D_];
}
__device__ __forceinline__ void ph_modnorm(float* lds, int ntok, const float* XC, const float* g, const float* MODL, int ishift, int iscale, AT* out, float* fout, const float* xsrc = nullptr, const float* csrc = nullptr) {
    const int half = threadIdx.x >> 8, tid = threadIdx.x & 255; float* red = lds + half * 256;
    const int stride = gridDim.x * 2, iters = (ntok + stride - 1) / stride;
    for (int it = 0; it < iters; ++it) {
        const int m = it * stride + blockIdx.x * 2 + half; const bool act = m < ntok;
        float v[4] = {0.f, 0.f, 0.f, 0.f}, ss = 0.f;
        if (act) { const float* xr = xsrc ? (m < NLAT ? xsrc + (size_t)m * D_ : csrc + (size_t)(m - NLAT) * D_) : XC + (size_t)m * D_;
#pragma unroll
            for (int i = 0; i < 4; ++i) { v[i] = xr[tid + 256 * i]; ss += v[i] * v[i]; } }
        __syncthreads();
        red[tid] = ss; __syncthreads();
        float tot = 0.f; for (int i = 0; i < 256; ++i) tot += red[i];
        float rs = rsqrtf(tot / D_ + 1e-6f);
        if (act) {
            if (fout) {
#pragma unroll
                for (int i = 0; i < 4; ++i) { int d = tid + 256 * i; fout[(size_t)m * D_ + d] = v[i] * rs * g[d]; }
            } else { const float* mr = MODL + (size_t)tok_row(m) * D6;
#pragma unroll
                for (int i = 0; i < 4; ++i) { int d = tid + 256 * i; float y = v[i] * rs * g[d] * (1.f + mr[iscale * D_ + d]) + mr[ishift * D_ + d]; stf(out + (size_t)m * D_ + d, y); } }
        }
    }
}

struct ALPlain { const AT* p; int lda; __device__ __forceinline__ float operator()(int m, int k) const { return ldf(p + (size_t)m * lda + k); } };
struct ALMix { const AT* h; const float* mu;
    __device__ __forceinline__ float operator()(int m, int k) const {
        TokInfo ti = tokinfo(m); float cur = ldf(h + (size_t)m * D_ + k);
        float prev = ti.pos > 0 ? ldf(h + (size_t)(m - 1) * D_ + k) : 0.f;
        float nxt = ti.pos < ti.len - 1 ? ldf(h + (size_t)(m + 1) * D_ + k) : 0.f;
        return cur + (0.5f * (prev + nxt) - cur) * mu[k]; } };
struct EPStore { AT* o; int ldo; int act;
    __device__ __forceinline__ void operator()(int m, int n, float a) const { if (act == 1) a = tanhf(a); if (act == 2) a = sigmoidf_(a); stf(o + (size_t)m * ldo + n, a); } };
struct EPResid { float* XC; const float* MODL; int igate;
    __device__ __forceinline__ void operator()(int m, int n, float a) const { XC[(size_t)m * D_ + n] += MODL[(size_t)tok_row(m) * D6 + igate * D_ + n] * a; } };
struct EPDecay { DT* o; const float* w0z; int z;
    __device__ __forceinline__ void operator()(int m, int n, float a) const { float lw = w0z[n] + a; o[((size_t)m * 2 + z) * D_ + n] = (DT)expf(-0.6065306597f * sigmoidf_(lw)); } };
struct EPAgate { AT* o; const float* a0z; int z;
    __device__ __forceinline__ void operator()(int m, int n, float a) const { stf(o + ((size_t)m * 2 + z) * D_ + n, sigmoidf_(a0z[n] + a)); } };

template <class AL, class EP>
__device__ __forceinline__ void ph_gemm(int M, int N, int K, AL al, const float* Bm, int ldb, EP ep) {
    const int n4 = N / 4;
    GSTRIDE(idx, (size_t)(M / 4) * n4) {
        int m0 = (int)(idx / n4) * 4, n0 = (int)(idx % n4) * 4;
        float acc[4][4];
#pragma unroll
        for (int i = 0; i < 4; ++i)
#pragma unroll
            for (int j = 0; j < 4; ++j) acc[i][j] = 0.f;
        for (int k = 0; k < K; ++k) {
            float a[4], b[4];
#pragma unroll
            for (int i = 0; i < 4; ++i) a[i] = al(m0 + i, k);
#pragma unroll
            for (int j = 0; j < 4; ++j) b[j] = Bm[(size_t)k * ldb + n0 + j];
#pragma unroll
            for (int i = 0; i < 4; ++i)
#pragma unroll
                for (int j = 0; j < 4; ++j) acc[i][j] += a[i] * b[j];
        }
#pragma unroll
        for (int i = 0; i < 4; ++i)
#pragma unroll
            for (int j = 0; j < 4; ++j) ep(m0 + i, n0 + j, acc[i][j]);
    }
}

__device__ __forceinline__ void ph_rope(AT* PROJ) {
    GSTRIDE(idx, (size_t)NLAT * 320) {
        int f = idx % 32, hd = (idx / 32) % 10; int m = (int)(idx / 320);
        int t = m % T_; int axis = f / 16, fr = f % 16;
        float pos = axis == 0 ? (float)(t / 64) : (float)(t % 64);
        float inv = expf(-(float)fr * (9.210340371976184f / 16.f));
        float ang = pos * inv, cs = cosf(ang), sn = sinf(ang);
        AT* p = PROJ + (size_t)m * PROJW + (hd < 8 ? C_SQ + hd * 64 : C_SK + (hd - 8) * 64) + axis * 32 + fr;
        float a = ldf(p), b = ldf(p + 16);
        stf(p, a * cs - b * sn); stf(p + 16, b * cs + a * sn); }
}
__device__ __forceinline__ void ph_gla_loga(const AT* PROJ, const float* dec_w2, const float* dec_b, float* LOGA) {
    GSTRIDE(idx, (size_t)NTOK * 512) {
        int e = idx % 256, z = (idx / 256) % 2; int m = (int)(idx / 512);
        float acc = dec_b[z * 256 + e];
        for (int r = 0; r < 16; ++r) acc += ldf(PROJ + (size_t)m * PROJW + C_LR + z * 16 + r) * dec_w2[(z * 16 + r) * 256 + e];
        float ls = fminf(acc, 0.f) - log1pf(expf(-fabsf(acc)));
        LOGA[idx] = ls * (1.f / 16.f); }
}
__device__ __forceinline__ int scan_token(int b, int z, int step) {
    if (step < L_) { int p = z == 0 ? step : L_ - 1 - step; return NLAT + b * L_ + p; }
    int s2 = step - L_; int p = z == 0 ? s2 : T_ - 1 - s2; return b * T_ + p;
}
constexpr int GLA_THREADS = B_ * 4 * 2 * 128;
__device__ __forceinline__ void ph_gla_scan(const AT* PROJ, const float* LOGA, float* GLAO) {
    GSTRIDE(i_, GLA_THREADS) { int idx = (int)i_;
        int vv = idx % 128, z = (idx / 128) % 2, h = (idx / 256) % 4, b = idx / 1024;
        float S[64];
#pragma unroll
        for (int d = 0; d < 64; ++d) S[d] = 0.f;
        for (int step = 0; step < L_ + T_; ++step) {
            int m = scan_token(b, z, step);
            const AT* pr = PROJ + (size_t)m * PROJW; const float* la = LOGA + ((size_t)m * 2 + z) * 256 + h * 64;
            float vval = ldf(pr + C_GV + h * 128 + vv), o = 0.f;
#pragma unroll
            for (int d = 0; d < 64; ++d) {
                float a = expf(la[d]); float q = ldf(pr + C_GQ + h * 64 + d) * 0.125f, k = ldf(pr + C_GK + h * 64 + d);
                float s = S[d] * a; if (z == 1) o += q * s; s += k * vval; if (z == 0) o += q * s; S[d] = s;
            }
            GLAO[((size_t)z * NTOK + m) * 512 + h * 128 + vv] = o;
        } }
}
__device__ __forceinline__ void ph_gla_out(const AT* PROJ, const float* GLAO, const float* gn, AT* MIX) {
    GSTRIDE(i_, NTOK * 4) { int idx = (int)i_;
        int h = idx % 4, m = idx / 4;
        const float* o0 = GLAO + (size_t)m * 512 + h * 128; const float* o1 = GLAO + ((size_t)NTOK + m) * 512 + h * 128;
        float ss = 0.f; for (int v = 0; v < 128; ++v) { float o = o0[v] + o1[v]; ss += o * o; }
        float rs = rsqrtf(ss / 128.f + 1e-6f);
        for (int v = 0; v < 128; ++v) { float o = o0[v] + o1[v]; float gt = ldf(PROJ + (size_t)m * PROJW + C_GG + h * 128 + v);
            stf(MIX + (size_t)m * D_ + h * 128 + v, o * rs * gn[h * 128 + v] * gt * sigmoidf_(gt)); } }
}
__device__ __forceinline__ void ph_swa(const AT* PROJ, const float* sink, AT* MIX, int skip) {
    const size_t gt = (size_t)blockIdx.x * NT + threadIdx.x, gs = (size_t)gridDim.x * NT;
    if (gt < (size_t)skip) return;
    for (size_t i_ = gt - skip; i_ < (size_t)NTOK * 8; i_ += gs - skip) { int idx = (int)i_;
        int hq = idx % 8, m = idx / 8, g = hq / 4;
        TokInfo ti = tokinfo(m);
        float q[64], acc[64];
#pragma unroll
        for (int d = 0; d < 64; ++d) { q[d] = ldf(PROJ + (size_t)m * PROJW + C_SQ + hq * 64 + d) * 0.125f; acc[d] = 0.f; }
        float mx = sink[hq], l = 1.f;
        int nloc = 0, j0 = 0;
        if (m < NLAT) { j0 = ti.pos - 128 < 0 ? 0 : ti.pos - 128; int j1 = ti.pos + 128 > T_ - 1 ? T_ - 1 : ti.pos + 128; nloc = j1 - j0 + 1; }
        for (int jj = 0; jj < nloc + L_; ++jj) {
            int row = jj < nloc ? ti.b * T_ + j0 + jj : NLAT + ti.b * L_ + (jj - nloc);
            const AT* kp = PROJ + (size_t)row * PROJW + C_SK + g * 64; const AT* vp = PROJ + (size_t)row * PROJW + C_SV + g * 64;
            float s = 0.f;
#pragma unroll
            for (int d = 0; d < 64; ++d) s += q[d] * ldf(kp + d);
            if (s > mx) { float sc = expf(mx - s); l *= sc;
#pragma unroll
                for (int d = 0; d < 64; ++d) acc[d] *= sc;
                mx = s; }
            float p = expf(s - mx); l += p;
#pragma unroll
            for (int d = 0; d < 64; ++d) acc[d] += p * ldf(vp + d);
        }
        float il = 1.f / l;
#pragma unroll
        for (int d = 0; d < 64; ++d) stf(MIX + (size_t)m * D_ + 512 + hq * 64 + d, acc[d] * il); }
}

constexpr int PT_WORDS = 4864;
__device__ __forceinline__ void ph_peer_topk(float* lds, int ntok, const float* SC, int* PIDX, float* PGATE) {
    const int half = threadIdx.x >> 8, tid = threadIdx.x & 255; float* base = lds + half * PT_WORDS;
    float (*sc)[128] = (float (*)[128])base; float (*tv)[16] = (float (*)[16])(base + 2048); int (*ti)[16] = (int (*)[16])(base + 2304);
    float (*cv)[256] = (float (*)[256])(base + 2560); float (*ss)[16] = (float (*)[16])(base + 4608); int (*si)[16] = (int (*)[16])(base + 4736);
    const int stride = gridDim.x * 2, iters = (ntok + stride - 1) / stride;
    for (int it = 0; it < iters; ++it) {
        const int m = it * stride + blockIdx.x * 2 + half; const bool act = m < ntok;
        __syncthreads();
        if (act) for (int i = 0; i < 8; ++i) { int e = tid + 256 * i; sc[e / 128][e % 128] = SC[(size_t)m * 2048 + e]; }
        __syncthreads();
        if (act) for (int i = 0; i < 8; ++i) { int e = tid + 256 * i; int list = e / 128, n = e % 128; float s = sc[list][n]; int r = 0;
            for (int j = 0; j < 128; ++j) { float o = sc[list][j]; r += (o > s || (o == s && j < n)) ? 1 : 0; }
            if (r < 16) { tv[list][r] = s; ti[list][r] = n; } }
        __syncthreads();
        if (act) for (int i = 0; i < 8; ++i) { int e = tid + 256 * i; int h = e / 256, c = e % 256; cv[h][c] = tv[2 * h][c / 16] + tv[2 * h + 1][c % 16]; }
        __syncthreads();
        if (act) for (int i = 0; i < 8; ++i) { int e = tid + 256 * i; int h = e / 256, c = e % 256; float s = cv[h][c]; int r = 0;
            for (int j = 0; j < 256; ++j) { float o = cv[h][j]; r += (o > s || (o == s && j < c)) ? 1 : 0; }
            if (r < 16) { ss[h][r] = s; si[h][r] = ti[2 * h][c / 16] * 128 + ti[2 * h + 1][c % 16]; } }
        __syncthreads();
        if (act && tid < 128) { int h = tid / 16, r = tid % 16; float mx = ss[h][0], sum = 0.f;
            for (int j = 0; j < 16; ++j) sum += expf(ss[h][j] - mx);
            PIDX[(size_t)m * 128 + tid] = si[h][r]; PGATE[(size_t)m * 128 + tid] = expf(ss[h][r] - mx) / sum; }
    }
}
constexpr int PA_WORDS = 1536;
__device__ __forceinline__ void ph_peer_apply(float* lds, int ntok, const AT* F, const int* PIDX, const float* PGATE, const float* U, const float* V, const float* MODL, float* XC) {
    const int half = threadIdx.x >> 8, tid = threadIdx.x & 255; float* base = lds + half * PA_WORDS;
    float* tvec = base; float* part = base + 1024; float* coef = base + 1280; int* eid = (int*)(base + 1408);
    const int stride = gridDim.x * 2, iters = (ntok + stride - 1) / stride;
    for (int it = 0; it < iters; ++it) {
        const int m = it * stride + blockIdx.x * 2 + half; const bool act = m < ntok;
        __syncthreads();
        if (act) { for (int i = 0; i < 4; ++i) tvec[tid + 256 * i] = ldf(F + (size_t)m * D_ + tid + 256 * i);
            if (tid < 128) eid[tid] = PIDX[(size_t)m * 128 + tid]; }
        __syncthreads();
        if (act) { int e = tid / 2, hf = tid % 2; const float* ur = U + (size_t)eid[e] * D_ + hf * 512; float s = 0.f;
            for (int d = 0; d < 512; ++d) s += ur[d] * (1.f / 32.f) * tvec[hf * 512 + d];
            part[tid] = s; }
        __syncthreads();
        if (act && tid < 128) { float a = part[2 * tid] + part[2 * tid + 1]; coef[tid] = PGATE[(size_t)m * 128 + tid] * 0.5f * a * (1.f + erff(a * 0.70710678118f)); }
        __syncthreads();
        if (act) { const float* mr = MODL + (size_t)tok_row(m) * D6 + 5 * D_;
            for (int i = 0; i < 4; ++i) { int col = tid + 256 * i; float acc = 0.f;
                for (int e = 0; e < 128; ++e) acc += coef[e] * V[(size_t)eid[e] * D_ + col];
                XC[(size_t)m * D_ + col] += mr[col] * acc; } }
    }
}

__device__ __forceinline__ void ph_rw_kk(const AT* K, const float* k_k, AT* KK) {
    GSTRIDE(i_, NTOK * 16) { int idx = (int)i_;
        int h = idx % 16, m = idx / 16; float ss = 0.f;
        for (int n = 0; n < 64; ++n) { float x = ldf(K + (size_t)m * D_ + h * 64 + n) * k_k[h * 64 + n]; ss += x * x; }
        float rs = rsqrtf(fmaxf(ss, 1e-24f));
        for (int n = 0; n < 64; ++n) stf(KK + (size_t)m * D_ + h * 64 + n, ldf(K + (size_t)m * D_ + h * 64 + n) * k_k[h * 64 + n] * rs); }
}
__device__ __forceinline__ void ph_rw_scan(const AT* R, const AT* K, const AT* V, const AT* KK, const AT* A, const AT* DEC, const float* w0, const float* a0, const float* k_a, AT* Y0, AT* Y1) {
    GSTRIDE(i_, B_ * 16 * 2 * 64) { int idx = (int)i_;
        int vv = idx % 64, z = (idx / 64) % 2, h = (idx / 128) % 16, b = idx / 2048;
        float S[64];
#pragma unroll
        for (int d = 0; d < 64; ++d) S[d] = 0.f;
        AT* Y = z == 0 ? Y0 : Y1;
        for (int step = 0; step < L_ + T_; ++step) {
            int m = scan_token(b, z, step);
            size_t o1 = (size_t)m * D_ + h * 64, o2 = ((size_t)m * 2 + z) * D_ + h * 64;
            float sa = 0.f;
#pragma unroll
            for (int d = 0; d < 64; ++d) sa += S[d] * ldf(KK + o1 + d);
            float vval = ldf(V + o1 + vv), y = 0.f;
            bool lat = m < NLAT;
#pragma unroll
            for (int d = 0; d < 64; ++d) {
                float w = decay_of(ldf(DEC + o2 + d) + w0[z * D_ + h * 64 + d]), a = sigmoidf_(ldf(A + o2 + d) + a0[z * D_ + h * 64 + d]), k = ldf(K + o1 + d), kk = ldf(KK + o1 + d);
                float kd = k * (1.f + (a - 1.f) * k_a[h * 64 + d]);
                float s = S[d] * w - sa * (kk * a) + vval * kd; S[d] = s;
                if (lat) y += s * ldf(R + o1 + d);
            }
            if (lat) stf(Y + o1 + vv, y);
        } }
}

#ifndef CPU_EMU
typedef float f4_t __attribute__((ext_vector_type(4)));
typedef float f2_t __attribute__((ext_vector_type(2)));
typedef unsigned u2_t __attribute__((ext_vector_type(2)));
typedef _Float16 h4_t __attribute__((ext_vector_type(4)));
#define DPP_ADD(v, ctrl) v += __int_as_float(__builtin_amdgcn_update_dpp(0, __float_as_int(v), ctrl, 0xF, 0xF, true))
__device__ __forceinline__ float allsum16(float v) {
    DPP_ADD(v, 0xB1); DPP_ADD(v, 0x4E); DPP_ADD(v, 0x141); DPP_ADD(v, 0x140); return v; }
__device__ __forceinline__ f4_t bf4(u2_t u) { f4_t r; r.x = __uint_as_float(u.x << 16); r.y = __uint_as_float(u.x & 0xffff0000u); r.z = __uint_as_float(u.y << 16); r.w = __uint_as_float(u.y & 0xffff0000u); return r; }
__device__ __forceinline__ unsigned short f2bf_bits(float f) { unsigned u = __float_as_uint(f); return (unsigned short)((u + 0x7fffu + ((u >> 16) & 1u)) >> 16); }

constexpr int RTS = 32;
__device__ __forceinline__ void ph_rw_scan2(unsigned char* lds, const AT* R, const AT* K, const AT* V, const float* k_k, const AT* A, const AT* DEC, const float* w0, const float* a0, const float* k_a, AT* Y0, AT* Y1) {
    float* buf = (float*)lds;
    float* yb = buf + 2 * 6 * RTS * 64;
    const int tid = (int)tid_now(), w = tid >> 6, l = tid & 63, rp = l >> 4, kc = l & 15;
    const int v0 = w * 8 + rp * 2, k0 = kc * 4;
    const int ss = tid >> 4, kq = tid & 15;
    constexpr int NCH = (L_ + T_) / RTS;
    for (int sc = blockIdx.x; sc < B_ * 32; sc += gridDim.x) {
        const int z = sc & 1, h = (sc >> 1) & 15, b = sc >> 5;
        AT* Y = z == 0 ? Y0 : Y1;
        const f4_t ka4 = *(const f4_t*)(k_a + h * 64 + kq * 4), w04 = *(const f4_t*)(w0 + z * D_ + h * 64 + kq * 4), a04 = *(const f4_t*)(a0 + z * D_ + h * 64 + kq * 4), kk4c = *(const f4_t*)(k_k + h * 64 + kq * 4);
        f4_t S0 = {0.f, 0.f, 0.f, 0.f}, S1 = {0.f, 0.f, 0.f, 0.f};
        u2_t gk, gv, gr, gd, ga;
#define RW_LOAD(c) do { const int m_ = scan_token(b, z, (c) * RTS + ss); const size_t o1_ = (size_t)m_ * D_ + h * 64 + kq * 4, o2_ = ((size_t)m_ * 2 + z) * D_ + h * 64 + kq * 4; \
        gk = *(const u2_t*)(K + o1_); gv = *(const u2_t*)(V + o1_); ga = *(const u2_t*)(A + o2_); gd = *(const u2_t*)(DEC + o2_); \
        if (m_ < NLAT) gr = *(const u2_t*)(R + o1_); else { gr.x = 0u; gr.y = 0u; } } while (0)
#define RW_STORE(bi) do { float* q_ = buf + (bi) * 6 * RTS * 64 + ss * 64 + kq * 4; const f4_t k_ = bf4(gk), ar_ = bf4(ga) + a04, wr_ = bf4(gd) + w04; f4_t a_, w_, kk_ = k_ * kk4c; \
        kk_ = kk_ * rsqrtf(fmaxf(allsum16(kk_.x * kk_.x + kk_.y * kk_.y + kk_.z * kk_.z + kk_.w * kk_.w), 1e-24f)); \
        a_.x = fsig(ar_.x); a_.y = fsig(ar_.y); a_.z = fsig(ar_.z); a_.w = fsig(ar_.w); \
        w_.x = __expf(-0.6065306597f * fsig(wr_.x)); w_.y = __expf(-0.6065306597f * fsig(wr_.y)); w_.z = __expf(-0.6065306597f * fsig(wr_.z)); w_.w = __expf(-0.6065306597f * fsig(wr_.w)); \
        *(f4_t*)(q_) = w_; *(f4_t*)(q_ + RTS * 64) = kk_ * a_; *(f4_t*)(q_ + 2 * RTS * 64) = k_ * (1.f + (a_ - 1.f) * ka4); *(f4_t*)(q_ + 3 * RTS * 64) = kk_; \
        *(f4_t*)(q_ + 4 * RTS * 64) = bf4(gr); *(f4_t*)(q_ + 5 * RTS * 64) = bf4(gv); } while (0)
        RW_LOAD(0); RW_STORE(0); __syncthreads();
        for (int c = 0; c < NCH; ++c) {
            if (c + 1 < NCH) RW_LOAD(c + 1);
            const float* bb = buf + (c & 1) * 6 * RTS * 64; float* yo = yb + (c & 1) * RTS * 64;
            f4_t w4 = *(const f4_t*)(bb + k0), kka4 = *(const f4_t*)(bb + RTS * 64 + k0), kd4 = *(const f4_t*)(bb + 2 * RTS * 64 + k0);
            f4_t kk4 = *(const f4_t*)(bb + 3 * RTS * 64 + k0), r4 = *(const f4_t*)(bb + 4 * RTS * 64 + k0);
            f2_t vv = *(const f2_t*)(bb + 5 * RTS * 64 + v0);
            f4_t rp = r4;
#pragma unroll 4
            for (int s = 0; s < RTS; ++s) {
                const int sn = (s + 1 < RTS ? s + 1 : s) * 64;
                const f4_t nw4 = *(const f4_t*)(bb + sn + k0), nkka4 = *(const f4_t*)(bb + RTS * 64 + sn + k0), nkd4 = *(const f4_t*)(bb + 2 * RTS * 64 + sn + k0);
                const f4_t nkk4 = *(const f4_t*)(bb + 3 * RTS * 64 + sn + k0), nr4 = *(const f4_t*)(bb + 4 * RTS * 64 + sn + k0);
                const f2_t nvv = *(const f2_t*)(bb + 5 * RTS * 64 + sn + v0);
                float sa0 = S0.x * kk4.x + S0.y * kk4.y + S0.z * kk4.z + S0.w * kk4.w;
                float sa1 = S1.x * kk4.x + S1.y * kk4.y + S1.z * kk4.z + S1.w * kk4.w;
                float y0 = S0.x * rp.x + S0.y * rp.y + S0.z * rp.z + S0.w * rp.w;
                float y1 = S1.x * rp.x + S1.y * rp.y + S1.z * rp.z + S1.w * rp.w;
                sa0 = allsum16(sa0); sa1 = allsum16(sa1); y0 = allsum16(y0); y1 = allsum16(y1);
                if (kc == 0 && s > 0) { f2_t yy; yy.x = y0; yy.y = y1; *(f2_t*)(yo + (s - 1) * 64 + v0) = yy; }
                S0 = S0 * w4 - sa0 * kka4 + vv.x * kd4;
                S1 = S1 * w4 - sa1 * kka4 + vv.y * kd4;
                rp = r4;
                w4 = nw4; kka4 = nkka4; kd4 = nkd4; kk4 = nkk4; r4 = nr4; vv = nvv;
            }
            { float y0 = S0.x * rp.x + S0.y * rp.y + S0.z * rp.z + S0.w * rp.w, y1 = S1.x * rp.x + S1.y * rp.y + S1.z * rp.z + S1.w * rp.w;
              y0 = allsum16(y0); y1 = allsum16(y1);
              if (kc == 0) { f2_t yy; yy.x = y0; yy.y = y1; *(f2_t*)(yo + (RTS - 1) * 64 + v0) = yy; } }
            if (c + 1 < NCH) RW_STORE((c + 1) & 1);
            __syncthreads();
            if (c * RTS >= L_) {
#pragma unroll
                for (int i = 0; i < 4; ++i) { const int e = tid + 512 * i, s = e >> 6, vx = e & 63; const int m = scan_token(b, z, c * RTS + s);
                    stf(Y + (size_t)m * D_ + h * 64 + vx, yo[s * 64 + vx]); }
            }
        }
        __syncthreads();
#undef RW_LOAD
#undef RW_STORE
    }
}

constexpr int GTS = 32;
__device__ __forceinline__ void ph_gla_scan2(unsigned char* lds, const AT* PROJ, const float* dec_w2, const float* dec_b, float* GLAO) {
    float* buf = (float*)lds;
    constexpr int BSZ = 3 * GTS * 64 + GTS * 32;
    float* ob = buf + 2 * BSZ;
    float* w2s = ob + 2 * GTS * 32;
    const int tid = (int)tid_now(), col = tid >> 4, dc = tid & 15, d0 = dc * 4;
    const int ss = tid >> 4, dq = tid & 15;
    constexpr int NCH = (L_ + T_) / GTS;
    for (int it = blockIdx.x; it < B_ * 32; it += gridDim.x) {
        const int vq = it & 3, z = (it >> 2) & 1, h = (it >> 3) & 3, b = it >> 5;
        __syncthreads();
        for (int i = tid; i < 16 * 64; i += NT) w2s[i] = dec_w2[(z * 16 + (i >> 6)) * 256 + h * 64 + (i & 63)];
        const f4_t db4 = *(const f4_t*)(dec_b + z * 256 + h * 64 + dq * 4);
        __syncthreads();
        f4_t S = {0.f, 0.f, 0.f, 0.f};
        u2_t gq, gk, gv; pg8::u32x4 glr0, glr1;
#define GL_LOAD(c) do { const int m_ = scan_token(b, z, (c) * GTS + ss); const AT* pr_ = PROJ + (size_t)m_ * PROJW; \
        gq = *(const u2_t*)(pr_ + C_GQ + h * 64 + dq * 4); gk = *(const u2_t*)(pr_ + C_GK + h * 64 + dq * 4); \
        glr0 = *(const pg8::u32x4*)(pr_ + C_LR + z * 16); glr1 = *(const pg8::u32x4*)(pr_ + C_LR + z * 16 + 8); \
        if (dq < 8) gv = *(const u2_t*)(pr_ + C_GV + h * 128 + vq * 32 + dq * 4); } while (0)
#define GL_STORE(bi) do { float* q_ = buf + (bi) * BSZ + ss * 64 + dq * 4; f4_t x_ = db4; \
        const unsigned lr_[8] = {glr0.x, glr0.y, glr0.z, glr0.w, glr1.x, glr1.y, glr1.z, glr1.w}; \
        _Pragma("unroll") for (int r_ = 0; r_ < 8; ++r_) { const float l0_ = __uint_as_float(lr_[r_] << 16), l1_ = __uint_as_float(lr_[r_] & 0xffff0000u); \
            x_ += l0_ * *(const f4_t*)(w2s + (2 * r_) * 64 + dq * 4); x_ += l1_ * *(const f4_t*)(w2s + (2 * r_ + 1) * 64 + dq * 4); } \
        f4_t a_; a_.x = expf((fminf(x_.x, 0.f) - log1pf(expf(-fabsf(x_.x)))) * 0.0625f); a_.y = expf((fminf(x_.y, 0.f) - log1pf(expf(-fabsf(x_.y)))) * 0.0625f); \
        a_.z = expf((fminf(x_.z, 0.f) - log1pf(expf(-fabsf(x_.z)))) * 0.0625f); a_.w = expf((fminf(x_.w, 0.f) - log1pf(expf(-fabsf(x_.w)))) * 0.0625f); \
        *(f4_t*)(q_) = a_; *(f4_t*)(q_ + GTS * 64) = bf4(gq) * 0.125f; *(f4_t*)(q_ + 2 * GTS * 64) = bf4(gk); \
        if (dq < 8) *(f4_t*)(buf + (bi) * BSZ + 3 * GTS * 64 + ss * 32 + dq * 4) = bf4(gv); } while (0)
        GL_LOAD(0); GL_STORE(0); __syncthreads();
        for (int c = 0; c < NCH; ++c) {
            if (c + 1 < NCH) GL_LOAD(c + 1);
            const float* bb = buf + (c & 1) * BSZ; float* oo = ob + (c & 1) * GTS * 32;
            f4_t a4 = *(const f4_t*)(bb + d0), q4 = *(const f4_t*)(bb + GTS * 64 + d0), k4 = *(const f4_t*)(bb + 2 * GTS * 64 + d0); float vv = bb[3 * GTS * 64 + col];
#define GL_STEPS(INCL) _Pragma("unroll 8") for (int s = 0; s < GTS; ++s) { const int sn = s + 1 < GTS ? s + 1 : s; \
                const f4_t na4 = *(const f4_t*)(bb + sn * 64 + d0), nq4 = *(const f4_t*)(bb + GTS * 64 + sn * 64 + d0), nk4 = *(const f4_t*)(bb + 2 * GTS * 64 + sn * 64 + d0); \
                const float nvv = bb[3 * GTS * 64 + sn * 32 + col]; float o; \
                if (INCL) { S = S * a4 + k4 * vv; o = S.x * q4.x + S.y * q4.y + S.z * q4.z + S.w * q4.w; } \
                else { S = S * a4; o = S.x * q4.x + S.y * q4.y + S.z * q4.z + S.w * q4.w; S = S + k4 * vv; } \
                o = allsum16(o); if (dc == 0) oo[s * 32 + col] = o; \
                a4 = na4; q4 = nq4; k4 = nk4; vv = nvv; }
            if (z == 0) { GL_STEPS(true) } else { GL_STEPS(false) }
#undef GL_STEPS
            if (c + 1 < NCH) GL_STORE((c + 1) & 1);
            __syncthreads();
#pragma unroll
            for (int i = 0; i < 2; ++i) { const int e = tid + 512 * i, s = e >> 5, vx = e & 31; const int m = scan_token(b, z, c * GTS + s);
                GLAO[((size_t)z * NTOK + m) * 512 + h * 128 + vq * 32 + vx] = oo[s * 32 + vx]; }
        }
        __syncthreads();
#undef GL_LOAD
#undef GL_STORE
    }
}

typedef __bf16 bf16x2_t __attribute__((ext_vector_type(2)));
__device__ __forceinline__ float dot2bf(unsigned a, unsigned b, float acc) { return __builtin_amdgcn_fdot2_f32_bf16(__builtin_bit_cast(bf16x2_t, a), __builtin_bit_cast(bf16x2_t, b), acc, false); }
__device__ __forceinline__ float wave_total(float v) {
    v = allsum16(v);
    v += __int_as_float(__builtin_amdgcn_update_dpp(0, __float_as_int(v), 0x142, 0xA, 0xF, false));
    v += __int_as_float(__builtin_amdgcn_update_dpp(0, __float_as_int(v), 0x143, 0xC, 0xF, false));
    return __int_as_float(__builtin_amdgcn_readlane(__float_as_int(v), 63));
}
__device__ __forceinline__ unsigned f2key(float f) { const unsigned u = __float_as_uint(f); return u ^ ((unsigned)((int)u >> 31) | 0x80000000u); }
__device__ __forceinline__ float key2f(unsigned k) { return __uint_as_float((k & 0x80000000u) ? (k ^ 0x80000000u) : ~k); }
#define INS16(r, x_) do { unsigned x__ = (x_); _Pragma("unroll") for (int i_ = 0; i_ < 16; ++i_) { const unsigned hi_ = r[i_] > x__ ? r[i_] : x__; x__ = r[i_] > x__ ? x__ : r[i_]; r[i_] = hi_; } } while (0)
__device__ __forceinline__ void ph_topk2(int ntok, const float* SC, int* PIDX, float* PGATE) {
    const int tn_ = (int)tid_now(), lane = tn_ & 63, gw = blockIdx.x * 8 + (tn_ >> 6), nw = gridDim.x * 8;
    const int ntask = (ntok / 64) * 8;
    for (int it = 0;; ++it) { const int task = it == 0 ? gw : (((tn_ >> 6) == 0) ? nw + (int)blockIdx.x + (it - 1) * (int)gridDim.x : ntask); if (task >= ntask) { if (it == 0) continue; break; }
        const int tile = task >> 3, h = task & 7, m = tile * 64 + lane;
        const float* row = SC + (size_t)m * 2048 + h * 256;
        unsigned r1[16], r2[16];
#define TK_CE(a_, b_) do { const unsigned hi_ = a_ > b_ ? a_ : b_, lo_ = a_ > b_ ? b_ : a_; a_ = hi_; b_ = lo_; } while (0)
#define TK_SORT16(x_) do { _Pragma("unroll") for (int k_ = 2; k_ <= 16; k_ <<= 1) { _Pragma("unroll") for (int j_ = k_ >> 1; j_ > 0; j_ >>= 1) { _Pragma("unroll") for (int i_ = 0; i_ < 16; ++i_) { const int l_ = i_ ^ j_; \
        if (l_ > i_) { if ((i_ & k_) == 0) TK_CE(x_[i_], x_[l_]); else TK_CE(x_[l_], x_[i_]); } } } } } while (0)
#define TK_MERGE16(x_) do { _Pragma("unroll") for (int j_ = 8; j_ > 0; j_ >>= 1) { _Pragma("unroll") for (int i_ = 0; i_ < 16; ++i_) { const int l_ = i_ ^ j_; if (l_ > i_) TK_CE(x_[i_], x_[l_]); } } } while (0)
#define TK_LOADSORT(xg_, base_, gq_) do { _Pragma("unroll") for (int q_ = 0; q_ < 4; ++q_) { const f4_t v_ = *(const f4_t*)((base_) + (gq_) * 16 + q_ * 4); const int j0_ = (gq_) * 16 + q_ * 4; \
                xg_[4 * q_] = (f2key(v_.x) & ~127u) | (unsigned)(127 - j0_); xg_[4 * q_ + 1] = (f2key(v_.y) & ~127u) | (unsigned)(126 - j0_); xg_[4 * q_ + 2] = (f2key(v_.z) & ~127u) | (unsigned)(125 - j0_); xg_[4 * q_ + 3] = (f2key(v_.w) & ~127u) | (unsigned)(124 - j0_); } \
            TK_SORT16(xg_); } while (0)
#define TK_LIST(rr_, base_) do { TK_LOADSORT(rr_, base_, 0); \
        for (int gq_ = 1; gq_ < 8; ++gq_) { unsigned xg_[16]; TK_LOADSORT(xg_, base_, gq_); \
            _Pragma("unroll") for (int i_ = 0; i_ < 16; ++i_) rr_[i_] = rr_[i_] > xg_[15 - i_] ? rr_[i_] : xg_[15 - i_]; TK_MERGE16(rr_); __builtin_amdgcn_sched_barrier(0); } } while (0)
        TK_LIST(r1, row); TK_LIST(r2, row + 128);
#undef TK_LIST
#undef TK_LOADSORT
#undef TK_MERGE16
#undef TK_SORT16
#undef TK_CE
        unsigned ck[16]; int cp[16];
#pragma unroll
        for (int i = 0; i < 16; ++i) ck[i] = 0u;
#pragma unroll
        for (int a = 0; a < 16; ++a)
#pragma unroll
            for (int b = 0; b < 16; ++b) if ((a + 1) * (b + 1) <= 16) {
                unsigned key = (f2key(key2f(r1[a] & ~127u) + key2f(r2[b] & ~127u)) & ~255u) | (unsigned)(a * 16 + b);
#pragma unroll
                for (int i = 0; i < 16; ++i) { const unsigned hi_ = key > ck[i] ? key : ck[i], lo_ = key > ck[i] ? ck[i] : key; ck[i] = hi_; key = lo_; }
                __builtin_amdgcn_sched_barrier(0);
            }
        { unsigned p1[4], p2[4];
#pragma unroll
          for (int d = 0; d < 4; ++d) { p1[d] = (r1[4 * d] & 127u) | ((r1[4 * d + 1] & 127u) << 8) | ((r1[4 * d + 2] & 127u) << 16) | ((r1[4 * d + 3] & 127u) << 24);
              p2[d] = (r2[4 * d] & 127u) | ((r2[4 * d + 1] & 127u) << 8) | ((r2[4 * d + 2] & 127u) << 16) | ((r2[4 * d + 3] & 127u) << 24); }
#pragma unroll
          for (int i = 0; i < 16; ++i) { const unsigned ab = ck[i] & 255u, a = ab >> 4, b = ab & 15u;
              const unsigned s1 = (a & 8u) ? ((a & 4u) ? p1[3] : p1[2]) : ((a & 4u) ? p1[1] : p1[0]), s2 = (b & 8u) ? ((b & 4u) ? p2[3] : p2[2]) : ((b & 4u) ? p2[1] : p2[0]);
              const unsigned f1 = (s1 >> ((a & 3u) * 8u)) & 127u, f2 = (s2 >> ((b & 3u) * 8u)) & 127u;
              cp[i] = (int)((127u - f1) * 128u + (127u - f2)); ck[i] &= ~255u; } }
        const float mx = key2f(ck[0]); float e[16], sum = 0.f;
#pragma unroll
        for (int i = 0; i < 16; ++i) { e[i] = __expf(key2f(ck[i]) - mx); sum += e[i]; }
        const float inv = 1.f / sum;
        int* pi = PIDX + (size_t)m * 128 + h * 16; float* pg = PGATE + (size_t)m * 128 + h * 16;
#pragma unroll
        for (int i = 0; i < 16; i += 4) { pg8::u32x4 w; w.x = (unsigned)cp[i]; w.y = (unsigned)cp[i + 1]; w.z = (unsigned)cp[i + 2]; w.w = (unsigned)cp[i + 3]; *(pg8::u32x4*)(pi + i) = w;
            f4_t g; g.x = e[i] * inv; g.y = e[i + 1] * inv; g.z = e[i + 2] * inv; g.w = e[i + 3] * inv; *(f4_t*)(pg + i) = g; }
    }
}
__device__ __forceinline__ void unpk8(pg8::u32x4 u, float (&o)[8]) {
    o[0] = __uint_as_float(u.x << 16); o[1] = __uint_as_float(u.x & 0xffff0000u); o[2] = __uint_as_float(u.y << 16); o[3] = __uint_as_float(u.y & 0xffff0000u);
    o[4] = __uint_as_float(u.z << 16); o[5] = __uint_as_float(u.z & 0xffff0000u); o[6] = __uint_as_float(u.w << 16); o[7] = __uint_as_float(u.w & 0xffff0000u); }
__device__ __forceinline__ void cvt16(pg8::u32x4 w, float (&o)[16]) {
    const unsigned ww[4] = {w.x, w.y, w.z, w.w};
#pragma unroll
    for (int j = 0; j < 4; ++j) { const f2_t lo = __builtin_amdgcn_cvt_pk_f32_fp8((int)ww[j], false), hi = __builtin_amdgcn_cvt_pk_f32_fp8((int)ww[j], true); o[4 * j] = lo.x; o[4 * j + 1] = lo.y; o[4 * j + 2] = hi.x; o[4 * j + 3] = hi.y; }
}
template <int NTK, int BS>
__device__ __forceinline__ void ph_peer_apply2(int ntok, const AT* F, const int* PIDX, const float* PGATE, const TT* TU, const TT* TV, const float* MODL, float* XC, float gscale, const float* fin_g = nullptr, float* fin_out = nullptr) {
    const int tn_ = (int)tid_now(), lane = tn_ & 63, gw = blockIdx.x * 8 + (tn_ >> 6), nw = gridDim.x * 8;
    for (int m0 = gw; m0 < ntok; m0 += nw * NTK) {
        f2_t t2[NTK][8]; int eh[NTK][2]; float gh[NTK][2], dh[NTK][2]; bool ok[NTK];
#pragma unroll
        for (int q = 0; q < NTK; ++q) { const int m = m0 + q * nw; ok[q] = m < ntok; const int mm = ok[q] ? m : m0; dh[q][0] = 0.f; dh[q][1] = 0.f;
            { const pg8::u32x4 ta = *(const pg8::u32x4*)(F + (size_t)mm * D_ + 16 * lane), tb = *(const pg8::u32x4*)(F + (size_t)mm * D_ + 16 * lane + 8); float x0[8], x1[8]; unpk8(ta, x0); unpk8(tb, x1);
#pragma unroll
              for (int j = 0; j < 4; ++j) { t2[q][j].x = x0[2 * j]; t2[q][j].y = x0[2 * j + 1]; t2[q][4 + j].x = x1[2 * j]; t2[q][4 + j].y = x1[2 * j + 1]; } }
            unsigned k0 = ((unsigned)PIDX[(size_t)mm * 128 + lane] << 7) | (unsigned)lane, k1 = ((unsigned)PIDX[(size_t)mm * 128 + 64 + lane] << 7) | (unsigned)(64 + lane);
#pragma unroll
            for (int k = 2; k <= 128; k <<= 1)
#pragma unroll
                for (int j = k >> 1; j > 0; j >>= 1) {
                    if (j == 64) { const unsigned lo = k0 < k1 ? k0 : k1, hi = k0 < k1 ? k1 : k0; k0 = lo; k1 = hi; }
                    else { const unsigned p0 = (unsigned)__shfl_xor((int)k0, j), p1 = (unsigned)__shfl_xor((int)k1, j);
                        const bool low = (lane & j) == 0; const bool asc0 = (lane & k) == 0, asc1 = ((64 + lane) & k) == 0; const bool min0 = low == asc0, min1 = low == asc1;
                        k0 = min0 ? (k0 < p0 ? k0 : p0) : (k0 > p0 ? k0 : p0); k1 = min1 ? (k1 < p1 ? k1 : p1) : (k1 > p1 ? k1 : p1); } }
            eh[q][0] = (int)(k0 >> 7); eh[q][1] = (int)(k1 >> 7); gh[q][0] = PGATE[(size_t)mm * 128 + (k0 & 127u)]; gh[q][1] = PGATE[(size_t)mm * 128 + (k1 & 127u)]; }
        __syncthreads();
        static_assert(BS == 4, "the batched reduction below sums four experts at a time");
        const __amdgpu_buffer_rsrc_t ru = __builtin_amdgcn_make_buffer_rsrc((void*)TU, 0, 16384 * D_, 0x00020000), rv = __builtin_amdgcn_make_buffer_rsrc((void*)TV, 0, 16384 * D_, 0x00020000);
        const int voff = 16 * lane;
        pg8::u32x4 rw[NTK][BS];
#define PA_LOADQ(rs, q, hf, jb_) do { _Pragma("unroll") for (int j = 0; j < BS; ++j) { \
            const int e = __builtin_amdgcn_readlane(eh[q][hf], (jb_) + j); rw[q][j] = __builtin_amdgcn_raw_buffer_load_b128(rs, voff, e << 10, 0); } } while (0)
#define PA_UCOMPQ(q, hf, jb) do { float p[4]; \
            _Pragma("unroll") for (int j = 0; j < 4; ++j) { const unsigned ww[4] = {rw[q][j].x, rw[q][j].y, rw[q][j].z, rw[q][j].w}; f2_t ac = {0.f, 0.f}; \
                _Pragma("unroll") for (int k = 0; k < 4; ++k) { ac += __builtin_amdgcn_cvt_pk_f32_fp8((int)ww[k], false) * t2[q][2 * k]; ac += __builtin_amdgcn_cvt_pk_f32_fp8((int)ww[k], true) * t2[q][2 * k + 1]; } \
                p[j] = ac.x + ac.y; } \
            const bool b0 = (lane & 1) != 0, b1 = (lane & 2) != 0; \
            float ra = b0 ? p[1] : p[0], sa = b0 ? p[0] : p[1], rc = b0 ? p[3] : p[2], sc = b0 ? p[2] : p[3]; \
            ra += __int_as_float(__builtin_amdgcn_update_dpp(0, __float_as_int(sa), 0xB1, 0xF, 0xF, true)); rc += __int_as_float(__builtin_amdgcn_update_dpp(0, __float_as_int(sc), 0xB1, 0xF, 0xF, true)); \
            float rd = b1 ? rc : ra, sd = b1 ? ra : rc; \
            rd += __int_as_float(__builtin_amdgcn_update_dpp(0, __float_as_int(sd), 0x4E, 0xF, 0xF, true)); \
            rd += __int_as_float(__builtin_amdgcn_update_dpp(0, __float_as_int(rd), 0x124, 0xF, 0xF, true)); \
            rd += __int_as_float(__builtin_amdgcn_update_dpp(0, __float_as_int(rd), 0x128, 0xF, 0xF, true)); \
            rd += __shfl_xor(rd, 16); rd += __shfl_xor(rd, 32); \
            dh[q][hf] = ((lane >> 2) == ((jb) >> 2)) ? rd : dh[q][hf]; } while (0)
#define PA_VCOMPQ(q, hf, jb) do { _Pragma("unroll") for (int j = 0; j < BS; ++j) { \
            const float c = __int_as_float(__builtin_amdgcn_readlane(__float_as_int(cf[q][hf]), (jb) + j)); float x[16]; cvt16(rw[q][j], x); \
            _Pragma("unroll") for (int i = 0; i < 16; ++i) acc[q][i] += c * x[i]; } } while (0)
#define PA_SWEEP(rs, COMPQ, rs_next) do { \
            for (int jb = 0; jb < 60; jb += 4) { _Pragma("unroll") for (int q = 0; q < NTK; ++q) { COMPQ(q, 0, jb); __builtin_amdgcn_sched_barrier(0); PA_LOADQ(rs, q, 0, jb + 4); __builtin_amdgcn_sched_barrier(0); } } \
            _Pragma("unroll") for (int q = 0; q < NTK; ++q) { COMPQ(q, 0, 60); __builtin_amdgcn_sched_barrier(0); PA_LOADQ(rs, q, 1, 0); __builtin_amdgcn_sched_barrier(0); } \
            for (int jb = 0; jb < 60; jb += 4) { _Pragma("unroll") for (int q = 0; q < NTK; ++q) { COMPQ(q, 1, jb); __builtin_amdgcn_sched_barrier(0); PA_LOADQ(rs, q, 1, jb + 4); __builtin_amdgcn_sched_barrier(0); } } \
            _Pragma("unroll") for (int q = 0; q < NTK; ++q) { COMPQ(q, 1, 60); __builtin_amdgcn_sched_barrier(0); if (rs_next) { PA_LOADQ(rv, q, 0, 0); __builtin_amdgcn_sched_barrier(0); } } } while (0)
#pragma unroll
        for (int q = 0; q < NTK; ++q) PA_LOADQ(ru, q, 0, 0);
        __builtin_amdgcn_sched_barrier(0);
        PA_SWEEP(ru, PA_UCOMPQ, true);
        float cf[NTK][2];
#pragma unroll
        for (int q = 0; q < NTK; ++q)
#pragma unroll
            for (int hf = 0; hf < 2; ++hf) { const float a = dh[q][hf] * (1.f / 32.f); cf[q][hf] = gscale * gh[q][hf] * 0.5f * a * (1.f + erff(a * 0.70710678118f)); }
        float acc[NTK][16];
#pragma unroll
        for (int q = 0; q < NTK; ++q)
#pragma unroll
            for (int i = 0; i < 16; ++i) acc[q][i] = 0.f;
        PA_SWEEP(rv, PA_VCOMPQ, false);
#undef PA_LOADQ
#undef PA_UCOMPQ
#undef PA_VCOMPQ
#undef PA_SWEEP
#pragma unroll
        for (int q = 0; q < NTK; ++q) if (ok[q]) { const int m = m0 + q * nw;
            const float* gr = MODL + (size_t)tok_row(m) * D6 + 5 * D_ + 16 * lane; float* xr = XC + (size_t)m * D_ + 16 * lane;
            f4_t xo[4]; float ssq = 0.f;
#pragma unroll
            for (int j = 0; j < 4; ++j) { f4_t a; a.x = acc[q][4 * j]; a.y = acc[q][4 * j + 1]; a.z = acc[q][4 * j + 2]; a.w = acc[q][4 * j + 3]; xo[j] = *(const f4_t*)(xr + 4 * j) + *(const f4_t*)(gr + 4 * j) * a;
                ssq += xo[j].x * xo[j].x + xo[j].y * xo[j].y + xo[j].z * xo[j].z + xo[j].w * xo[j].w; }
            if (fin_out) { const float rsn = rsqrtf(wave_total(ssq) * (1.f / D_) + 1e-6f);
#pragma unroll
                for (int j = 0; j < 4; ++j) *(f4_t*)(fin_out + (size_t)m * D_ + 16 * lane + 4 * j) = xo[j] * rsn * *(const f4_t*)(fin_g + 16 * lane + 4 * j);
            } else {
#pragma unroll
                for (int j = 0; j < 4; ++j) *(f4_t*)(xr + 4 * j) = xo[j]; } }
    }
}
#define L3 __attribute__((address_space(3)))
template <int NTK>
__device__ __forceinline__ void ph_peer_apply4(unsigned char* lds, int ntok, const AT* F, const int* PIDX, const float* PGATE, const TT* TU, const float* USCL, const TT* TV, const float* MODL, float* XC, float gscale, const float* fin_g = nullptr, float* fin_out = nullptr) {
    const int tn_ = (int)tid_now(), lane = tn_ & 63, wv = tn_ >> 6, gw = blockIdx.x * 8 + wv, nw = gridDim.x * 8;
    L3 unsigned char* TQ = (L3 unsigned char*)lds + wv * (NTK * 1024);
    for (int m0 = gw; m0 < ntok; m0 += nw * NTK) {
        int eh[NTK][2]; float gh[NTK][2], tsc[NTK]; bool ok[NTK];
#pragma unroll
        for (int q = 0; q < NTK; ++q) { const int m = m0 + q * nw; ok[q] = m < ntok; const int mm = ok[q] ? m : m0;
            { const pg8::u32x4 ta = *(const pg8::u32x4*)(F + (size_t)mm * D_ + 16 * lane), tb = *(const pg8::u32x4*)(F + (size_t)mm * D_ + 16 * lane + 8); float x0[8], x1[8]; unpk8(ta, x0); unpk8(tb, x1);
              float mx = 0.f;
#pragma unroll
              for (int i = 0; i < 8; ++i) mx = fmaxf(mx, fmaxf(fabsf(x0[i]), fabsf(x1[i])));
              mx = wave_maxf(mx); const float inv = mx > 0.f ? 127.f / mx : 0.f; tsc[q] = mx * (1.f / 127.f); pg8::u32x4 w;
              w.x = q8pack(x0[0], x0[1], x0[2], x0[3], inv); w.y = q8pack(x0[4], x0[5], x0[6], x0[7], inv); w.z = q8pack(x1[0], x1[1], x1[2], x1[3], inv); w.w = q8pack(x1[4], x1[5], x1[6], x1[7], inv);
              *(L3 pg8::u32x4*)(TQ + q * 1024 + 16 * lane) = w; }
            unsigned k0 = ((unsigned)PIDX[(size_t)mm * 128 + lane] << 7) | (unsigned)lane, k1 = ((unsigned)PIDX[(size_t)mm * 128 + 64 + lane] << 7) | (unsigned)(64 + lane);
#pragma unroll
            for (int k = 2; k <= 128; k <<= 1)
#pragma unroll
                for (int j = k >> 1; j > 0; j >>= 1) {
                    if (j == 64) { const unsigned lo = k0 < k1 ? k0 : k1, hi = k0 < k1 ? k1 : k0; k0 = lo; k1 = hi; }
                    else { const unsigned p0 = (unsigned)__shfl_xor((int)k0, j), p1 = (unsigned)__shfl_xor((int)k1, j);
                        const bool low = (lane & j) == 0; const bool asc0 = (lane & k) == 0, asc1 = ((64 + lane) & k) == 0; const bool min0 = low == asc0, min1 = low == asc1;
                        k0 = min0 ? (k0 < p0 ? k0 : p0) : (k0 > p0 ? k0 : p0); k1 = min1 ? (k1 < p1 ? k1 : p1) : (k1 > p1 ? k1 : p1); } }
            eh[q][0] = (int)(k0 >> 7); eh[q][1] = (int)(k1 >> 7); gh[q][0] = PGATE[(size_t)mm * 128 + (k0 & 127u)]; gh[q][1] = PGATE[(size_t)mm * 128 + (k1 & 127u)]; }
        __syncthreads();
        const __amdgpu_buffer_rsrc_t ru = __builtin_amdgcn_make_buffer_rsrc((void*)TU, 0, 16384 * D_, 0x00020000), rv = __builtin_amdgcn_make_buffer_rsrc((void*)TV, 0, 16384 * D_, 0x00020000);
        const int voff = 16 * lane;
        constexpr int RU = 4, RV = NTK <= 3 ? 8 : 4;
        pg8::u32x4 rw[NTK][RV > RU ? RV : RU]; int idh[NTK][2];
        {
            pg8::u32x4 tq[NTK];
#pragma unroll
            for (int q = 0; q < NTK; ++q) { idh[q][0] = 0; idh[q][1] = 0; tq[q] = *(L3 const pg8::u32x4*)(TQ + q * 1024 + 16 * lane); }
#define P4_ULOAD1(q, j, hf, jb_) do { const int e = __builtin_amdgcn_readlane(eh[q][hf], (jb_) + (j)); rw[q][j] = __builtin_amdgcn_raw_buffer_load_b128(ru, voff, e << 10, 0); } while (0)
#define P4_USTEP(q, hf, jb, NEXT) do { int p[4]; \
            _Pragma("unroll") for (int j = 0; j < 4; ++j) { int s_ = __builtin_amdgcn_sdot4((int)rw[q][j].x, (int)tq[q].x, 0, false); s_ = __builtin_amdgcn_sdot4((int)rw[q][j].y, (int)tq[q].y, s_, false); \
                s_ = __builtin_amdgcn_sdot4((int)rw[q][j].z, (int)tq[q].z, s_, false); p[j] = __builtin_amdgcn_sdot4((int)rw[q][j].w, (int)tq[q].w, s_, false); __builtin_amdgcn_sched_barrier(0); NEXT(q, j); __builtin_amdgcn_sched_barrier(0); } \
            const bool b0 = (lane & 1) != 0, b1 = (lane & 2) != 0; \
            int ra = b0 ? p[1] : p[0], sa = b0 ? p[0] : p[1], rc = b0 ? p[3] : p[2], sc = b0 ? p[2] : p[3]; \
            ra += __builtin_amdgcn_update_dpp(0, sa, 0xB1, 0xF, 0xF, true); rc += __builtin_amdgcn_update_dpp(0, sc, 0xB1, 0xF, 0xF, true); \
            int rd = b1 ? rc : ra, sd = b1 ? ra : rc; \
            rd += __builtin_amdgcn_update_dpp(0, sd, 0x4E, 0xF, 0xF, true); \
            rd += __builtin_amdgcn_update_dpp(0, rd, 0x124, 0xF, 0xF, true); \
            rd += __builtin_amdgcn_update_dpp(0, rd, 0x128, 0xF, 0xF, true); \
            rd += __shfl_xor(rd, 16); rd += __shfl_xor(rd, 32); \
            idh[q][hf] = ((lane >> 2) == ((jb) >> 2)) ? rd : idh[q][hf]; } while (0)
#define P4_UN0(q, j) P4_ULOAD1(q, j, 0, jb + 4)
#define P4_UN01(q, j) P4_ULOAD1(q, j, 1, 0)
#define P4_UN1(q, j) P4_ULOAD1(q, j, 1, jb + 4)
#define P4_UNV(q, j) P4_VLOAD1(q, j, 0, 0)
#define P4_VLOAD1(q, j, hf, jb_) do { const int e = __builtin_amdgcn_readlane(eh[q][hf], (jb_) + (j)); rw[q][j] = __builtin_amdgcn_raw_buffer_load_b128(rv, voff, e << 10, 0); } while (0)
#pragma unroll
            for (int q = 0; q < NTK; ++q)
#pragma unroll
                for (int j = 0; j < 4; ++j) P4_ULOAD1(q, j, 0, 0);
            __builtin_amdgcn_sched_barrier(0);
            for (int jb = 0; jb < 60; jb += 4) {
#pragma unroll
                for (int q = 0; q < NTK; ++q) P4_USTEP(q, 0, jb, P4_UN0); }
#pragma unroll
            for (int q = 0; q < NTK; ++q) P4_USTEP(q, 0, 60, P4_UN01);
            for (int jb = 0; jb < 60; jb += 4) {
#pragma unroll
                for (int q = 0; q < NTK; ++q) P4_USTEP(q, 1, jb, P4_UN1); }
#pragma unroll
            for (int q = 0; q < NTK; ++q) P4_USTEP(q, 1, 60, P4_UNV);
#pragma unroll
            for (int q = 0; q < NTK; ++q)
#pragma unroll
                for (int j = 4; j < RV; ++j) P4_VLOAD1(q, j, 0, 0);
#undef P4_USTEP
#undef P4_UN0
#undef P4_UN01
#undef P4_UN1
#undef P4_UNV
#undef P4_ULOAD1
        }
        float cf[NTK][2];
#pragma unroll
        for (int q = 0; q < NTK; ++q)
#pragma unroll
            for (int hf = 0; hf < 2; ++hf) { const float a = (float)idh[q][hf] * (tsc[q] * USCL[eh[q][hf]]); cf[q][hf] = gscale * gh[q][hf] * 0.5f * a * (1.f + erff(a * 0.70710678118f)); }
        f2_t acc[NTK][8];
#pragma unroll
        for (int q = 0; q < NTK; ++q)
#pragma unroll
            for (int i = 0; i < 8; ++i) acc[q][i] = f2_t{0.f, 0.f};
#define P4_VSTEP(q, hf, jb, NEXT) do { _Pragma("unroll") for (int j = 0; j < RV; ++j) { \
            const float c = __int_as_float(__builtin_amdgcn_readlane(__float_as_int(cf[q][hf]), (jb) + j)); const unsigned ww_[4] = {rw[q][j].x, rw[q][j].y, rw[q][j].z, rw[q][j].w}; \
            _Pragma("unroll") for (int k = 0; k < 4; ++k) { acc[q][2 * k] += __builtin_amdgcn_cvt_pk_f32_fp8((int)ww_[k], false) * c; acc[q][2 * k + 1] += __builtin_amdgcn_cvt_pk_f32_fp8((int)ww_[k], true) * c; } \
            asm volatile("" : "+v"(acc[q][0]), "+v"(acc[q][1]), "+v"(acc[q][2]), "+v"(acc[q][3]), "+v"(acc[q][4]), "+v"(acc[q][5]), "+v"(acc[q][6]), "+v"(acc[q][7]));   \
            __builtin_amdgcn_sched_barrier(0); NEXT(q, j); __builtin_amdgcn_sched_barrier(0); } } while (0)
#define P4_VN0(q, j) P4_VLOAD1(q, j, 0, jb + RV)
#define P4_VN01(q, j) P4_VLOAD1(q, j, 1, 0)
#define P4_VN1(q, j) P4_VLOAD1(q, j, 1, jb + RV)
#define P4_VNONE(q, j) do { } while (0)
        for (int jb = 0; jb < 64 - RV; jb += RV) {
#pragma unroll
            for (int q = 0; q < NTK; ++q) P4_VSTEP(q, 0, jb, P4_VN0); }
#pragma unroll
        for (int q = 0; q < NTK; ++q) P4_VSTEP(q, 0, 64 - RV, P4_VN01);
        for (int jb = 0; jb < 64 - RV; jb += RV) {
#pragma unroll
            for (int q = 0; q < NTK; ++q) P4_VSTEP(q, 1, jb, P4_VN1); }
#pragma unroll
        for (int q = 0; q < NTK; ++q) P4_VSTEP(q, 1, 64 - RV, P4_VNONE);
#undef P4_VSTEP
#undef P4_VN0
#undef P4_VN01
#undef P4_VN1
#undef P4_VNONE
#undef P4_VLOAD1
#pragma unroll
        for (int q = 0; q < NTK; ++q) if (ok[q]) { const int m = m0 + q * nw;
            const float* gr = MODL + (size_t)tok_row(m) * D6 + 5 * D_ + 16 * lane; unsigned short* xr = (unsigned short*)XC + (size_t)m * D_ + 16 * lane;
            f4_t xo[4]; float ssq = 0.f; float xin[16];
            { const pg8::u32x4 xa = *(const pg8::u32x4*)xr, xb = *(const pg8::u32x4*)(xr + 8); float x0[8], x1[8]; unpk8(xa, x0); unpk8(xb, x1);
#pragma unroll
              for (int i = 0; i < 8; ++i) { xin[i] = x0[i]; xin[8 + i] = x1[i]; } }
#pragma unroll
            for (int j = 0; j < 4; ++j) { f4_t a; a.x = acc[q][2 * j].x; a.y = acc[q][2 * j].y; a.z = acc[q][2 * j + 1].x; a.w = acc[q][2 * j + 1].y; f4_t xi; xi.x = xin[4 * j]; xi.y = xin[4 * j + 1]; xi.z = xin[4 * j + 2]; xi.w = xin[4 * j + 3];
                xo[j] = xi + *(const f4_t*)(gr + 4 * j) * a;
                ssq += xo[j].x * xo[j].x + xo[j].y * xo[j].y + xo[j].z * xo[j].z + xo[j].w * xo[j].w; }
            if (fin_out) { const float rsn = rsqrtf(wave_total(ssq) * (1.f / D_) + 1e-6f);
#pragma unroll
                for (int j = 0; j < 4; ++j) *(f4_t*)(fin_out + (size_t)m * D_ + 16 * lane + 4 * j) = xo[j] * rsn * *(const f4_t*)(fin_g + 16 * lane + 4 * j);
            } else { pg8::u32x4 w0, w1;
                w0.x = pg8::cvt_pk_bf16(xo[0].x, xo[0].y); w0.y = pg8::cvt_pk_bf16(xo[0].z, xo[0].w); w0.z = pg8::cvt_pk_bf16(xo[1].x, xo[1].y); w0.w = pg8::cvt_pk_bf16(xo[1].z, xo[1].w);
                w1.x = pg8::cvt_pk_bf16(xo[2].x, xo[2].y); w1.y = pg8::cvt_pk_bf16(xo[2].z, xo[2].w); w1.z = pg8::cvt_pk_bf16(xo[3].x, xo[3].y); w1.w = pg8::cvt_pk_bf16(xo[3].z, xo[3].w);
                *(pg8::u32x4*)xr = w0; *(pg8::u32x4*)(xr + 8) = w1; } }
    }
}
#undef L3
typedef short bf16x8_t __attribute__((ext_vector_type(8)));
typedef short s16x4_t __attribute__((ext_vector_type(4)));
typedef float f32x16_t __attribute__((ext_vector_type(16)));
#define MFMA32(a, b, c) __builtin_amdgcn_mfma_f32_32x32x16_bf16((a), (b), (c), 0, 0, 0)
__device__ __forceinline__ unsigned pkbf(float a, float b) { f2_t v; v.x = a; v.y = b; return __builtin_bit_cast(unsigned, __builtin_convertvector(v, bf16x2_t)); }
constexpr int SW_KST = 72, SW_VST = 68;
__device__ __forceinline__ void ph_swa2(unsigned char* lds, const AT* PROJ, const float* sink, AT* MIX) {
    unsigned short* KS = (unsigned short*)lds;
    unsigned short* VT = KS + 2 * 64 * SW_KST;
    float* cosT = (float*)(VT + 2 * 64 * SW_VST);
    float* sinT = cosT + 96 * 16;
    const int tid = (int)tid_now(), w = tid >> 6, lane = tid & 63, r = lane & 31, h = lane >> 5;
    const int skey = tid >> 3, spart = tid & 7;
    __syncthreads();
    for (int i = tid; i < 96 * 16; i += NT) { const int p = i >> 4, f = i & 15; const float pos = p < 32 ? (float)p : (float)(p - 32);
        const float ang = pos * __expf(-(float)f * (9.210340371976184f / 16.f)); cosT[i] = __cosf(ang); sinT[i] = __sinf(ang); }
    __syncthreads();
    constexpr int NBLK = T_ / 64, NLU = B_ * 2 * NBLK, NCB = L_ / 64, NCU = B_ * 2 * NCB, CEND = 5 + NCB;
    f32x16_t zero;
#pragma unroll
    for (int i = 0; i < 16; ++i) zero[i] = 0.f;
    for (int u = blockIdx.x; u < NLU + NCU; u += gridDim.x) {
        const bool isl = u < NLU; int b, g, blk;
        if (isl) { blk = u % NBLK; g = (u / NBLK) & 1; b = u / (2 * NBLK); } else { const int v = u - NLU; blk = v % NCB; g = (v / NCB) & 1; b = v / (2 * NCB); }
        const int Q0 = blk * 64, qrow0 = isl ? b * T_ + Q0 : NLAT + b * L_ + Q0;
        const int hq = g * 4 + (w >> 1), ql = (w & 1) * 32 + r;
        bf16x8_t qf[4];
        { const AT* qp = PROJ + (size_t)(qrow0 + ql) * PROJW + C_SQ + hq * 64 + 8 * h; float x[4][8];
#pragma unroll
          for (int s2 = 0; s2 < 4; ++s2) unpk8(*(const pg8::u32x4*)(qp + 16 * s2), x[s2]);
          if (isl) { const int t = Q0 + ql;
#pragma unroll
              for (int ax = 0; ax < 2; ++ax) { const int p = ax == 0 ? (t >> 6) : 32 + (t & 63);
#pragma unroll
                  for (int j = 0; j < 8; ++j) { const float cs = cosT[p * 16 + 8 * h + j], sn = sinT[p * 16 + 8 * h + j]; const float a = x[2 * ax][j], bb = x[2 * ax + 1][j];
                      x[2 * ax][j] = a * cs - bb * sn; x[2 * ax + 1][j] = bb * cs + a * sn; } } }
#pragma unroll
          for (int s2 = 0; s2 < 4; ++s2) { pg8::u32x4 pk; pk.x = pkbf(x[s2][0] * 0.125f, x[s2][1] * 0.125f); pk.y = pkbf(x[s2][2] * 0.125f, x[s2][3] * 0.125f);
              pk.z = pkbf(x[s2][4] * 0.125f, x[s2][5] * 0.125f); pk.w = pkbf(x[s2][6] * 0.125f, x[s2][7] * 0.125f); qf[s2] = __builtin_bit_cast(bf16x8_t, pk); } }
        f32x16_t O0 = zero, O1 = zero; float mrun = sink[hq], lrun = (h == 0) ? 1.f : 0.f;
        pg8::u32x4 gA, gB;
#define SW_OK(ci) ((ci) >= 5 || (isl && Q0 - 128 + 64 * (ci) >= 0 && Q0 - 128 + 64 * (ci) + 64 <= T_))
#define SW_ROW0(ci) ((ci) < 5 ? b * T_ + Q0 - 128 + 64 * (ci) : NLAT + b * L_ + 64 * ((ci) - 5))
#define SW_LOAD(ci) do { const AT* pr_ = PROJ + (size_t)(SW_ROW0(ci) + skey) * PROJW; \
        if (spart < 4) { const int d0_ = (spart & 1) * 8 + (spart >> 1) * 32; gA = *(const pg8::u32x4*)(pr_ + C_SK + g * 64 + d0_); gB = *(const pg8::u32x4*)(pr_ + C_SK + g * 64 + d0_ + 16); } \
        else { gA = *(const pg8::u32x4*)(pr_ + C_SV + g * 64 + (spart - 4) * 16); gB = *(const pg8::u32x4*)(pr_ + C_SV + g * 64 + (spart - 4) * 16 + 8); } } while (0)
#define SW_STORE(ci, bi) do { \
        if (spart < 4) { const int d0_ = (spart & 1) * 8 + (spart >> 1) * 32; unsigned short* kd_ = KS + (bi) * 64 * SW_KST + skey * SW_KST + d0_; pg8::u32x4 oa_ = gA, ob_ = gB; \
            if ((ci) < 5) { float a_[8], b_[8]; unpk8(gA, a_); unpk8(gB, b_); const int t_ = Q0 - 128 + 64 * (ci) + skey; const int p_ = (spart >> 1) == 0 ? (t_ >> 6) : 32 + (t_ & 63); const int f0_ = (spart & 1) * 8; \
                float ra_[8], rb_[8]; _Pragma("unroll") for (int j_ = 0; j_ < 8; ++j_) { const float cs_ = cosT[p_ * 16 + f0_ + j_], sn_ = sinT[p_ * 16 + f0_ + j_]; ra_[j_] = a_[j_] * cs_ - b_[j_] * sn_; rb_[j_] = b_[j_] * cs_ + a_[j_] * sn_; } \
                oa_.x = pkbf(ra_[0], ra_[1]); oa_.y = pkbf(ra_[2], ra_[3]); oa_.z = pkbf(ra_[4], ra_[5]); oa_.w = pkbf(ra_[6], ra_[7]); ob_.x = pkbf(rb_[0], rb_[1]); ob_.y = pkbf(rb_[2], rb_[3]); ob_.z = pkbf(rb_[4], rb_[5]); ob_.w = pkbf(rb_[6], rb_[7]); } \
            *(pg8::u32x4*)kd_ = oa_; *(pg8::u32x4*)(kd_ + 16) = ob_; } \
        else { unsigned short* vd_ = VT + (bi) * 64 * SW_VST + ((spart - 4) * 16) * SW_VST + skey; const unsigned va_[4] = {gA.x, gA.y, gA.z, gA.w}, vb_[4] = {gB.x, gB.y, gB.z, gB.w}; \
            _Pragma("unroll") for (int j_ = 0; j_ < 4; ++j_) { vd_[(2 * j_) * SW_VST] = (unsigned short)(va_[j_] & 0xffffu); vd_[(2 * j_ + 1) * SW_VST] = (unsigned short)(va_[j_] >> 16); \
                vd_[(8 + 2 * j_) * SW_VST] = (unsigned short)(vb_[j_] & 0xffffu); vd_[(9 + 2 * j_) * SW_VST] = (unsigned short)(vb_[j_] >> 16); } } } while (0)
        int ci = isl ? 0 : 5; while (!SW_OK(ci)) ++ci;
        int bi = 0;
        __syncthreads();
        SW_LOAD(ci); SW_STORE(ci, 0); __syncthreads();
        while (ci < CEND) {
            int cn = ci + 1; while (cn < CEND && !SW_OK(cn)) ++cn;
            if (cn < CEND) SW_LOAD(cn);
            const unsigned short* KSb = KS + bi * 64 * SW_KST; const unsigned short* VTb = VT + bi * 64 * SW_VST;
            const int mt = ci == 0 ? 1 : (ci == 4 ? 2 : 0);
            f32x16_t S[2];
#pragma unroll
            for (int kb = 0; kb < 2; ++kb) { f32x16_t acc = zero;
#pragma unroll
                for (int s2 = 0; s2 < 4; ++s2) { const bf16x8_t kf = *(const bf16x8_t*)(KSb + (kb * 32 + r) * SW_KST + 16 * s2 + 8 * h); acc = MFMA32(kf, qf[s2], acc); }
                S[kb] = acc; }
            if (mt) {
#pragma unroll
                for (int kb = 0; kb < 2; ++kb)
#pragma unroll
                    for (int i = 0; i < 16; ++i) { const int kk = 32 * kb + (i & 3) + 8 * (i >> 2) + 4 * h; const bool ok = mt == 1 ? kk >= ql : kk <= ql; S[kb][i] = ok ? S[kb][i] : -INFINITY; } }
            float cm = -INFINITY;
#pragma unroll
            for (int kb = 0; kb < 2; ++kb)
#pragma unroll
                for (int i = 0; i < 16; ++i) cm = fmaxf(cm, S[kb][i]);
            cm = fmaxf(cm, __shfl_xor(cm, 32));
            const float mn = fmaxf(mrun, cm), alpha = __expf(mrun - mn); mrun = mn; lrun *= alpha; O0 *= alpha; O1 *= alpha;
            float ls = 0.f;
#pragma unroll
            for (int kb = 0; kb < 2; ++kb)
#pragma unroll
                for (int i = 0; i < 16; ++i) { const float pv = __expf(S[kb][i] - mn); S[kb][i] = pv; ls += pv; }
            lrun += ls;
#pragma unroll
            for (int kb = 0; kb < 2; ++kb)
#pragma unroll
                for (int s2 = 0; s2 < 2; ++s2) { pg8::u32x4 pk; pk.x = pkbf(S[kb][8 * s2], S[kb][8 * s2 + 1]); pk.y = pkbf(S[kb][8 * s2 + 2], S[kb][8 * s2 + 3]);
                    pk.z = pkbf(S[kb][8 * s2 + 4], S[kb][8 * s2 + 5]); pk.w = pkbf(S[kb][8 * s2 + 6], S[kb][8 * s2 + 7]); const bf16x8_t pf = __builtin_bit_cast(bf16x8_t, pk);
                    const unsigned short* vp = VTb + r * SW_VST + kb * 32 + 16 * s2 + 4 * h;
                    { const s16x4_t lo = *(const s16x4_t*)vp, hi = *(const s16x4_t*)(vp + 8); O0 = MFMA32(__builtin_shufflevector(lo, hi, 0, 1, 2, 3, 4, 5, 6, 7), pf, O0); }
                    { const s16x4_t lo = *(const s16x4_t*)(vp + 32 * SW_VST), hi = *(const s16x4_t*)(vp + 32 * SW_VST + 8); O1 = MFMA32(__builtin_shufflevector(lo, hi, 0, 1, 2, 3, 4, 5, 6, 7), pf, O1); } }
            if (cn < CEND) SW_STORE(cn, bi ^ 1);
            __syncthreads();
            ci = cn; bi ^= 1;
        }
        { const float lt = lrun + __shfl_xor(lrun, 32), inv = 1.f / lt;
          pg8::bf16_t* op = (pg8::bf16_t*)MIX + (size_t)(qrow0 + ql) * D_ + 512 + hq * 64 + 4 * h;
#pragma unroll
          for (int g4 = 0; g4 < 4; ++g4) { u2_t wv; wv.x = pkbf(O0[4 * g4] * inv, O0[4 * g4 + 1] * inv); wv.y = pkbf(O0[4 * g4 + 2] * inv, O0[4 * g4 + 3] * inv); *(u2_t*)(op + 8 * g4) = wv;
              wv.x = pkbf(O1[4 * g4] * inv, O1[4 * g4 + 1] * inv); wv.y = pkbf(O1[4 * g4 + 2] * inv, O1[4 * g4 + 3] * inv); *(u2_t*)(op + 32 + 8 * g4) = wv; } }
#undef SW_OK
#undef SW_ROW0
#undef SW_LOAD
#undef SW_STORE
    }
    __syncthreads();
}

constexpr int GC_QST = 72, GC_VST = 68;
__device__ __forceinline__ void ph_gla_chunk(unsigned char* lds, const AT* PROJ, const float* dec_w2, const float* dec_b, float* GLAO) {
    unsigned short* QI = (unsigned short*)lds;
    unsigned short* KI = QI + 2 * 64 * GC_QST;
    unsigned short* KOT = KI + 2 * 64 * GC_QST;
    unsigned short* VT = KOT + 2 * 64 * GC_QST;
    unsigned short* ST = VT + 2 * 32 * GC_VST;
    float* TOT = (float*)(ST + 2 * 32 * GC_QST);
    float* ETOT = TOT + 8 * 64;
    unsigned short* LRS = (unsigned short*)(ETOT + 2 * 64);
    const int tid = (int)tid_now(), w = tid >> 6, lane = tid & 63, r = lane & 31, h = lane >> 5;
    const int d = lane;
    constexpr int NCH = (L_ + T_) / 64;
    f32x16_t zero;
#pragma unroll
    for (int i = 0; i < 16; ++i) zero[i] = 0.f;
    for (int it = blockIdx.x; it < B_ * 32; it += gridDim.x) {
        const int vq = it & 3, z = (it >> 2) & 1, hh = (it >> 3) & 3, b = it >> 5;
        float w2c[16];
#pragma unroll
        for (int rr = 0; rr < 16; ++rr) w2c[rr] = dec_w2[(z * 16 + rr) * 256 + hh * 64 + d];
        const float dbc = dec_b[z * 256 + hh * 64 + d];
        f32x16_t Sst0 = zero, Sst1 = zero;
        __syncthreads();
        if (w == 2) {
#pragma unroll
            for (int i = 0; i < 18; ++i) ((unsigned*)(ST))[lane + 64 * i] = 0u; }
        float gq[8], gk[8], gla[8]; unsigned short gv[4]; pg8::u32x4 glr;
#define GC_LOADLR(c) do { if (tid < 128) { const int m_ = scan_token(b, z, (c) * 64 + (tid >> 1)); glr = *(const pg8::u32x4*)(PROJ + (size_t)m_ * PROJW + C_LR + z * 16 + (tid & 1) * 8); } } while (0)
#define GC_STORELR(bi) do { if (tid < 128) *(pg8::u32x4*)(LRS + (bi) * 1024 + (tid >> 1) * 16 + (tid & 1) * 8) = glr; } while (0)
#define GC_LOADQKV(c) do { _Pragma("unroll") for (int t_ = 0; t_ < 8; ++t_) { const int m_ = scan_token(b, z, (c) * 64 + w * 8 + t_); const AT* pr_ = PROJ + (size_t)m_ * PROJW; \
            gq[t_] = ldf(pr_ + C_GQ + hh * 64 + d) * 0.125f; gk[t_] = ldf(pr_ + C_GK + hh * 64 + d); } \
        _Pragma("unroll") for (int q_ = 0; q_ < 4; ++q_) { const int e_ = tid + 512 * q_, j_ = e_ >> 5, v_ = e_ & 31; const int m_ = scan_token(b, z, (c) * 64 + j_); \
            gv[q_] = ((const unsigned short*)(PROJ + (size_t)m_ * PROJW + C_GV + hh * 128 + vq * 32))[v_]; } } while (0)
#define GC_LA(bi) do { _Pragma("unroll") for (int t_ = 0; t_ < 8; ++t_) { const unsigned short* lp_ = LRS + (bi) * 1024 + (w * 8 + t_) * 16; const pg8::u32x4 l0_ = *(const pg8::u32x4*)lp_, l1_ = *(const pg8::u32x4*)(lp_ + 8); \
            float a8_[8], b8_[8]; unpk8(l0_, a8_); unpk8(l1_, b8_); float x_ = dbc; _Pragma("unroll") for (int q_ = 0; q_ < 8; ++q_) { x_ += a8_[q_] * w2c[q_]; x_ += b8_[q_] * w2c[8 + q_]; } \
            gla[t_] = (fminf(x_, 0.f) - __logf(1.f + __expf(-fabsf(x_)))) * 0.0625f; } } while (0)
#define GC_STORE1() do { float run_ = 0.f; _Pragma("unroll") for (int t_ = 0; t_ < 8; ++t_) { run_ += gla[t_]; gla[t_] = run_; } TOT[w * 64 + d] = run_; } while (0)
#define GC_STORE2(bi) do { float off_ = 0.f, tot_ = 0.f; _Pragma("unroll") for (int q_ = 0; q_ < 8; ++q_) { const float x_ = TOT[q_ * 64 + d]; tot_ += x_; off_ += q_ < w ? x_ : 0.f; } \
        if (w == 0) ETOT[(bi) * 64 + d] = __expf(tot_); \
        _Pragma("unroll") for (int t_ = 0; t_ < 8; ++t_) { const float bc_ = gla[t_] + off_; const int tt_ = w * 8 + t_; \
            QI[(bi) * 64 * GC_QST + tt_ * GC_QST + d] = f2bf_bits(gq[t_] * __expf(bc_)); KI[(bi) * 64 * GC_QST + tt_ * GC_QST + d] = f2bf_bits(gk[t_] * __expf(-bc_)); \
            KOT[(bi) * 64 * GC_QST + d * GC_QST + tt_] = f2bf_bits(gk[t_] * __expf(tot_ - bc_)); } \
        _Pragma("unroll") for (int q_ = 0; q_ < 4; ++q_) { const int e_ = tid + 512 * q_, j_ = e_ >> 5, v_ = e_ & 31; VT[(bi) * 32 * GC_VST + v_ * GC_VST + j_] = gv[q_]; } } while (0)
        GC_LOADLR(0); GC_LOADQKV(0); GC_STORELR(0); __syncthreads();
        GC_LA(0); GC_STORE1(); if (NCH > 1) GC_LOADLR(1); __syncthreads(); GC_STORE2(0); if (NCH > 1) GC_STORELR(1); __syncthreads();
        for (int c = 0; c < NCH; ++c) {
            const int bi = c & 1;
            if (c + 1 < NCH) GC_LOADQKV(c + 1);
            if (c + 2 < NCH) GC_LOADLR(c + 2);
            const unsigned short* QIb = QI + bi * 64 * GC_QST; const unsigned short* KIb = KI + bi * 64 * GC_QST; const unsigned short* KOTb = KOT + bi * 64 * GC_QST;
            const unsigned short* VTb = VT + bi * 32 * GC_VST; const unsigned short* STb = ST + bi * 32 * GC_QST;
            if (w < 2) {
                bf16x8_t qf[4];
#pragma unroll
                for (int s2 = 0; s2 < 4; ++s2) qf[s2] = *(const bf16x8_t*)(QIb + (w * 32 + r) * GC_QST + 16 * s2 + 8 * h);
                f32x16_t O = zero;
#pragma unroll
                for (int s2 = 0; s2 < 4; ++s2) { const bf16x8_t sf = *(const bf16x8_t*)(STb + r * GC_QST + 16 * s2 + 8 * h); O = MFMA32(sf, qf[s2], O); }
#pragma unroll
                for (int jb = 0; jb < 2; ++jb) if (jb <= w) {
                    f32x16_t A = zero;
#pragma unroll
                    for (int s2 = 0; s2 < 4; ++s2) { const bf16x8_t kf = *(const bf16x8_t*)(KIb + (jb * 32 + r) * GC_QST + 16 * s2 + 8 * h); A = MFMA32(kf, qf[s2], A); }
                    if (jb == w) {
#pragma unroll
                        for (int i = 0; i < 16; ++i) { const int jj = (i & 3) + 8 * (i >> 2) + 4 * h; const bool ok = z == 0 ? jj <= r : jj < r; A[i] = ok ? A[i] : 0.f; } }
#pragma unroll
                    for (int s2 = 0; s2 < 2; ++s2) { pg8::u32x4 pk; pk.x = pkbf(A[8 * s2], A[8 * s2 + 1]); pk.y = pkbf(A[8 * s2 + 2], A[8 * s2 + 3]); pk.z = pkbf(A[8 * s2 + 4], A[8 * s2 + 5]); pk.w = pkbf(A[8 * s2 + 6], A[8 * s2 + 7]);
                        const unsigned short* vp = VTb + r * GC_VST + jb * 32 + 16 * s2 + 4 * h; const s16x4_t lo = *(const s16x4_t*)vp, hi = *(const s16x4_t*)(vp + 8);
                        O = MFMA32(__builtin_shufflevector(lo, hi, 0, 1, 2, 3, 4, 5, 6, 7), __builtin_bit_cast(bf16x8_t, pk), O); } }
                const int m = scan_token(b, z, c * 64 + w * 32 + r);
                unsigned short* op = (unsigned short*)GLAO + ((size_t)z * NTOK + m) * 512 + hh * 128 + vq * 32 + 4 * h;
#pragma unroll
                for (int g4 = 0; g4 < 4; ++g4) { u2_t o4; o4.x = pkbf(O[4 * g4], O[4 * g4 + 1]); o4.y = pkbf(O[4 * g4 + 2], O[4 * g4 + 3]); *(u2_t*)(op + 8 * g4) = o4; }
            } else if (w == 2) {
                f32x16_t D0 = zero, D1 = zero;
#pragma unroll
                for (int s2 = 0; s2 < 4; ++s2) { const unsigned short* vq_ = VTb + r * GC_VST + 16 * s2 + 8 * h; const s16x4_t vlo = *(const s16x4_t*)vq_, vhi = *(const s16x4_t*)(vq_ + 4); const bf16x8_t vf = __builtin_shufflevector(vlo, vhi, 0, 1, 2, 3, 4, 5, 6, 7);
                    const bf16x8_t k0 = *(const bf16x8_t*)(KOTb + r * GC_QST + 16 * s2 + 8 * h), k1 = *(const bf16x8_t*)(KOTb + (32 + r) * GC_QST + 16 * s2 + 8 * h);
                    D0 = MFMA32(k0, vf, D0); D1 = MFMA32(k1, vf, D1); }
                unsigned short* sn = ST + (bi ^ 1) * 32 * GC_QST + r * GC_QST;
#pragma unroll
                for (int g4 = 0; g4 < 4; ++g4) { const int d0 = 8 * g4 + 4 * h; const f4_t e0 = *(const f4_t*)(ETOT + bi * 64 + d0), e1 = *(const f4_t*)(ETOT + bi * 64 + 32 + d0);
                    Sst0[4 * g4] = Sst0[4 * g4] * e0.x + D0[4 * g4]; Sst0[4 * g4 + 1] = Sst0[4 * g4 + 1] * e0.y + D0[4 * g4 + 1]; Sst0[4 * g4 + 2] = Sst0[4 * g4 + 2] * e0.z + D0[4 * g4 + 2]; Sst0[4 * g4 + 3] = Sst0[4 * g4 + 3] * e0.w + D0[4 * g4 + 3];
                    Sst1[4 * g4] = Sst1[4 * g4] * e1.x + D1[4 * g4]; Sst1[4 * g4 + 1] = Sst1[4 * g4 + 1] * e1.y + D1[4 * g4 + 1]; Sst1[4 * g4 + 2] = Sst1[4 * g4 + 2] * e1.z + D1[4 * g4 + 2]; Sst1[4 * g4 + 3] = Sst1[4 * g4 + 3] * e1.w + D1[4 * g4 + 3];
                    u2_t w0; w0.x = pkbf(Sst0[4 * g4], Sst0[4 * g4 + 1]); w0.y = pkbf(Sst0[4 * g4 + 2], Sst0[4 * g4 + 3]); *(u2_t*)(sn + d0) = w0;
                    u2_t w1; w1.x = pkbf(Sst1[4 * g4], Sst1[4 * g4 + 1]); w1.y = pkbf(Sst1[4 * g4 + 2], Sst1[4 * g4 + 3]); *(u2_t*)(sn + 32 + d0) = w1; }
            }
            if (c + 1 < NCH) { GC_LA(bi ^ 1); GC_STORE1(); }
            __syncthreads();
            if (c + 1 < NCH) GC_STORE2(bi ^ 1);
            if (c + 2 < NCH) GC_STORELR(bi);
            __syncthreads();
        }
#undef GC_LOADLR
#undef GC_STORELR
#undef GC_LOADQKV
#undef GC_LA
#undef GC_STORE1
#undef GC_STORE2
    }
    __syncthreads();
}

typedef float f32x4m_t __attribute__((ext_vector_type(4)));
__device__ __forceinline__ bf16x8_t cvt8bf(f4_t a, f4_t b) { pg8::u32x4 pk; pk.x = pkbf(a.x, a.y); pk.y = pkbf(a.z, a.w); pk.z = pkbf(b.x, b.y); pk.w = pkbf(b.z, b.w); return __builtin_bit_cast(bf16x8_t, pk); }
__device__ __forceinline__ void ph_rw_scan3(unsigned char* lds, const AT* R, const AT* K, const AT* V, const float* k_k, const AT* A, const AT* DEC, const float* w0, const float* a0, const float* k_a, AT* Y0, AT* Y1,
                                            const float* tsrc_u, const float* tsrc_v, TT* tdst, float* tusc) {
    constexpr int TS = 48, NST = L_ + T_, NCH = NST / TS, RING = 128;
    static_assert(NST % TS == 0 && (TS * 16) % 256 == 0 && RING >= 2 * TS, "scan chunking");
    float* VEC = (float*)lds;
    unsigned short* KKR = (unsigned short*)(VEC + 2 * 2 * TS * 64);
    unsigned short* VV = KKR + 2 * TS * 128;
    float* YB = (float*)(VV + 2 * TS * 64);
    unsigned short* ZR = (unsigned short*)(YB + RING * 64);
    float* AB = (float*)(ZR + 64);
    const int tid = (int)tid_now(), w = tid >> 6, lane = tid & 63, Rl = lane & 15, g = lane >> 4, row = 16 * (w & 3) + Rl, msel = Rl & 3;
    const int tt = tid - 256;
    bf16x8_t zf;
#pragma unroll
    for (int i = 0; i < 8; ++i) zf[i] = 0;
    for (int sc = blockIdx.x; sc < B_ * 32; sc += gridDim.x) {
        const int z = sc & 1, h = (sc >> 1) & 15, b = sc >> 5;
        AT* Y = z == 0 ? Y0 : Y1;
        __syncthreads();
        if (tid < 32) ((unsigned*)ZR)[tid] = 0u;
        f4_t SaL = {0.f, 0.f, 0.f, 0.f}, SaH = SaL, SbL = SaL, SbH = SaL; float sa = 0.f;
        bf16x8_t ra0 = zf, ra1 = zf;
#define RW3_STAGE(c, bi) do { _Pragma("unroll") for (int q_ = 0; q_ < TS * 16 / 256; ++q_) { const int i_ = tt + 256 * q_, ss_ = i_ >> 4, kq_ = i_ & 15; \
            const int m_ = scan_token(b, z, (c) * TS + ss_); const size_t o1_ = (size_t)m_ * D_ + h * 64 + kq_ * 4, o2_ = ((size_t)m_ * 2 + z) * D_ + h * 64 + kq_ * 4; \
            const u2_t gk_ = *(const u2_t*)(K + o1_), gv_ = *(const u2_t*)(V + o1_), ga_ = *(const u2_t*)(A + o2_), gd_ = *(const u2_t*)(DEC + o2_); u2_t gr_; \
            if (m_ < NLAT) gr_ = *(const u2_t*)(R + o1_); else { gr_.x = 0u; gr_.y = 0u; } \
            const f4_t ka4_ = *(const f4_t*)(k_a + h * 64 + kq_ * 4), w04_ = *(const f4_t*)(w0 + z * D_ + h * 64 + kq_ * 4), a04_ = *(const f4_t*)(a0 + z * D_ + h * 64 + kq_ * 4), kk4c_ = *(const f4_t*)(k_k + h * 64 + kq_ * 4); \
            const int tn1_ = (c) * TS + ss_ + 1 < NST ? (c) * TS + ss_ + 1 : NST - 1; const u2_t gkn_ = *(const u2_t*)(K + (size_t)scan_token(b, z, tn1_) * D_ + h * 64 + kq_ * 4); \
            const f4_t k_ = bf4(gk_), ar_ = bf4(ga_) + a04_, wr_ = bf4(gd_) + w04_; f4_t a_, w_, kk_ = k_ * kk4c_, kkn_ = bf4(gkn_) * kk4c_; \
            kk_ = kk_ * rsqrtf(fmaxf(allsum16(kk_.x * kk_.x + kk_.y * kk_.y + kk_.z * kk_.z + kk_.w * kk_.w), 1e-24f)); \
            kkn_ = kkn_ * rsqrtf(fmaxf(allsum16(kkn_.x * kkn_.x + kkn_.y * kkn_.y + kkn_.z * kkn_.z + kkn_.w * kkn_.w), 1e-24f));     \
            a_.x = fsig(ar_.x); a_.y = fsig(ar_.y); a_.z = fsig(ar_.z); a_.w = fsig(ar_.w); \
            w_.x = __expf(-0.6065306597f * fsig(wr_.x)); w_.y = __expf(-0.6065306597f * fsig(wr_.y)); w_.z = __expf(-0.6065306597f * fsig(wr_.z)); w_.w = __expf(-0.6065306597f * fsig(wr_.w)); \
            float* vq_ = VEC + (bi) * 2 * TS * 64 + ss_ * 64 + kq_ * 4; *(f4_t*)vq_ = w_; \
            const f4_t qk_ = kk_ * a_, dk_ = k_ * (1.f + (a_ - 1.f) * ka4_); \
            { const float al_ = allsum16(qk_.x * kkn_.x + qk_.y * kkn_.y + qk_.z * kkn_.z + qk_.w * kkn_.w), be_ = allsum16(dk_.x * kkn_.x + dk_.y * kkn_.y + dk_.z * kkn_.z + dk_.w * kkn_.w); \
              if (kq_ == 0) { f2_t ab_; ab_.x = al_; ab_.y = be_; *(f2_t*)(AB + (bi) * TS * 2 + ss_ * 2) = ab_; } } \
            { unsigned* qd_ = (unsigned*)(VEC + (bi) * 2 * TS * 64 + TS * 64) + ss_ * 64 + (4 * (kq_ & 3)) * 4 + (kq_ >> 2); \
              qd_[0] = pkbf(qk_.x, dk_.x); qd_[4] = pkbf(qk_.y, dk_.y); qd_[8] = pkbf(qk_.z, dk_.z); qd_[12] = pkbf(qk_.w, dk_.w); }     \
            const f4_t xr_ = w_ * kkn_; u2_t kb_; kb_.x = pkbf(xr_.x, xr_.y); kb_.y = pkbf(xr_.z, xr_.w);     \
            unsigned short* kr_ = KKR + (bi) * TS * 128 + ss_ * 128 + 32 * (kq_ >> 3) + 8 * (kq_ & 3) + 4 * ((kq_ >> 2) & 1); *(u2_t*)kr_ = kb_; *(u2_t*)(kr_ + 64) = gr_;     \
            *(u2_t*)(VV + (bi) * TS * 64 + ss_ * 64 + kq_ * 4) = gv_; } } while (0)
        if (w >= 4) RW3_STAGE(0, 0);
        __syncthreads();
        for (int c = 0; c < NCH; ++c) {
            const int bi = c & 1;
            if (w >= 4) { if (c + 1 < NCH) RW3_STAGE(c + 1, bi ^ 1);
                { constexpr size_t NG = (size_t)16384 * D_ / 16; const size_t per = (size_t)gridDim.x * NCH * 256; const size_t base = ((size_t)blockIdx.x * NCH + c) * 256 + tt;
                  for (size_t gi = base; gi < 2 * NG; gi += per) { if (gi < NG) cvt_row_i8(tsrc_u, tdst, tusc, gi >> 6, (int)(gi & 63)); else cvt_tab16(tsrc_v, tdst + (size_t)16384 * D_, gi - NG, 1.f); } } }
            else {
                __builtin_amdgcn_s_setprio(3);
                const float* vb = VEC + bi * 2 * TS * 64 + 4 * g; const unsigned short* vvb = VV + bi * TS * 64 + row;
                const unsigned* qp = g == 0 ? (const unsigned*)(VEC + bi * 2 * TS * 64 + TS * 64) + Rl * 4 : (const unsigned*)ZR; const int q_str = g == 0 ? 64 : 0;
                const unsigned short* pa = msel == 0 ? KKR + bi * TS * 128 + 8 * g : (msel == 1 ? KKR + bi * TS * 128 - 128 + 64 + 8 * g : ZR + 8 * g); const int sa_str = msel < 2 ? 128 : 0;
                bf16x8_t a0f = msel == 1 ? ra0 : *(const bf16x8_t*)(pa), a1f = msel == 1 ? ra1 : *(const bf16x8_t*)(pa + 32);
                f4_t wA = *(const f4_t*)(vb), wB = *(const f4_t*)(vb + 16), wC = *(const f4_t*)(vb + 32), wD = *(const f4_t*)(vb + 48);
                pg8::u32x4 qd = *(const pg8::u32x4*)qp;
                float vr = __uint_as_float((unsigned)vvb[0] << 16); const float* abp = AB + bi * TS * 2; f2_t ab = *(const f2_t*)abp;
#pragma unroll 8
                for (int s = 0; s < TS; ++s) {
                    const int sn = s + 1 < TS ? s + 1 : s;
                    const bf16x8_t na0 = *(const bf16x8_t*)(pa + sn * sa_str), na1 = *(const bf16x8_t*)(pa + sn * sa_str + 32);
                    const f4_t nwA = *(const f4_t*)(vb + sn * 64), nwB = *(const f4_t*)(vb + sn * 64 + 16), nwC = *(const f4_t*)(vb + sn * 64 + 32), nwD = *(const f4_t*)(vb + sn * 64 + 48);
                    const pg8::u32x4 nqd = *(const pg8::u32x4*)(qp + sn * q_str);
                    const float nvr = __uint_as_float((unsigned)vvb[sn * 64] << 16); const f2_t nab = *(const f2_t*)(abp + sn * 2);
                    const f32x4m_t Dz = {0.f, 0.f, 0.f, 0.f};
                    const f32x4m_t D1 = __builtin_amdgcn_mfma_f32_16x16x32_bf16(a0f, cvt8bf(SaL, SaH), Dz, 0, 0, 0);
                    const f32x4m_t D2 = __builtin_amdgcn_mfma_f32_16x16x32_bf16(a1f, cvt8bf(SbL, SbH), Dz, 0, 0, 0);
                    SaL = SaL * wA; SaH = SaH * wB; SbL = SbL * wC; SbH = SbH * wD;
                    const float pn = D1[0] + D2[0];
                    if (g == 0) YB[((c * TS + s - 1) & (RING - 1)) * 64 + row] = D1[1] + D2[1];
                    { u2_t bq; bq.x = g == 0 ? pkbf(-sa, vr) : 0u; bq.y = 0u; const s16x4_t bsv = __builtin_bit_cast(s16x4_t, bq);
                      u2_t aq; aq.y = 0u;
                      aq.x = qd.x; SaL = __builtin_amdgcn_mfma_f32_16x16x16bf16_1k(__builtin_bit_cast(s16x4_t, aq), bsv, SaL, 0, 0, 0);
                      aq.x = qd.y; SaH = __builtin_amdgcn_mfma_f32_16x16x16bf16_1k(__builtin_bit_cast(s16x4_t, aq), bsv, SaH, 0, 0, 0);
                      aq.x = qd.z; SbL = __builtin_amdgcn_mfma_f32_16x16x16bf16_1k(__builtin_bit_cast(s16x4_t, aq), bsv, SbL, 0, 0, 0);
                      aq.x = qd.w; SbH = __builtin_amdgcn_mfma_f32_16x16x16bf16_1k(__builtin_bit_cast(s16x4_t, aq), bsv, SbH, 0, 0, 0); }
                    sa = pn - sa * ab.x + vr * ab.y;
                    a0f = na0; a1f = na1; wA = nwA; wB = nwB; wC = nwC; wD = nwD; qd = nqd; vr = nvr; ab = nab;
                }
                __builtin_amdgcn_s_setprio(0);
                if (msel == 1) { ra0 = *(const bf16x8_t*)(KKR + bi * TS * 128 + (TS - 1) * 128 + 64 + 8 * g); ra1 = *(const bf16x8_t*)(KKR + bi * TS * 128 + (TS - 1) * 128 + 64 + 8 * g + 32); }
                if (c == NCH - 1) {
                    f32x4m_t Dm = {0.f, 0.f, 0.f, 0.f};
                    Dm = __builtin_amdgcn_mfma_f32_16x16x32_bf16(msel == 1 ? ra0 : zf, cvt8bf(SaL, SaH), Dm, 0, 0, 0);
                    Dm = __builtin_amdgcn_mfma_f32_16x16x32_bf16(msel == 1 ? ra1 : zf, cvt8bf(SbL, SbH), Dm, 0, 0, 0);
                    if (g == 0) YB[((NST - 1) & (RING - 1)) * 64 + row] = Dm[1];
                }
            }
            __syncthreads();
            if (w >= 4) {
#pragma unroll
                for (int i = 0; i < TS * 64 / 256; ++i) { const int e = tt + 256 * i, sl = e >> 6, vx = e & 63; const int G = c * TS - 1 + sl;
                    if (G >= L_) { const int m = scan_token(b, z, G); stf(Y + (size_t)m * D_ + h * 64 + vx, YB[(G & (RING - 1)) * 64 + vx]); } } }
            if (c == NCH - 1 && tid < 64) { const int G = NST - 1; const int m = scan_token(b, z, G); stf(Y + (size_t)m * D_ + h * 64 + tid, YB[(G & (RING - 1)) * 64 + tid]); }
        }
#undef RW3_STAGE
    }
    __syncthreads();
}

__device__ __forceinline__ void ph_wc2(float* ldsf, const float* peer_wq, const float* peer_k1, const float* peer_k2, AT* WQ0) {
    unsigned short* KA = (unsigned short*)ldsf;
    unsigned short* WB = KA + 128 * 136;
    const int tid = (int)tid_now(), w = tid >> 6, lane = tid & 63, r = lane & 31, h = lane >> 5;
    f32x16_t zero;
#pragma unroll
    for (int i = 0; i < 16; ++i) zero[i] = 0.f;
    for (int tile = blockIdx.x; tile < 256; tile += gridDim.x) {
        const int layer = tile >> 7, g = (tile >> 3) & 15, kt = tile & 7;
        const float* key = ((g & 1) ? peer_k2 : peer_k1) + (size_t)layer * 8 * 128 * 128 + (size_t)(g >> 1) * 128 * 128;
        const float* wq = peer_wq + (size_t)layer * D_ * 2048 + (size_t)(kt * 128) * 2048 + g * 128;
        __syncthreads();
#pragma unroll
        for (int i = 0; i < 8; ++i) { const int e = tid * 4 + i * 2048, row = e >> 7, col = e & 127; const f4_t v = *(const f4_t*)(key + e), u = *(const f4_t*)(wq + (size_t)row * 2048 + col);
            u2_t a; a.x = pkbf(v.x, v.y); a.y = pkbf(v.z, v.w); *(u2_t*)(KA + row * 136 + col) = a; u2_t bq; bq.x = pkbf(u.x, u.y); bq.y = pkbf(u.z, u.w); *(u2_t*)(WB + row * 136 + col) = bq; }
        __syncthreads();
        const int nb = w & 3, kh = w >> 2;
        f32x16_t acc0 = zero, acc1 = zero;
#pragma unroll
        for (int s2 = 0; s2 < 8; ++s2) { const bf16x8_t af = *(const bf16x8_t*)(KA + (nb * 32 + r) * 136 + 16 * s2 + 8 * h);
            const bf16x8_t b0 = *(const bf16x8_t*)(WB + (kh * 64 + r) * 136 + 16 * s2 + 8 * h), b1 = *(const bf16x8_t*)(WB + (kh * 64 + 32 + r) * 136 + 16 * s2 + 8 * h);
            acc0 = MFMA32(af, b0, acc0); acc1 = MFMA32(af, b1, acc1); }
        pg8::bf16_t* out = (pg8::bf16_t*)WQ0 + (size_t)layer * 2048 * D_ + (size_t)(g * 128 + nb * 32) * D_ + kt * 128 + kh * 64 + r;
#pragma unroll
        for (int i = 0; i < 16; ++i) { const int n = (i & 3) + 8 * (i >> 2) + 4 * h; out[(size_t)n * D_] = f2bf_bits(acc0[i]); out[(size_t)n * D_ + 32] = f2bf_bits(acc1[i]); }
    }
    __syncthreads();
}
__device__ __forceinline__ float wave_allsum(float v) { return wave_total(v); }
__device__ __forceinline__ unsigned pk_bf16(float a, float b) { return pg8::cvt_pk_bf16(a, b); }
__device__ __forceinline__ void ph_wc2(float* ldsf, const float* peer_wq, const float* peer_k1, const float* peer_k2, AT* WQ0);
__device__ __forceinline__ void wprep_items(float* scr, int lane, int gw, int nw, const float* W, int K, int N, int Npad, AT* WT) {
    const int nblk = Npad / 32, nitems = (K / 64) * nblk;
    for (int it = gw; it < nitems; it += nw) { const int kb = it / nblk, nb = it % nblk, k0 = 64 * kb, n0 = 32 * nb; const int nn = n0 + (lane & 31);
        { const int c4 = lane & 7; pg8::f32x4 v[8];
#pragma unroll
          for (int i = 0; i < 8; ++i) { const int kk = 8 * i + (lane >> 3); v[i] = n0 < N ? *(const pg8::f32x4*)(W + (size_t)(k0 + kk) * N + n0 + 4 * c4) : pg8::f32x4{0.f, 0.f, 0.f, 0.f}; }
#pragma unroll
          for (int i = 0; i < 8; ++i) { const int kk = 8 * i + (lane >> 3); float* d = scr + kk * 33 + 4 * c4; d[0] = v[i][0]; d[1] = v[i][1]; d[2] = v[i][2]; d[3] = v[i][3]; } }
        asm volatile("s_waitcnt lgkmcnt(0)" ::: "memory");
        const int c = lane & 7;
#pragma unroll
        for (int j = 0; j < 4; ++j) { const int n = (lane >> 3) + 8 * j; const float* q = scr + (8 * c) * 33 + n; pg8::u32x4 o;
            o.x = pk_bf16(q[0], q[33]); o.y = pk_bf16(q[2 * 33], q[3 * 33]); o.z = pk_bf16(q[4 * 33], q[5 * 33]); o.w = pk_bf16(q[6 * 33], q[7 * 33]);
            *(pg8::u32x4*)((pg8::bf16_t*)WT + (size_t)(n0 + n) * K + k0 + 8 * c) = o; }
        asm volatile("s_waitcnt lgkmcnt(0)" ::: "memory"); }
}
__device__ __forceinline__ void ph_adaln2(float* ldsf, const float* c, const float* c_ctx, const float* ada_w, const float* ada_b, float* MOD) {
    static_assert(B_ + 1 <= 12, "adaln row padding");
    float* sv = ldsf;
    float* part = ldsf + D_ * 12;
    const int tid = (int)tid_now(), w = tid >> 6, lane = tid & 63;
    __syncthreads();
    for (int i = tid; i < D_ * 12; i += NT) { const int k = i / 12, rr = i % 12; float x = 0.f; if (rr < B_) x = c[rr * D_ + k]; else if (rr == B_) x = c_ctx[k]; sv[i] = rr <= B_ ? x * fsig(x) : 0.f; }
    __syncthreads();
    const int nitem = 2 * (D6 / 64);
    for (int it = blockIdx.x; it < nitem; it += gridDim.x) { const int layer = it / (D6 / 64), col = (it % (D6 / 64)) * 64 + lane;
        const float* wp = ada_w + (size_t)layer * D_ * D6 + (size_t)(w * 128) * D6 + col; const float* sp = sv + (w * 128) * 12;
        float acc[12];
#pragma unroll
        for (int rr = 0; rr < 12; ++rr) acc[rr] = 0.f;
#pragma unroll 32
        for (int k = 0; k < 128; ++k) { const float wv = wp[(size_t)k * D6]; const f4_t s0 = *(const f4_t*)(sp + k * 12), s1 = *(const f4_t*)(sp + k * 12 + 4), s2 = *(const f4_t*)(sp + k * 12 + 8);
            acc[0] += s0.x * wv; acc[1] += s0.y * wv; acc[2] += s0.z * wv; acc[3] += s0.w * wv; acc[4] += s1.x * wv; acc[5] += s1.y * wv; acc[6] += s1.z * wv; acc[7] += s1.w * wv;
            acc[8] += s2.x * wv; acc[9] += s2.y * wv; acc[10] += s2.z * wv; acc[11] += s2.w * wv; }
        __syncthreads();
#pragma unroll
        for (int rr = 0; rr < 12; ++rr) part[(w * 12 + rr) * 64 + lane] = acc[rr];
        __syncthreads();
        for (int o = tid; o < (B_ + 1) * 64; o += NT) { const int rr = o >> 6, cl = o & 63; float t = ada_b[layer * D6 + (it % (D6 / 64)) * 64 + cl];
#pragma unroll
            for (int q = 0; q < 8; ++q) t += part[(q * 12 + rr) * 64 + cl];
            MOD[((size_t)layer * (B_ + 1) + rr) * D6 + (it % (D6 / 64)) * 64 + cl] = t; }
    }
    __syncthreads();
}
__device__ __forceinline__ float row_rs(const float* xr, int lane, f4_t (&v)[4]) {
    float ss = 0.f;
#pragma unroll
    for (int j = 0; j < 4; ++j) { v[j] = *(const f4_t*)(xr + lane * 4 + 256 * j); ss += v[j].x * v[j].x + v[j].y * v[j].y + v[j].z * v[j].z + v[j].w * v[j].w; }
    return rsqrtf(wave_allsum(ss) * (1.f / D_) + 1e-6f);
}
__device__ __forceinline__ float row_rs16(const unsigned short* xr, int lane, f4_t (&v)[4]) {
    float ss = 0.f;
#pragma unroll
    for (int j = 0; j < 4; ++j) { const u2_t q = *(const u2_t*)(xr + lane * 4 + 256 * j); v[j] = bf4(q); ss += v[j].x * v[j].x + v[j].y * v[j].y + v[j].z * v[j].z + v[j].w * v[j].w; }
    return rsqrtf(wave_allsum(ss) * (1.f / D_) + 1e-6f);
}
__device__ __forceinline__ void mod_row(const f4_t (&v)[4], float rs, const float* g, const float* mr, int ishift, int iscale, int lane, f4_t (&y)[4]) {
#pragma unroll
    for (int j = 0; j < 4; ++j) { const int cI = lane * 4 + 256 * j; const f4_t gg = *(const f4_t*)(g + cI), sc = *(const f4_t*)(mr + iscale * D_ + cI), sh = *(const f4_t*)(mr + ishift * D_ + cI);
        y[j] = v[j] * rs * gg * (1.f + sc) + sh; }
}
__device__ __forceinline__ void st_row_bf16(AT* o, int lane, const f4_t (&y)[4]) {
#pragma unroll
    for (int j = 0; j < 4; ++j) { u2_t w; w.x = pk_bf16(y[j].x, y[j].y); w.y = pk_bf16(y[j].z, y[j].w); *(u2_t*)((pg8::bf16_t*)o + lane * 4 + 256 * j) = w; }
}
__device__ __forceinline__ void ph_modnorm2(int ntok, const float* XC, const float* g, const float* MODL, int ishift, int iscale, AT* out, float* fout, const float* xsrc = nullptr, const float* csrc = nullptr) {
    const int tn_ = (int)tid_now(), lane = tn_ & 63, gw = blockIdx.x * 8 + (tn_ >> 6), nw = gridDim.x * 8;
    for (int m = gw; m < ntok; m += nw) { f4_t v[4], y[4]; const float rs = xsrc ? row_rs(m < NLAT ? xsrc + (size_t)m * D_ : csrc + (size_t)(m - NLAT) * D_, lane, v) : row_rs16((const unsigned short*)XC + (size_t)m * D_, lane, v);
        if (fout) {
#pragma unroll
            for (int j = 0; j < 4; ++j) { const int cI = lane * 4 + 256 * j; *(f4_t*)(fout + (size_t)m * D_ + cI) = v[j] * rs * *(const f4_t*)(g + cI); }
        } else { mod_row(v, rs, g, MODL + (size_t)tok_row(m) * D6, ishift, iscale, lane, y); st_row_bf16(out + (size_t)m * D_, lane, y); } }
}
__device__ __forceinline__ void ph_norm_mix(const float* XC, const float* g, const float* MODL, const float* mu, AT* XS, AT* HX) {
    const int tn_ = (int)tid_now(), lane = tn_ & 63, gw = blockIdx.x * 8 + (tn_ >> 6), nw = gridDim.x * 8;
    for (int m = gw; m < NTOK; m += nw) { const TokInfo ti = tokinfo(m); const float* mr = MODL + (size_t)tok_row(m) * D6;
        f4_t v[4], h[4], hp[4], hn[4];
        { const float rs = row_rs16((const unsigned short*)XC + (size_t)m * D_, lane, v); mod_row(v, rs, g, mr, 0, 1, lane, h); }
        if (ti.pos > 0) { const float rs = row_rs16((const unsigned short*)XC + (size_t)(m - 1) * D_, lane, v); mod_row(v, rs, g, mr, 0, 1, lane, hp); }
        else {
#pragma unroll
            for (int j = 0; j < 4; ++j) hp[j] = (f4_t){0.f, 0.f, 0.f, 0.f}; }
        if (ti.pos < ti.len - 1) { const float rs = row_rs16((const unsigned short*)XC + (size_t)(m + 1) * D_, lane, v); mod_row(v, rs, g, mr, 0, 1, lane, hn); }
        else {
#pragma unroll
            for (int j = 0; j < 4; ++j) hn[j] = (f4_t){0.f, 0.f, 0.f, 0.f}; }
        f4_t xx[4], y[4];
#pragma unroll
        for (int j = 0; j < 4; ++j) xx[j] = 0.5f * (hp[j] + hn[j]) - h[j];
        st_row_bf16(HX + (size_t)m * 2048, lane, h); st_row_bf16(HX + (size_t)m * 2048 + 1024, lane, xx);
#pragma unroll
        for (int q = 0; q < 3; ++q) { const float* muq = mu + (q == 0 ? 0 : (q == 1 ? 2 : 3)) * D_;
#pragma unroll
            for (int j = 0; j < 4; ++j) y[j] = h[j] + xx[j] * *(const f4_t*)(muq + lane * 4 + 256 * j);
            st_row_bf16(XS + (size_t)q * (ROWB / SA) + (size_t)m * D_, lane, y); }
    }
}
__device__ __forceinline__ void ph_gla_out2(const AT* PROJ, const float* GLAO, const float* gn, AT* MIX) {
    const int tn_ = (int)tid_now(), lane = tn_ & 63, gw = blockIdx.x * 8 + (tn_ >> 6), nw = gridDim.x * 8;
    for (int m = gw; m < NTOK; m += nw) {
        const unsigned short* o0 = (const unsigned short*)GLAO + (size_t)m * 512 + lane * 8; const unsigned short* o1 = (const unsigned short*)GLAO + ((size_t)NTOK + m) * 512 + lane * 8;
        float x0_[8], x1_[8]; unpk8(*(const pg8::u32x4*)o0, x0_); unpk8(*(const pg8::u32x4*)o1, x1_);
        f4_t a0, a1; a0.x = x0_[0] + x1_[0]; a0.y = x0_[1] + x1_[1]; a0.z = x0_[2] + x1_[2]; a0.w = x0_[3] + x1_[3]; a1.x = x0_[4] + x1_[4]; a1.y = x0_[5] + x1_[5]; a1.z = x0_[6] + x1_[6]; a1.w = x0_[7] + x1_[7];
        float ss = a0.x * a0.x + a0.y * a0.y + a0.z * a0.z + a0.w * a0.w + a1.x * a1.x + a1.y * a1.y + a1.z * a1.z + a1.w * a1.w;
        const float rs = rsqrtf(allsum16(ss) * (1.f / 128.f) + 1e-6f);
        const pg8::u32x4 gt = *(const pg8::u32x4*)(PROJ + (size_t)m * PROJW + C_GG + lane * 8);
        u2_t q; q.x = gt.x; q.y = gt.y; const f4_t g0 = bf4(q); q.x = gt.z; q.y = gt.w; const f4_t g1 = bf4(q);
        const f4_t n0 = *(const f4_t*)(gn + lane * 8), n1 = *(const f4_t*)(gn + lane * 8 + 4);
        f4_t s0, s1; s0.x = g0.x * fsig(g0.x); s0.y = g0.y * fsig(g0.y); s0.z = g0.z * fsig(g0.z); s0.w = g0.w * fsig(g0.w);
        s1.x = g1.x * fsig(g1.x); s1.y = g1.y * fsig(g1.y); s1.z = g1.z * fsig(g1.z); s1.w = g1.w * fsig(g1.w);
        const f4_t r0 = a0 * rs * n0 * s0, r1 = a1 * rs * n1 * s1; pg8::u32x4 w;
        w.x = pk_bf16(r0.x, r0.y); w.y = pk_bf16(r0.z, r0.w); w.z = pk_bf16(r1.x, r1.y); w.w = pk_bf16(r1.z, r1.w);
        *(pg8::u32x4*)((pg8::bf16_t*)MIX + (size_t)m * D_ + lane * 8) = w; }
}
__device__ __forceinline__ void ld16(const AT* p, f4_t (&o)[4]) { const pg8::u32x4 a = *(const pg8::u32x4*)p, b = *(const pg8::u32x4*)(p + 8); u2_t q;
    q.x = a.x; q.y = a.y; o[0] = bf4(q); q.x = a.z; q.y = a.w; o[1] = bf4(q); q.x = b.x; q.y = b.y; o[2] = bf4(q); q.x = b.z; q.y = b.w; o[3] = bf4(q); }
__device__ __forceinline__ float hsum4(f4_t a) { return a.x + a.y + a.z + a.w; }
__device__ __forceinline__ float quadsum(float v) { DPP_ADD(v, 0xB1); DPP_ADD(v, 0x4E); return v; }
__device__ __forceinline__ void ph_rw_out2(const AT* Y0, const AT* Y1, const AT* R, const AT* K, const AT* V, const AT* A, const float* a0, const AT* G, const float* k_a, const float* r_k,
                                           const float* ln_g, const float* ln_b, AT* OUT) {
    const int tn_ = (int)tid_now(), lane = tn_ & 63, gw = blockIdx.x * 8 + (tn_ >> 6), nw = gridDim.x * 8;
    for (int m = gw; m < NLAT; m += nw) { int ln_ = lane; asm volatile("" : "+v"(ln_)); const size_t o1 = (size_t)m * D_ + ln_ * 16; const int cI = ln_ * 16;
        f4_t y[4], t[4], r[4], k[4];
        ld16(Y0 + o1, y); ld16(Y1 + o1, t);
        float s = 0.f;
#pragma unroll
        for (int j = 0; j < 4; ++j) { y[j] += t[j]; s += hsum4(y[j]); }
        const float mean = quadsum(s) * (1.f / 64.f); float q = 0.f;
#pragma unroll
        for (int j = 0; j < 4; ++j) { y[j] -= mean; q += hsum4(y[j] * y[j]); }
        const float rs = rsqrtf(quadsum(q) * (1.f / 64.f) + 64e-5f);
        ld16(R + o1, r); ld16(K + o1, k);
        float bs = 0.f;
#pragma unroll
        for (int z = 0; z < 2; ++z) { ld16(A + ((size_t)m * 2 + z) * D_ + cI, t);
#pragma unroll
            for (int j = 0; j < 4; ++j) { f4_t ar = t[j] + *(const f4_t*)(a0 + z * D_ + cI + 4 * j); f4_t a; a.x = fsig(ar.x); a.y = fsig(ar.y); a.z = fsig(ar.z); a.w = fsig(ar.w);
                bs += hsum4(r[j] * k[j] * (1.f + (a - 1.f) * *(const f4_t*)(k_a + cI + 4 * j)) * *(const f4_t*)(r_k + cI + 4 * j)); } }
        const float bonus = quadsum(bs);
        ld16(V + o1, r); ld16(G + o1, k);
        pg8::u32x4 w0, w1; f4_t o[4];
#pragma unroll
        for (int j = 0; j < 4; ++j) o[j] = (y[j] * rs * *(const f4_t*)(ln_g + cI + 4 * j) + *(const f4_t*)(ln_b + cI + 4 * j) + bonus * r[j]) * k[j];
        w0.x = pk_bf16(o[0].x, o[0].y); w0.y = pk_bf16(o[0].z, o[0].w); w0.z = pk_bf16(o[1].x, o[1].y); w0.w = pk_bf16(o[1].z, o[1].w);
        w1.x = pk_bf16(o[2].x, o[2].y); w1.y = pk_bf16(o[2].z, o[2].w); w1.z = pk_bf16(o[3].x, o[3].y); w1.w = pk_bf16(o[3].z, o[3].w);
        *(pg8::u32x4*)((pg8::bf16_t*)OUT + o1) = w0; *(pg8::u32x4*)((pg8::bf16_t*)OUT + o1 + 8) = w1; }
}
#endif
__device__ __forceinline__ void ph_rw_out(const AT* Y0, const AT* Y1, const AT* R, const AT* K, const AT* V, const AT* A, const float* a0, const AT* G, const float* k_a, const float* r_k,
                                          const float* ln_g, const float* ln_b, AT* OUT) {
    GSTRIDE(i_, NLAT * 16) { int idx = (int)i_;
        int h = idx % 16, m = idx / 16; size_t o1 = (size_t)m * D_ + h * 64;
        float mean = 0.f; for (int n = 0; n < 64; ++n) mean += ldf(Y0 + o1 + n) + ldf(Y1 + o1 + n); mean *= (1.f / 64.f);
        float var = 0.f; for (int n = 0; n < 64; ++n) { float d = ldf(Y0 + o1 + n) + ldf(Y1 + o1 + n) - mean; var += d * d; } var *= (1.f / 64.f);
        float rs = rsqrtf(var + 64e-5f);
        float bonus = 0.f;
        for (int z = 0; z < 2; ++z) for (int n = 0; n < 64; ++n) { float a = sigmoidf_(ldf(A + ((size_t)m * 2 + z) * D_ + h * 64 + n) + a0[z * D_ + h * 64 + n]); float k = ldf(K + o1 + n);
            bonus += ldf(R + o1 + n) * k * (1.f + (a - 1.f) * k_a[h * 64 + n]) * r_k[h * 64 + n]; }
        for (int n = 0; n < 64; ++n) { float y = ldf(Y0 + o1 + n) + ldf(Y1 + o1 + n);
            float o = ((y - mean) * rs * ln_g[h * 64 + n] + ln_b[h * 64 + n] + bonus * ldf(V + o1 + n)) * ldf(G + o1 + n);
            stf(OUT + o1 + n, o); } }
}

struct Params { const float* in[36]; float* out; char* ws; int ph_lo, ph_hi; };
#ifdef CPU_EMU
#define KP (&p)
#else
typedef const Params __attribute__((address_space(4))) CParams;
__device__ __forceinline__ CParams* kp_now() { CParams* q = (CParams*)__builtin_amdgcn_kernarg_segment_ptr(); asm volatile("" : "+s"(q)); return q; }
#define KP (kp_now())
#endif
constexpr int N_PHASES = 23;
constexpr int LDS_BYTES = 131072 + 1024;
constexpr size_t OFF_CTL = WS_END;
constexpr size_t CTL_BYTES = 16384;
constexpr size_t OFF_USC = OFF_CTL + CTL_BYTES;
constexpr size_t WS_TOTAL = OFF_USC + (size_t)2 * 16384 * 4;

#ifndef CPU_EMU
#define LAS __attribute__((address_space(3)))
#define XB_TMO      128
#define XB_XCNT(j)  (256  + 64 * (j))
#define XB_XSUB(j)  (1280 + 64 * (j))
#define XB_XGEN(j)  (2304 + 64 * (j))
#define XB_TOP      3328
#define XB_TOPGEN   3392
#define XCD_BAR_WORDS 3456
#define XB_SPIN_CAP (1u << 26)
__device__ __forceinline__ unsigned xb_ld(unsigned* p)              { return __hip_atomic_load(p, __ATOMIC_RELAXED, __HIP_MEMORY_SCOPE_AGENT); }
__device__ __forceinline__ unsigned xb_add(unsigned* p, unsigned v) { return __hip_atomic_fetch_add(p, v, __ATOMIC_RELAXED, __HIP_MEMORY_SCOPE_AGENT); }
__device__ __forceinline__ unsigned xb_xcc_id() { return (unsigned)__builtin_amdgcn_s_getreg((3 << 11) | 20) & 0xFu; }
#define XB_SPIN(cond, bar) do { unsigned _sp = 0; while (cond) { __builtin_amdgcn_s_sleep(1); \
    if ((++_sp & 255u) == 0u) { if (xb_ld(&(bar)[XB_TMO])) break; if (_sp > XB_SPIN_CAP) { atomicAdd(&(bar)[XB_TMO], 1u); break; } } } } while (0)
struct XcdBarrier { unsigned* bar; unsigned x; volatile LAS unsigned* st; };
__device__ __forceinline__ XcdBarrier xcd_barrier_post(unsigned* bar, volatile LAS unsigned* st) {
    XcdBarrier b; b.bar = bar; b.x = xb_xcc_id(); b.st = st;
    if (tid_now() == 0u) (void)xb_add(&bar[XB_XCNT(b.x)], 1u);
    return b;
}
__device__ __forceinline__ void xcd_barrier_complete(unsigned* bar, unsigned x, unsigned& nloc, unsigned& nx) {
    const unsigned G = gridDim.x * gridDim.y * gridDim.z;
    unsigned sum, cnt, mine, sp = 0u;
    for (;;) {
        sum = 0u; cnt = 0u; mine = 0u;
#pragma unroll
        for (unsigned j = 0; j < 16; ++j) { const unsigned c = xb_ld(&bar[XB_XCNT(j)]); sum += c; cnt += (c > 0u) ? 1u : 0u; mine = (j == x) ? c : mine; }
        if (sum == G) break;
        __builtin_amdgcn_s_sleep(1);
        if ((++sp & 255u) == 0u) { if (xb_ld(&bar[XB_TMO])) break; if (sp > XB_SPIN_CAP) { atomicAdd(&bar[XB_TMO], 1u); break; } }
    }
    nloc = mine > 0u ? mine : 1u; nx = cnt > 0u ? cnt : 1u;
}
__device__ __forceinline__ void xcd_barrier(const XcdBarrier& b) {
    asm volatile("s_waitcnt vmcnt(0)" ::: "memory");
    __syncthreads();
    if (tid_now() == 0u) {
        unsigned* bar = b.bar;
        __builtin_amdgcn_s_waitcnt(0);
        unsigned nloc = b.st[0], nx = b.st[1];
        if (nloc == 0u) { xcd_barrier_complete(bar, b.x, nloc, nx); b.st[0] = nloc; b.st[1] = nx; }
        const unsigned old = xb_add(&bar[XB_XSUB(b.x)], 1u);
        const unsigned gen = old / nloc;
        if (old + 1u == (gen + 1u) * nloc) {
            __builtin_amdgcn_fence(__ATOMIC_RELEASE, "agent");
            asm volatile("s_waitcnt vmcnt(0)" ::: "memory");
            const unsigned og = xb_add(&bar[XB_TOP], 1u);
            const unsigned tg = og / nx;
            if (og + 1u == (tg + 1u) * nx) xb_add(&bar[XB_TOPGEN], 1u);
            else XB_SPIN(xb_ld(&bar[XB_TOPGEN]) == tg, bar);
            __builtin_amdgcn_fence(__ATOMIC_ACQUIRE, "agent");
            xb_add(&bar[XB_XGEN(b.x)], 1u);
            asm volatile("s_waitcnt vmcnt(0)" ::: "memory");
        } else {
            XB_SPIN(xb_ld(&bar[XB_XGEN(b.x)]) == gen, bar);
            __builtin_amdgcn_fence(__ATOMIC_ACQUIRE, "agent");
            asm volatile("s_waitcnt vmcnt(0)" ::: "memory");
        }
    }
    __syncthreads();
}
#endif

#define x_in (KP->in[0])
#define c_in (KP->in[1])
#define ctx (KP->in[2])
#define c_ctx (KP->in[3])
#define ada_w (KP->in[4])
#define ada_b (KP->in[5])
#define norm1_g (KP->in[6])
#define norm2_g (KP->in[7])
#define w_in (KP->in[8])
#define dec_w2 (KP->in[9])
#define dec_b (KP->in[10])
#define gla_g (KP->in[11])
#define sink (KP->in[12])
#define w_out (KP->in[13])
#define rw_mu (KP->in[14])
#define w_rkv (KP->in[15])
#define w_o (KP->in[16])
#define rw_w0 (KP->in[17])
#define rw_w1 (KP->in[18])
#define rw_w2 (KP->in[19])
#define rw_a0 (KP->in[20])
#define rw_a1 (KP->in[21])
#define rw_a2 (KP->in[22])
#define rw_g1 (KP->in[23])
#define rw_g2 (KP->in[24])
#define k_k (KP->in[25])
#define k_a (KP->in[26])
#define r_k (KP->in[27])
#define ln_g (KP->in[28])
#define ln_b (KP->in[29])
#define peer_wq (KP->in[30])
#define peer_k1 (KP->in[31])
#define peer_k2 (KP->in[32])
#define peer_u (KP->in[33])
#define peer_v (KP->in[34])
#define final_g (KP->in[35])
#define MOD ((float*)(KP->ws + OFF_MOD))
#define XC ((float*)(KP->ws + OFF_XC))
#define U ((AT*)(KP->ws + OFF_U))
#define MIX ((AT*)(KP->ws + OFF_MIX))
#define WIN ((AT*)(KP->ws + OFF_WIN))
#define WOUT ((AT*)(KP->ws + OFF_WOUT))
#define WQ0 ((AT*)(KP->ws + OFF_WQ0))
#define WQ1 ((AT*)(KP->ws + OFF_WQ1))
#define WRKV ((AT*)(KP->ws + OFF_WRKV))
#define WO ((AT*)(KP->ws + OFF_WO))
#define H ((AT*)(KP->ws + OFF_H))
#define XS ((AT*)(KP->ws + OFF_XS))
#define Y0 ((AT*)(KP->ws + OFF_Y0))
#define Y1 ((AT*)(KP->ws + OFF_Y1))
#define PROJ ((AT*)(KP->ws + OFF_PROJ))
#define LOGA ((float*)(KP->ws + OFF_LOGA))
#define GLAO ((float*)(KP->ws + OFF_GLAO))
#define SC ((float*)(KP->ws + OFF_SC))
#define TAB0 ((TT*)(KP->ws + OFF_TAB0))
#define TAB1 ((TT*)(KP->ws + OFF_TAB1))
#define USC ((float*)(KP->ws + OFF_USC))
#define PIDX ((int*)(KP->ws + OFF_PIDX))
#define PGATE ((float*)(KP->ws + OFF_PGATE))
#define R ((AT*)(KP->ws + OFF_R))
#define K ((AT*)(KP->ws + OFF_K))
#define V ((AT*)(KP->ws + OFF_V))
#define KK ((AT*)(KP->ws + OFF_KK))
#define U1 ((AT*)(KP->ws + OFF_U1))
#define SC1 ((float*)(KP->ws + OFF_SC1))
#define G ((AT*)(KP->ws + OFF_G))
#define A ((AT*)(KP->ws + OFF_A))
#define DEC ((AT*)(KP->ws + OFF_DEC))
#define RWOUT ((AT*)(KP->ws + OFF_DEC))
#define T1 ((AT*)(KP->ws + OFF_T1))
#define T2 ((AT*)(KP->ws + OFF_T2))
#define HX ((AT*)(KP->ws + OFF_HX))
#define WL1 ((AT*)(KP->ws + OFF_WL1))
#define WL2A ((AT*)(KP->ws + OFF_WL2A))
#define WL2B ((AT*)(KP->ws + OFF_WL2B))
#define MOD0 ((const float*)MOD)
#define MOD1 ((const float*)(MOD + (size_t)(B_ + 1) * D6))
__global__ void __launch_bounds__(NT, 2) mega(Params p) {
#ifdef CPU_EMU
    static unsigned char lds_raw[LDS_BYTES]; unsigned char* lds = lds_raw;
#else
    extern __shared__ __attribute__((aligned(16))) unsigned char lds[];
#endif
    float* ldsf = (float*)lds;
    const size_t PE = (size_t)16384 * D_;
    const int lo = p.ph_lo, hi = p.ph_hi;
#ifndef CPU_EMU
    volatile LAS unsigned* st = (volatile LAS unsigned*)(lds + LDS_BYTES - 16);
    if (threadIdx.x < 4) st[threadIdx.x] = 0u;
    if ((threadIdx.x & 63u) == 0u) *(volatile LAS unsigned*)(lds + TID_TAB_OFF + 4 * hw_slot()) = threadIdx.x >> 6;
    __syncthreads();
    XcdBarrier bar = xcd_barrier_post((unsigned*)(KP->ws + OFF_CTL), st);
#define SEAM(k) do { if (hi - lo > 1) xcd_barrier(bar); } while (0)
#else
#define SEAM(k) do { } while (0)
#endif
#define IN(k) (lo <= (k) && (k) < hi)
#ifdef CPU_EMU
    if (IN(0)) { ph_adaln(c_in, c_ctx, ada_w, ada_b, MOD);
        ph_wprep(w_in, D_, 2336, PROJW, WIN); ph_wprep(w_out, D_, D_, D_, WOUT); ph_wc(peer_wq, peer_k1, peer_k2, WQ0); ph_wc(peer_wq + (size_t)D_ * 2048, peer_k1 + (size_t)8 * 128 * 128, peer_k2 + (size_t)8 * 128 * 128, WQ1);
        ph_cvt_tab(peer_u, TAB0, PE, 32.f); ph_cvt_tab(peer_v, TAB0 + PE, PE, 1.f);
        for (int j = 0; j < 3; ++j) ph_wprep(w_rkv + (size_t)j * D_ * D_, D_, D_, D_, WRKV + (size_t)j * D_ * D_);
        ph_wprep(w_o, D_, D_, D_, WO); ph_wlora(rw_mu, rw_w1, rw_a1, rw_g1, rw_w2, rw_a2, rw_g2, WL1, WL2A, WL2B); SEAM(0); }
#else
    if (IN(0)) {
        ph_wc2(ldsf, peer_wq, peer_k1, peer_k2, WQ0);
        ph_adaln2(ldsf, c_in, c_ctx, ada_w, ada_b, MOD);
        { const int tn_ = (int)tid_now(), lane = tn_ & 63, wv = tn_ >> 6, gw = blockIdx.x * 8 + wv, nw = gridDim.x * 8; float* scr = ldsf + wv * (64 * 33);
          wprep_items(scr, lane, gw, nw, w_in, D_, 2336, PROJW, WIN); wprep_items(scr, lane, gw, nw, w_out, D_, D_, D_, WOUT);
          if ((int)gridDim.x * 3 <= (NTOK / 256) * (PROJW / 256) || (int)gridDim.x * 2 >= (NTOK / 256) * (PROJW / 256)) {
              for (int j = 0; j < 3; ++j) wprep_items(scr, lane, gw, nw, w_rkv + (size_t)j * D_ * D_, D_, D_, D_, WRKV + (size_t)j * D_ * D_);
              wprep_items(scr, lane, gw, nw, w_o, D_, D_, D_, WO); } }
        ph_wlora(rw_mu, rw_w1, rw_a1, rw_g1, rw_w2, rw_a2, rw_g2, WL1, WL2A, WL2B, 0, (int)gridDim.x);
        SEAM(0); }
#endif
#ifdef CPU_EMU
    if (IN(1)) { ph_modnorm(ldsf, NTOK, XC, norm1_g, MOD0, 0, 1, U, nullptr, x_in, ctx); SEAM(1); }
#else
    if (IN(1)) { ph_modnorm2(NTOK, XC, norm1_g, MOD0, 0, 1, U, nullptr, x_in, ctx); SEAM(1); }
#endif
    if (IN(2)) { run_gemm(lds, U, WIN, NTOK, PROJW, D_, EpiStore16{PROJ, PROJW});
#ifndef CPU_EMU
        { const int nun_ = (NTOK / 256) * (PROJW / 256), ngr_ = (int)gridDim.x, first_ = nun_ - 2 * ngr_;
          if (ngr_ * 3 > nun_ && ngr_ * 2 < nun_ && (int)blockIdx.x >= first_) {
              __syncthreads();
              const int tn_ = (int)tid_now(), lane = tn_ & 63, wv = tn_ >> 6, gw = ((int)blockIdx.x - first_) * 8 + wv, nw = (ngr_ - first_) * 8; float* scr = ldsf + wv * (64 * 33);
              for (int j = 0; j < 3; ++j) wprep_items(scr, lane, gw, nw, w_rkv + (size_t)j * D_ * D_, D_, D_, D_, WRKV + (size_t)j * D_ * D_);
              wprep_items(scr, lane, gw, nw, w_o, D_, D_, D_, WO); } }
#endif
        SEAM(2); }
    #ifdef CPU_EMU
    if (IN(3)) { ph_rope(PROJ); ph_gla_loga(PROJ, dec_w2, dec_b, LOGA); SEAM(3); }
    if (IN(4)) { ph_gla_scan(PROJ, LOGA, GLAO); ph_swa(PROJ, sink, MIX, GLA_THREADS); SEAM(4); }
#else
    if (IN(4)) { ph_gla_chunk(lds, PROJ, dec_w2, dec_b, GLAO); ph_swa2(lds, PROJ, sink, MIX); SEAM(4); }
#endif
#ifdef CPU_EMU
    if (IN(5)) { ph_gla_out(PROJ, GLAO, gla_g, MIX); SEAM(5); }
#else
    if (IN(5)) { ph_gla_out2(PROJ, GLAO, gla_g, MIX); SEAM(5); }
#endif
    if (IN(6)) { run_gemm(lds, MIX, WOUT, NTOK, D_, D_, EpiResid{XC, MOD0 + 2 * D_, x_in, ctx});
#ifndef CPU_EMU
        if ((int)blockIdx.x >= 32) ph_cvt_tab_i8(peer_u, TAB0, USC, 32, 224);
#endif
        SEAM(6); }
#ifdef CPU_EMU
    if (IN(7)) { ph_modnorm(ldsf, NTOK, XC, norm2_g, MOD0, 3, 4, U, nullptr); SEAM(7); }
#else
    if (IN(7)) { ph_modnorm2(NTOK, XC, norm2_g, MOD0, 3, 4, U, nullptr); SEAM(7); }
#endif
    if (IN(8)) { run_gemm(lds, U, WQ0, NTOK, 2048, D_, EpiStoreF32{SC, 2048});
#ifndef CPU_EMU
        if ((int)blockIdx.x >= 64) ph_cvt_tab(peer_v, TAB0 + PE, PE, 1.f, 64, 192);
#endif
        SEAM(8); }
    #ifdef CPU_EMU
    if (IN(9)) { ph_peer_topk(ldsf, NTOK, SC, PIDX, PGATE); SEAM(9); }
    if (IN(10)) { ph_peer_apply(ldsf, NTOK, U, PIDX, PGATE, TAB0, TAB0 + PE, MOD0, XC); SEAM(10); }
#else
    if (IN(9)) { ph_topk2(NTOK, SC, PIDX, PGATE); SEAM(9); }
    if (IN(10)) { ph_peer_apply4<3>(lds, NTOK, U, PIDX, PGATE, TAB0, USC, TAB0 + PE, MOD0, XC, 1.f); SEAM(10); }
#endif
#ifdef CPU_EMU
    if (IN(11)) { ph_modnorm(ldsf, NTOK, XC, norm1_g + D_, MOD1, 0, 1, H, nullptr); SEAM(11); }
    if (IN(22)) { ph_xs(H, rw_mu, XS, HX); SEAM(22); }
#else
    if (IN(11)) { ph_norm_mix(XC, norm1_g + D_, MOD1, rw_mu, XS, HX); SEAM(11); }
#endif
    if (IN(12)) {
        for (int j = 0; j < 3; ++j) run_gemm(lds, XS + (size_t)j * (ROWB / SA), WRKV + (size_t)j * D_ * D_, j == 0 ? NLAT : NTOK, D_, D_, EpiStore16{j == 0 ? R : (j == 1 ? K : V), D_}, j == 2 ? 224 : 0);
        run_gemm(lds, HX, WL1, NTOK, 512, 2048, EpiLora1{T1, T2}, 144);
        SEAM(12); }
    if (IN(13)) {
        run_gemm(lds, T1, WL2A, NTOK, 2048, 256, EpiStore16{DEC, 2048});
        run_gemm(lds, T1, WL2A + (size_t)2048 * 256, NTOK, 2048, 256, EpiStore16{A, 2048}, 192);
        run_gemm(lds, T2, WL2B, NLAT, D_, 256, EpiStore16{G, D_});
#ifdef CPU_EMU
        ph_rw_kk(K, k_k, KK);
#else

#endif
        SEAM(13); }
    #ifdef CPU_EMU
    if (IN(14)) { ph_rw_scan(R, K, V, KK, A, DEC, rw_w0, rw_a0, k_a, Y0, Y1); SEAM(14); }
#else
    if (IN(14)) { ph_rw_scan3(lds, R, K, V, k_k, A, DEC, rw_w0, rw_a0, k_a, Y0, Y1, peer_u + PE, peer_v + PE, TAB1, USC + 16384); SEAM(14); }
#endif
#ifdef CPU_EMU
    if (IN(15)) { ph_rw_out(Y0, Y1, R, K, V, A, rw_a0, G, k_a, r_k, ln_g, ln_b, RWOUT); SEAM(15); }
#else
    if (IN(15)) { ph_rw_out2(Y0, Y1, R, K, V, A, rw_a0, G, k_a, r_k, ln_g, ln_b, RWOUT); SEAM(15); }
#endif
#ifdef CPU_EMU
    if (IN(16)) { ph_cvt_tab(peer_u + PE, TAB1, PE, 32.f); ph_cvt_tab(peer_v + PE, TAB1 + PE, PE, 1.f); run_gemm(lds, RWOUT, WO, NLAT, D_, D_, EpiResid{XC, MOD1 + 2 * D_, nullptr, nullptr}); SEAM(16); }
#else
    if (IN(16)) { run_gemm(lds, RWOUT, WO, NLAT, D_, D_, EpiResid{XC, MOD1 + 2 * D_, nullptr, nullptr}); SEAM(16); }
#endif
#ifdef CPU_EMU
    if (IN(17)) { ph_modnorm(ldsf, NLAT, XC, norm2_g + D_, MOD1, 3, 4, U1, nullptr); SEAM(17); }
#else
    if (IN(17)) { ph_modnorm2(NLAT, XC, norm2_g + D_, MOD1, 3, 4, U1, nullptr); SEAM(17); }
#endif
    if (IN(18)) { run_gemm(lds, U1, WQ1, NLAT, 2048, D_, EpiStoreF32{SC1, 2048}); SEAM(18); }
    #ifdef CPU_EMU
    if (IN(19)) { ph_peer_topk(ldsf, NLAT, SC1, PIDX, PGATE); SEAM(19); }
    if (IN(20)) { ph_peer_apply(ldsf, NLAT, U1, PIDX, PGATE, TAB1, TAB1 + PE, MOD1, XC); SEAM(20); }
#else
    if (IN(19)) { ph_topk2(NLAT, SC1, PIDX, PGATE); SEAM(19); }
    if (IN(20)) { ph_peer_apply4<4>(lds, NLAT, U1, PIDX, PGATE, TAB1, USC + 16384, TAB1 + PE, MOD1, XC, 1.f, final_g, KP->out); }
#endif
#ifdef CPU_EMU
    if (IN(21)) { ph_modnorm(ldsf, NLAT, XC, final_g, nullptr, 0, 0, nullptr, p.out); }
#endif
}

#undef x_in
#undef c_in
#undef ctx
#undef c_ctx
#undef ada_w
#undef ada_b
#undef norm1_g
#undef norm2_g
#undef w_in
#undef dec_w2
#undef dec_b
#undef gla_g
#undef sink
#undef w_out
#undef rw_mu
#undef w_rkv
#undef w_o
#undef rw_w0
#undef rw_w1
#undef rw_w2
#undef rw_a0
#undef rw_a1
#undef rw_a2
#undef rw_g1
#undef rw_g2
#undef k_k
#undef k_a
#undef r_k
#undef ln_g
#undef ln_b
#undef peer_wq
#undef peer_k1
#undef peer_k2
#undef peer_u
#undef peer_v
#undef final_g
#undef MOD
#undef XC
#undef U
#undef MIX
#undef WIN
#undef WOUT
#undef WQ0
#undef WQ1
#undef WRKV
#undef WO
#undef H
#undef XS
#undef Y0
#undef Y1
#undef PROJ
#undef LOGA
#undef GLAO
#undef SC
#undef TAB0
#undef TAB1
#undef USC
#undef PIDX
#undef PGATE
#undef R
#undef K
#undef V
#undef KK
#undef U1
#undef SC1
#undef G
#undef A
#undef DEC
#undef RWOUT
#undef T1
#undef T2
#undef HX
#undef WL1
#undef WL2A
#undef WL2B
#undef MOD0
#undef MOD1

extern "C" void kernel_launch(void* const* d_in, const int* in_sizes, int n_in, void* d_out, int out_size, void* d_ws, size_t ws_size, hipStream_t stream) {
    if (ws_size < WS_TOTAL || n_in != 36) { fprintf(stderr, "kernel_launch: ws too small (%zu < %zu) or n_in %d != 36\n", ws_size, (size_t)WS_TOTAL, n_in); return; }
    Params p{};
    for (int i = 0; i < 36; ++i) p.in[i] = (const float*)d_in[i];
    p.out = (float*)d_out; p.ws = (char*)d_ws;
#ifdef CPU_EMU
    { const int order[N_PHASES] = {0,1,2,3,4,5,6,7,8,9,10,11,22,12,13,14,15,16,17,18,19,20,21};
      for (int i = 0; i < N_PHASES; ++i) { int ph = order[i]; p.ph_lo = ph; p.ph_hi = ph + 1; emu_launch(true, 8, NT, [=] { mega(p); }); emu_phase_hook(ph, (char*)d_ws); } }
#else
    static int grid = 0;
    if (grid == 0) {
        int dev = 0, cus = 0;
        if (hipGetDevice(&dev) != hipSuccess || hipDeviceGetAttribute(&cus, hipDeviceAttributeMultiprocessorCount, dev) != hipSuccess) { grid = -1; return; }
        if (hipFuncSetAttribute((const void*)mega, hipFuncAttributeMaxDynamicSharedMemorySize, LDS_BYTES) != hipSuccess) { grid = -1; return; }
        grid = cus;
    }
    if (grid < 0) return;
    (void)hipMemsetAsync((char*)d_ws + OFF_CTL, 0, CTL_BYTES, stream);
    p.ph_lo = 0; p.ph_hi = N_PHASES;
    hipLaunchKernelGGL(mega, dim3(grid), dim3(NT), LDS_BYTES, stream, p);
#endif
}
```

```cpp
#ifndef CPU_EMU
#include <hip/hip_runtime.h>
#define DUMP(name, ptr, count)
#define DUMPD(name, ptr, count)
#endif
#include <stdint.h>
#include <string.h>
#include <stdio.h>

#ifndef CFG_B
#define CFG_B 8
#define CFG_T 2048
#define CFG_L 256
#endif
constexpr int B_ = CFG_B, T_ = CFG_T, L_ = CFG_L, D_ = 1024;
constexpr int NLAT = B_ * T_, NCTX = B_ * L_, NTOK = NLAT + NCTX;
constexpr int PROJW = 2560;
constexpr int C_GQ = 0, C_GK = 256, C_GV = 512, C_GG = 1024, C_LR = 1536, C_SQ = 1568, C_SK = 2080, C_SV = 2208;
constexpr int D6 = 6 * D_;

struct bf16 { unsigned short v; };
#ifdef AT_F32
typedef float AT;
#else
typedef bf16 AT;
#endif
#ifdef CPU_EMU
typedef float DT;
#else
typedef _Float16 DT;
#endif
__device__ __forceinline__ float ldf(const float* p) { return *p; }
__device__ __forceinline__ void stf(float* p, float v) { *p = v; }
__device__ __forceinline__ float ldf(const bf16* p) { unsigned u = (unsigned)p->v << 16; float f; memcpy(&f, &u, 4); return f; }
__device__ __forceinline__ void stf(bf16* p, float f) { unsigned u; memcpy(&u, &f, 4); u = (u + 0x7fffu + ((u >> 16) & 1u)) >> 16; p->v = (unsigned short)u; }
__device__ __forceinline__ float sigmoidf_(float x) { return 1.f / (1.f + expf(-x)); }
#ifdef CPU_EMU
__device__ __forceinline__ float fsig(float x) { return sigmoidf_(x); }
__device__ __forceinline__ float ftanh(float x) { return tanhf(x); }
#else
__device__ __forceinline__ float fsig(float x) { return __builtin_amdgcn_rcpf(1.f + __expf(-x)); }
__device__ __forceinline__ float ftanh(float x) { return 2.f * __builtin_amdgcn_rcpf(1.f + __expf(-2.f * x)) - 1.f; }
#endif

struct TokInfo { int b, pos, len; };
__device__ __forceinline__ TokInfo tokinfo(int m) {
    TokInfo t; if (m < NLAT) { t.b = m / T_; t.pos = m % T_; t.len = T_; } else { int c = m - NLAT; t.b = c / L_; t.pos = c % L_; t.len = L_; } return t; }
__device__ __forceinline__ int tok_row(int m) { return m < NLAT ? m / T_ : B_; }

constexpr size_t al_(size_t x) { return (x + 255) & ~(size_t)255; }
constexpr size_t SA = sizeof(AT), SD = sizeof(DT);
constexpr size_t ROWB = al_((size_t)NTOK * D_ * SA);
constexpr size_t OFF_MOD = 0;
constexpr size_t OFF_XC = al_(OFF_MOD + (size_t)2 * (B_ + 1) * D6 * 4);
constexpr size_t OFF_WB = al_(OFF_XC + (size_t)NTOK * D_ * 4);
constexpr size_t WSZ = (size_t)D_ * D_ * SA;
constexpr size_t OFF_WIN = OFF_WB;
constexpr size_t OFF_WOUT = OFF_WIN + (size_t)PROJW * D_ * SA;
constexpr size_t OFF_WQ0 = OFF_WOUT + WSZ;
constexpr size_t OFF_WQ1 = OFF_WQ0 + 2 * WSZ;
constexpr size_t OFF_WRKV = OFF_WQ1 + 2 * WSZ;
constexpr size_t OFF_WO = OFF_WRKV + 3 * WSZ;
constexpr size_t OFF_WL1 = OFF_WO + WSZ;
constexpr size_t OFF_WL2A = OFF_WL1 + (size_t)512 * 2048 * SA;
constexpr size_t OFF_WL2B = OFF_WL2A + (size_t)4096 * 256 * SA;
constexpr size_t OFF_X = al_(OFF_WL2B + (size_t)1024 * 256 * SA);
constexpr size_t OFF_Y = OFF_X + 6 * ROWB;
constexpr size_t SZ_TAB = (size_t)2 * 16384 * D_ * (SA == 4 ? 4 : 1);
constexpr size_t mx_(size_t a, size_t b) { return a > b ? a : b; }
constexpr size_t SZ_Y = mx_(mx_(al_((size_t)NTOK * PROJW * SA), 3 * ROWB + 2 * al_((size_t)NTOK * 256 * SA)), SZ_TAB);
constexpr size_t OFF_Z = OFF_Y + SZ_Y;
constexpr size_t SZ_Z = mx_(mx_(ROWB, 2 * al_((size_t)NLAT * D_ * SA)), SZ_TAB);
constexpr size_t WS_END = OFF_Z + SZ_Z;
constexpr size_t OFF_U = OFF_X;
constexpr size_t OFF_MIX = OFF_X + ROWB;
constexpr size_t OFF_LOGA = OFF_X + 2 * ROWB;
constexpr size_t OFF_GLAO = OFF_LOGA + al_((size_t)NTOK * 512 * 4);
static_assert(OFF_GLAO + (size_t)2 * NTOK * 512 * 4 <= OFF_Y || SA == 4, "layer-0 view overflows region X");
constexpr size_t OFF_PROJ = OFF_Y;
constexpr size_t OFF_SC = OFF_X + ROWB;
constexpr size_t OFF_PIDX = OFF_X + 5 * ROWB;
constexpr size_t OFF_PGATE = OFF_PIDX + al_((size_t)NTOK * 128 * 4);
static_assert(OFF_SC + (size_t)NTOK * 2048 * 4 <= OFF_PIDX && OFF_PGATE + (size_t)NTOK * 128 * 4 <= OFF_X + 6 * ROWB, "peer view overflows region X");
#ifdef CPU_EMU
constexpr size_t OFF_TAB0 = OFF_Z, OFF_TAB1 = OFF_Y;
constexpr size_t OFF_U1 = OFF_U, OFF_SC1 = OFF_SC;
#else
constexpr size_t OFF_TAB0 = OFF_Z, OFF_TAB1 = OFF_X + 4 * ROWB;
constexpr size_t OFF_U1 = OFF_Y, OFF_SC1 = OFF_X;
static_assert((size_t)2 * 16384 * D_ <= ROWB && (size_t)NLAT * 2048 * 4 <= 4 * ROWB, "layer-1 PEER view");
#endif
constexpr size_t OFF_H = OFF_Z;
constexpr size_t OFF_XS = OFF_X;
constexpr size_t OFF_R = OFF_Y, OFF_K = OFF_Y + ROWB, OFF_V = OFF_Y + 2 * ROWB;
constexpr size_t OFF_T1 = OFF_Y + 3 * ROWB;
constexpr size_t OFF_T2 = OFF_T1 + al_((size_t)NTOK * 256 * SA);
constexpr size_t OFF_HX = OFF_X + 3 * ROWB;
constexpr size_t OFF_DEC = OFF_X;
constexpr size_t OFF_A = OFF_X + 2 * ROWB;
constexpr size_t OFF_KK = OFF_A + 2 * ROWB;
constexpr size_t OFF_G = OFF_KK + ROWB;
constexpr size_t OFF_Y0 = OFF_Z, OFF_Y1 = OFF_Z + al_((size_t)NLAT * D_ * SA);
#ifndef CPU_EMU
static_assert(OFF_G + ROWB <= OFF_Y, "layer-1 view overflows region X");
#endif

constexpr int NT = 512;
#ifdef CPU_EMU
__device__ __forceinline__ unsigned tid_now() { return threadIdx.x; }
#else
constexpr int TID_TAB_OFF = 131072 + 512;
__device__ __forceinline__ unsigned hw_slot() { return (unsigned)__builtin_amdgcn_s_getreg((5 << 11) | 4) & 63u; }
__device__ __forceinline__ unsigned tid_now() {
    extern __shared__ __attribute__((aligned(16))) unsigned char lds_dyn_tid_[];
    const unsigned wv = *(volatile __attribute__((address_space(3))) unsigned*)((__attribute__((address_space(3))) unsigned char*)lds_dyn_tid_ + TID_TAB_OFF + 4 * hw_slot());
    const unsigned lane = __builtin_amdgcn_mbcnt_hi(~0u, __builtin_amdgcn_mbcnt_lo(~0u, 0u));
    return ((unsigned)__builtin_amdgcn_readfirstlane((int)wv) << 6) | lane; }
#endif
#define GSTRIDE(idx, N) for (size_t idx = (size_t)blockIdx.x * NT + tid_now(); idx < (size_t)(N); idx += (size_t)gridDim.x * NT)
#define GSTRIDE_SUB(idx, N, wg0, nwg) for (size_t idx = (size_t)((int)blockIdx.x - (wg0)) * NT + tid_now(); idx < (size_t)(N); idx += (size_t)(nwg) * NT)

#ifndef CPU_EMU
namespace pg8 {
#define PG8_LAS __attribute__((address_space(3)))
typedef unsigned short bf16_t;
typedef short bf16x8 __attribute__((ext_vector_type(8)));
typedef float f32x4 __attribute__((ext_vector_type(4)));
typedef unsigned u32x4 __attribute__((ext_vector_type(4)));
constexpr int BM = 256, BK = 64, HALF = 128, HTB = HALF * BK * 2  , STAGE_BYTES = 8 * HTB, NXCD = 8, WGM = 8;

__host__ __device__ __forceinline__ int lds_byte(int r, int c) { const int st = (r >> 4) * 2 + (c >> 5), rr = r & 15, cc = c & 31, ob = rr * 64 + cc * 2; return st * 1024 + (ob ^ (((ob >> 9) & 1) << 5)); }
__host__ __device__ __forceinline__ void stage_rc(int b, int& R, int& C) { const int st = b / 1024, sb = b % 1024, swz = sb ^ (((sb >> 9) & 1) << 5); R = (st >> 1) * 16 + swz / 64; C = (st & 1) * 32 + (swz % 64) / 2; }
__host__ __device__ __forceinline__ int perm32(int rho) { const int n = rho >> 4, i = rho & 15; return 8 * (i >> 2) + 4 * n + (i & 3); }

struct Unit { int pm, pn; };
struct Gemm { const bf16_t* A; const bf16_t* Bt; int M, N, K; };

struct StaticOrder {
    int nM, nN, nwg, G, c;
    __host__ __device__ void init(int M, int N, int G_, int c_) { nM = M / BM; nN = N / BM; nwg = nM * nN; G = G_; c = c_; }
    __host__ __device__ bool next(int i, Unit& u) const {
        const long L = (long)i * G + c; if (L >= nwg) return false;
        int wgid = (int)L; { const int q = nwg / NXCD, r = nwg % NXCD, xcd = wgid % NXCD, off = wgid / NXCD; wgid = (xcd < r ? xcd * (q + 1) : r * (q + 1) + (xcd - r) * q) + off; }
        const int nig = WGM * nN, gid = wgid / nig, fm = gid * WGM, gsz = (nM - fm) < WGM ? (nM - fm) : WGM;
        u.pm = fm + ((wgid % nig) % gsz); u.pn = (wgid % nig) / gsz; return true;
    }
    __device__ __forceinline__ void a_ready(const Unit&) const {}
    __device__ __forceinline__ void done(const Unit&) const {}
};

__device__ __forceinline__ unsigned cvt_pk_bf16(float lo, float hi) { unsigned r; asm volatile("v_cvt_pk_bf16_f32 %0, %1, %2" : "=v"(r) : "v"(lo), "v"(hi)); return r; }
typedef float f32x2 __attribute__((ext_vector_type(2)));
template <class Epi, class Sched, bool ALIGN_EPI = false, bool SP2 = false>
__device__ __forceinline__ void gemm_phase(PG8_LAS unsigned char* lds, const Gemm g, const Sched& S, const Epi& E) {
    const int tid = (int)tid_now(), wid = __builtin_amdgcn_readfirstlane(tid >> 6), lane = tid & 63, wr = wid >> 2, wc = wid & 3, fr = lane & 15, fq = lane >> 4;
    const int K = g.K, nt = K / BK;
    unsigned voffA[2], voffB[2];
#pragma unroll
    for (int i = 0; i < 2; ++i) { int R, C; stage_rc(tid * 16 + i * 8192, R, C); const int Rb = Epi::PERM ? ((R & ~31) + perm32(R & 31)) : R;
        voffA[i] = (unsigned)(R * K + C) * 2u; voffB[i] = (unsigned)(Rb * K + C) * 2u; }
    const size_t kstep = (size_t)(BK * 2);
    const size_t hstep = (size_t)HALF * K * 2;
    const size_t tstep = 2 * hstep;
    const unsigned ldsw = (unsigned)wid * 1024u;
    const int aoff = lds_byte(wr * 64 + fr, fq * 8), boff = lds_byte(wc * 32 + fr, fq * 8);
#define PG8_SA(b, h) (((b) * 2 + (h)) * HTB)
#define PG8_SB(b, h) ((4 + (b) * 2 + (h)) * HTB)
#define PG8_STAGE(bufoff, gbase, voff) do { _Pragma("unroll") for (int _i = 0; _i < 2; ++_i) \
        __builtin_amdgcn_global_load_lds((const unsigned*)((const char*)(gbase) + (voff)[_i]), (PG8_LAS unsigned*)(lds + (bufoff) + ldsw + _i * 8192), 16, 0, 0); } while (0)
#define PG8_LDA(dst, b, h) do { _Pragma("unroll") for (int m = 0; m < 4; ++m) _Pragma("unroll") for (int k = 0; k < 2; ++k) dst[m][k] = *(const PG8_LAS bf16x8*)(lds + PG8_SA(b, h) + aoff + m * 2048 + k * 1024); } while (0)
#define PG8_LDB(dst, b, h) do { _Pragma("unroll") for (int n = 0; n < 2; ++n) _Pragma("unroll") for (int k = 0; k < 2; ++k) dst[n][k] = *(const PG8_LAS bf16x8*)(lds + PG8_SB(b, h) + boff + n * 2048 + k * 1024); } while (0)
#define PG8_MMA(ai, bj, At, Bt) do { __builtin_amdgcn_s_setprio(1); _Pragma("unroll") for (int m = 0; m < 4; ++m) _Pragma("unroll") for (int n = 0; n < 2; ++n) _Pragma("unroll") for (int k = 0; k < 2; ++k) \
        acc[ai][bj][m][n] = __builtin_amdgcn_mfma_f32_16x16x32_bf16(Bt[n][k], At[m][k], acc[ai][bj][m][n], 0, 0, 0); __builtin_amdgcn_s_setprio(0); } while (0)
#define PG8_WAIT_V(n) asm volatile("s_waitcnt vmcnt(" #n ")" ::: "memory")
#define PG8_WAIT_L(n) asm volatile("s_waitcnt lgkmcnt(" #n ")" ::: "memory")
#define PG8_BAR __builtin_amdgcn_s_barrier()
#define PG8_SCHED __builtin_amdgcn_sched_barrier(0)
    Unit cur, nxt; int ui = 0;
    if (!S.next(0, cur)) return;
    f32x4 acc[2][2][4][2];
#pragma unroll
    for (int a = 0; a < 2; ++a)
#pragma unroll
        for (int b = 0; b < 2; ++b)
#pragma unroll
            for (int m = 0; m < 4; ++m)
#pragma unroll
                for (int n = 0; n < 2; ++n) acc[a][b][m][n] = (f32x4){0.f, 0.f, 0.f, 0.f};
    bf16x8 At[4][2], B0[2][2], B1[2][2];
    const char* cA = (const char*)g.A + (size_t)cur.pm * tstep; const char* cB = (const char*)g.Bt + (size_t)cur.pn * tstep;
    S.a_ready(cur);
    if constexpr (SP2) {
        PG8_STAGE(PG8_SB(0, 0), cB, voffB); PG8_STAGE(PG8_SB(0, 1), cB + hstep, voffB); PG8_STAGE(PG8_SA(0, 0), cA, voffA); PG8_STAGE(PG8_SA(0, 1), cA + hstep, voffA);
        if (wr == 1) PG8_BAR;
        PG8_WAIT_V(2); PG8_BAR;
        PG8_STAGE(PG8_SB(1, 0), cB + kstep, voffB); PG8_STAGE(PG8_SA(1, 0), cA + kstep, voffA); PG8_STAGE(PG8_SB(1, 1), cB + hstep + kstep, voffB);
        PG8_WAIT_V(6); PG8_BAR;
    } else {
        PG8_STAGE(PG8_SB(0, 0), cB, voffB); PG8_STAGE(PG8_SA(0, 0), cA, voffA); PG8_STAGE(PG8_SB(0, 1), cB + hstep, voffB); PG8_STAGE(PG8_SA(0, 1), cA + hstep, voffA);
        if (wr == 1) PG8_BAR;
        PG8_WAIT_V(4); PG8_BAR;
        PG8_STAGE(PG8_SB(1, 0), cB + kstep, voffB); PG8_STAGE(PG8_SA(1, 0), cA + kstep, voffA); PG8_STAGE(PG8_SB(1, 1), cB + hstep + kstep, voffB);
        PG8_WAIT_V(6); PG8_BAR;
    }
    for (;;) {
        const bool has_next = S.next(ui + 1, nxt);
        const char* nA = has_next ? (const char*)g.A + (size_t)nxt.pm * tstep : cA; const char* nB = has_next ? (const char*)g.Bt + (size_t)nxt.pn * tstep : cB;
        for (int t = 0; t < nt; t += 2) {
            const bool last = (t == nt - 2);
            const char* a1 = cA + (size_t)(t + 1) * kstep;
            const char* a2 = last ? nA : cA + (size_t)(t + 2) * kstep; const char* b2 = last ? nB : cB + (size_t)(t + 2) * kstep;
            const char* a3 = a2 + kstep; const char* b3 = b2 + kstep;
            if (last && has_next) S.a_ready(nxt);
            if constexpr (SP2) {
            PG8_LDB(B0, 0, 0); PG8_LDB(B1, 0, 1); PG8_SCHED; PG8_LDA(At, 0, 0); PG8_STAGE(PG8_SA(1, 1), a1 + hstep, voffA);
            PG8_WAIT_V(8); PG8_WAIT_L(0); PG8_BAR; PG8_MMA(0, 0, At, B0); PG8_MMA(0, 1, At, B1); PG8_BAR; PG8_SCHED;
            PG8_LDA(At, 0, 1); PG8_STAGE(PG8_SB(0, 0), b2, voffB); PG8_STAGE(PG8_SB(0, 1), b2 + hstep, voffB); PG8_STAGE(PG8_SA(0, 0), a2, voffA);
            PG8_WAIT_V(8); PG8_WAIT_L(0); PG8_BAR; PG8_MMA(1, 0, At, B0); PG8_MMA(1, 1, At, B1); PG8_BAR; PG8_SCHED;
            PG8_LDB(B0, 1, 0); PG8_LDB(B1, 1, 1); PG8_SCHED; PG8_LDA(At, 1, 0); PG8_STAGE(PG8_SA(0, 1), a2 + hstep, voffA);
            PG8_WAIT_V(8); PG8_WAIT_L(0); PG8_BAR; PG8_MMA(0, 0, At, B0); PG8_MMA(0, 1, At, B1); PG8_BAR; PG8_SCHED;
            PG8_LDA(At, 1, 1); PG8_STAGE(PG8_SB(1, 0), b3, voffB); PG8_STAGE(PG8_SB(1, 1), b3 + hstep, voffB); PG8_STAGE(PG8_SA(1, 0), a3, voffA);
            PG8_WAIT_V(8); PG8_WAIT_L(0); PG8_BAR; PG8_MMA(1, 0, At, B0); PG8_MMA(1, 1, At, B1); PG8_BAR; PG8_SCHED;
            } else {
            PG8_LDB(B0, 0, 0); PG8_SCHED; PG8_LDA(At, 0, 0); PG8_STAGE(PG8_SA(1, 1), a1 + hstep, voffA);
            PG8_WAIT_L(8); PG8_BAR; PG8_WAIT_L(0); PG8_MMA(0, 0, At, B0); PG8_BAR; PG8_SCHED;
            PG8_LDB(B1, 0, 1); PG8_STAGE(PG8_SB(0, 0), b2, voffB);
            PG8_BAR; PG8_WAIT_L(0); PG8_MMA(0, 1, At, B1); PG8_BAR;
            PG8_LDA(At, 0, 1); PG8_STAGE(PG8_SA(0, 0), a2, voffA);
            PG8_BAR; PG8_WAIT_L(0); PG8_MMA(1, 0, At, B0); PG8_BAR; PG8_SCHED;
            PG8_STAGE(PG8_SB(0, 1), b2 + hstep, voffB);
            PG8_WAIT_V(6); PG8_BAR; PG8_MMA(1, 1, At, B1); PG8_BAR;
            PG8_LDB(B0, 1, 0); PG8_SCHED; PG8_LDA(At, 1, 0); PG8_STAGE(PG8_SA(0, 1), a2 + hstep, voffA);
            PG8_WAIT_L(8); PG8_BAR; PG8_WAIT_L(0); PG8_MMA(0, 0, At, B0); PG8_BAR; PG8_SCHED;
            PG8_LDB(B1, 1, 1); PG8_STAGE(PG8_SB(1, 0), b3, voffB);
            PG8_BAR; PG8_WAIT_L(0); PG8_MMA(0, 1, At, B1); PG8_BAR;
            PG8_LDA(At, 1, 1); PG8_STAGE(PG8_SA(1, 0), a3, voffA);
            PG8_BAR; PG8_WAIT_L(0); PG8_MMA(1, 0, At, B0); PG8_BAR; PG8_SCHED;
            PG8_STAGE(PG8_SB(1, 1), b3 + hstep, voffB);
            PG8_WAIT_V(6); PG8_BAR; PG8_MMA(1, 1, At, B1); PG8_BAR;
            }
        }
        if constexpr (ALIGN_EPI) { if (wr == 0) PG8_BAR; }
        if constexpr (!Epi::AFTER_DRAIN) { E(acc, cur, wr, wc, fr, fq); S.done(cur); }
        if (!has_next) break;
#pragma unroll
        for (int a = 0; a < 2; ++a)
#pragma unroll
            for (int b = 0; b < 2; ++b)
#pragma unroll
                for (int m = 0; m < 4; ++m)
#pragma unroll
                    for (int n = 0; n < 2; ++n) acc[a][b][m][n] = (f32x4){0.f, 0.f, 0.f, 0.f};
        cur = nxt; cA = nA; cB = nB; ++ui;
        if constexpr (ALIGN_EPI) { if (wr == 1) PG8_BAR; }
    }
    PG8_WAIT_V(0);
    if constexpr (!ALIGN_EPI) { if (wr == 0) PG8_BAR; }
    PG8_BAR;
    if constexpr (Epi::AFTER_DRAIN) { E.fused(acc, cur, wr, wc, fr, fq, lds, wid, lane); S.done(cur); }
#undef PG8_SA
#undef PG8_SB
#undef PG8_STAGE
#undef PG8_LDA
#undef PG8_LDB
#undef PG8_MMA
#undef PG8_WAIT_V
#undef PG8_WAIT_L
#undef PG8_BAR
#undef PG8_SCHED
}
}

#define PG8_SP2 true
#define PG8_ALIGN true
#endif
struct EpiStore16 {
    static constexpr bool PERM = true, AFTER_DRAIN = false; AT* O; int ldc;
#ifndef CPU_EMU
    __device__ __forceinline__ void operator()(const pg8::f32x4 (&acc)[2][2][4][2], const pg8::Unit& u, int wr, int wc, int fr, int fq) const {
        const int row0 = u.pm * 256 + wr * 64 + fr, col0 = u.pn * 256 + wc * 32 + 8 * fq;
#pragma unroll
        for (int ai = 0; ai < 2; ++ai)
#pragma unroll
            for (int m = 0; m < 4; ++m) { pg8::bf16_t* rowp = (pg8::bf16_t*)O + (size_t)(row0 + ai * 128 + m * 16) * ldc + col0;
#pragma unroll
                for (int bj = 0; bj < 2; ++bj) { const pg8::f32x4 v0 = acc[ai][bj][m][0], v1 = acc[ai][bj][m][1]; pg8::u32x4 w;
                    w.x = pg8::cvt_pk_bf16(v0[0], v0[1]); w.y = pg8::cvt_pk_bf16(v0[2], v0[3]); w.z = pg8::cvt_pk_bf16(v1[0], v1[1]); w.w = pg8::cvt_pk_bf16(v1[2], v1[3]);
                    *(pg8::u32x4*)(rowp + bj * 128) = w; } }
    }
#endif
    __device__ __forceinline__ void elem(int m, int n, float v) const { stf(O + (size_t)m * ldc + n, v); }
};
typedef unsigned eu2_t __attribute__((ext_vector_type(2)));
struct EpiResid {
    static constexpr bool PERM = false, AFTER_DRAIN = false; float* XC; const float* gate; const float* xsrc; const float* csrc;
    __device__ __forceinline__ const float* srow(int r) const { return xsrc ? (r < NLAT ? xsrc + (size_t)r * D_ : csrc + (size_t)(r - NLAT) * D_) : XC + (size_t)r * D_; }
#ifndef CPU_EMU
    __device__ __forceinline__ void operator()(const pg8::f32x4 (&acc)[2][2][4][2], const pg8::Unit& u, int wr, int wc, int fr, int fq) const {
        const int row0 = u.pm * 256 + wr * 64 + fr, col0 = u.pn * 256 + wc * 32 + 4 * fq;
#pragma unroll
        for (int ai = 0; ai < 2; ++ai)
#pragma unroll
            for (int m = 0; m < 4; ++m) { const int r = row0 + ai * 128 + m * 16; const float* gr = gate + (size_t)tok_row(r) * D6 + col0; unsigned short* xh = (unsigned short*)XC + (size_t)r * D_ + col0;
                const float* sr = xsrc ? srow(r) + col0 : nullptr;
#pragma unroll
                for (int bj = 0; bj < 2; ++bj)
#pragma unroll
                    for (int n = 0; n < 2; ++n) { const int off = bj * 128 + n * 16; const pg8::f32x4 gv = *(const pg8::f32x4*)(gr + off); pg8::f32x4 sv;
                        if (xsrc) sv = *(const pg8::f32x4*)(sr + off);
                        else { const eu2_t q = *(const eu2_t*)(xh + off); sv[0] = __uint_as_float(q.x << 16); sv[1] = __uint_as_float(q.x & 0xffff0000u); sv[2] = __uint_as_float(q.y << 16); sv[3] = __uint_as_float(q.y & 0xffff0000u); }
                        const pg8::f32x4 rv = sv + gv * acc[ai][bj][m][n]; eu2_t w; w.x = pg8::cvt_pk_bf16(rv[0], rv[1]); w.y = pg8::cvt_pk_bf16(rv[2], rv[3]); *(eu2_t*)(xh + off) = w; }
                __builtin_amdgcn_sched_barrier(0); }
    }
#endif
    __device__ __forceinline__ void elem(int m, int n, float v) const { XC[(size_t)m * D_ + n] = srow(m)[n] + gate[(size_t)tok_row(m) * D6 + n] * v; }
};
template <class Epi>
__device__ __forceinline__ void run_gemm(unsigned char* lds, const AT* A, const AT* Bt, int M, int N, int K, const Epi& E, int coff = 0) {
#ifdef CPU_EMU
    GSTRIDE(idx, (size_t)M * N) { int m = (int)(idx / N), n = (int)(idx % N); float acc = 0.f;
        for (int k = 0; k < K; ++k) acc += ldf(A + (size_t)m * K + k) * ldf(Bt + (size_t)n * K + k);
        E.elem(m, n, acc); }
#else
    pg8::Gemm g{(const pg8::bf16_t*)A, (const pg8::bf16_t*)Bt, M, N, K}; pg8::StaticOrder S; S.init(M, N, (int)gridDim.x, (int)((blockIdx.x + (unsigned)coff) % gridDim.x));
    pg8::gemm_phase<Epi, pg8::StaticOrder, PG8_ALIGN, PG8_SP2>((PG8_LAS unsigned char*)lds, g, S, E);
#endif
}

struct EpiStoreF32 {
    static constexpr bool PERM = false, AFTER_DRAIN = false; float* O; int ldc;
#ifndef CPU_EMU
    __device__ __forceinline__ void operator()(const pg8::f32x4 (&acc)[2][2][4][2], const pg8::Unit& u, int wr, int wc, int fr, int fq) const {
        const int row0 = u.pm * 256 + wr * 64 + fr, col0 = u.pn * 256 + wc * 32 + 4 * fq;
#pragma unroll
        for (int ai = 0; ai < 2; ++ai)
#pragma unroll
            for (int m = 0; m < 4; ++m) { float* rp = O + (size_t)(row0 + ai * 128 + m * 16) * ldc + col0;
#pragma unroll
                for (int bj = 0; bj < 2; ++bj)
#pragma unroll
                    for (int n = 0; n < 2; ++n) *(pg8::f32x4*)(rp + bj * 128 + n * 16) = acc[ai][bj][m][n]; }
    }
#endif
    __device__ __forceinline__ void elem(int m, int n, float v) const { O[(size_t)m * ldc + n] = v; }
};
__device__ __forceinline__ void ph_wc(const float* Wq, const float* k1, const float* k2, AT* WcT) {
    GSTRIDE(idx, (size_t)2048 * D_) { const int gn = (int)(idx / D_), kin = (int)(idx % D_); const int g = gn >> 7, n = gn & 127, h = g >> 1, side = g & 1;
        const float* key = (side ? k2 : k1) + ((size_t)h * 128 + n) * 128; const float* wq = Wq + (size_t)kin * 2048 + g * 128;
        float acc = 0.f; for (int d = 0; d < 128; ++d) acc += key[d] * wq[d];
        stf(WcT + idx, acc); }
}
#ifdef CPU_EMU
typedef float TT;
__device__ __forceinline__ float e4m3_round(float x) { if (x == 0.f) return 0.f; float a = fabsf(x); if (a > 448.f) a = 448.f; int e; frexpf(a, &e); int ex = e - 1; if (ex < -6) ex = -6;
    const float q = ldexpf(1.f, ex - 3); float r = nearbyintf(a / q) * q; return x < 0.f ? -r : r; }
#else
typedef unsigned char TT;
#endif
__device__ __forceinline__ void ph_cvt_tab(const float* src, TT* dst, size_t n, float scale, int wg0 = 0, int nwg = 0) {
#ifdef CPU_EMU
    GSTRIDE(i, n) dst[i] = e4m3_round(src[i] * scale);
#else
    if (nwg == 0) nwg = (int)gridDim.x;
    GSTRIDE_SUB(i, n / 16, wg0, nwg) { const float* sp = src + i * 16; pg8::u32x4 w; unsigned ww[4];
#pragma unroll
        for (int j = 0; j < 4; ++j) { const pg8::f32x4 a = *(const pg8::f32x4*)(sp + 4 * j); int pk = 0;
            pk = __builtin_amdgcn_cvt_pk_fp8_f32(a[0] * scale, a[1] * scale, pk, false); pk = __builtin_amdgcn_cvt_pk_fp8_f32(a[2] * scale, a[3] * scale, pk, true); ww[j] = (unsigned)pk; }
        w.x = ww[0]; w.y = ww[1]; w.z = ww[2]; w.w = ww[3];
        *(pg8::u32x4*)(dst + i * 16) = w; }
#endif
}
struct EpiLora1 {
    static constexpr bool PERM = true, AFTER_DRAIN = false; AT* T1; AT* T2;
    __device__ __forceinline__ static float act(int n, float v) { return n < 128 ? ftanh(v) : (n < 256 ? v : (n < 416 ? fsig(v) : 0.f)); }
#ifndef CPU_EMU
    __device__ __forceinline__ void operator()(const pg8::f32x4 (&acc)[2][2][4][2], const pg8::Unit& u, int wr, int wc, int fr, int fq) const {
        const int row0 = u.pm * 256 + wr * 64 + fr, col0 = wc * 32 + 8 * fq; pg8::bf16_t* O = (pg8::bf16_t*)(u.pn == 0 ? T1 : T2);
#pragma unroll
        for (int ai = 0; ai < 2; ++ai)
#pragma unroll
            for (int m = 0; m < 4; ++m) { pg8::bf16_t* rowp = O + (size_t)(row0 + ai * 128 + m * 16) * 256 + col0;
#pragma unroll
                for (int bj = 0; bj < 2; ++bj) { const int n0 = u.pn * 256 + col0 + bj * 128; const pg8::f32x4 v0 = acc[ai][bj][m][0], v1 = acc[ai][bj][m][1]; pg8::u32x4 w;
                    w.x = pg8::cvt_pk_bf16(act(n0, v0[0]), act(n0 + 1, v0[1])); w.y = pg8::cvt_pk_bf16(act(n0 + 2, v0[2]), act(n0 + 3, v0[3]));
                    w.z = pg8::cvt_pk_bf16(act(n0 + 4, v1[0]), act(n0 + 5, v1[1])); w.w = pg8::cvt_pk_bf16(act(n0 + 6, v1[2]), act(n0 + 7, v1[3]));
                    *(pg8::u32x4*)(rowp + bj * 128) = w; } }
    }
#endif
    __device__ __forceinline__ void elem(int m, int n, float v) const { if (n < 256) stf(T1 + (size_t)m * 256 + n, act(n, v)); else stf(T2 + (size_t)m * 256 + n - 256, act(n, v)); }
};
__device__ __forceinline__ float decay_of(float lw) { return expf(-0.6065306597f * sigmoidf_(lw)); }
__device__ __forceinline__ void ph_wlora(const float* mu, const float* w1, const float* a1, const float* g1, const float* w2, const float* a2, const float* g2, AT* WL1, AT* WL2A, AT* WL2B, int wg0, int nwg) {
    GSTRIDE_SUB(idx, (size_t)512 * 2048, wg0, nwg) { const int j = (int)(idx >> 11), kk = (int)(idx & 2047), kin = kk & 1023; float w = 0.f, m_ = 0.f;
        if (j < 128) { const int z = j >> 6, c = j & 63; w = w1[((size_t)z * 1024 + kin) * 64 + c]; m_ = mu[1 * D_ + kin]; }
        else if (j < 256) { const int z = (j - 128) >> 6, c = (j - 128) & 63; w = a1[((size_t)z * 1024 + kin) * 64 + c]; m_ = mu[4 * D_ + kin]; }
        else if (j < 416) { w = g1[(size_t)kin * 160 + (j - 256)]; m_ = mu[5 * D_ + kin]; }
        stf(WL1 + idx, kk >= 1024 ? w * m_ : w); }
    GSTRIDE_SUB(idx, (size_t)4096 * 256, wg0, nwg) { const int n4 = (int)(idx >> 8), k = (int)(idx & 255); const int which = n4 >> 10, c = n4 & 1023, z = which & 1; float w = 0.f;
        const int kb = (which < 2 ? 0 : 128) + z * 64;
        if (k >= kb && k < kb + 64) w = (which < 2 ? w2 : a2)[((size_t)z * 64 + (k - kb)) * 1024 + c];
        stf(WL2A + idx, w); }
    GSTRIDE_SUB(idx, (size_t)1024 * 256, wg0, nwg) { const int c = (int)(idx >> 8), k = (int)(idx & 255); stf(WL2B + idx, k < 160 ? g2[(size_t)k * 1024 + c] : 0.f); }
}

__device__ __forceinline__ void cvt_tab16(const float* src, TT* dst, size_t i, float scale) {
#ifndef CPU_EMU
    const float* sp = src + i * 16; pg8::u32x4 w; unsigned ww[4];
#pragma unroll
    for (int j = 0; j < 4; ++j) { const pg8::f32x4 a = *(const pg8::f32x4*)(sp + 4 * j); int pk = 0;
        pk = __builtin_amdgcn_cvt_pk_fp8_f32(a[0] * scale, a[1] * scale, pk, false); pk = __builtin_amdgcn_cvt_pk_fp8_f32(a[2] * scale, a[3] * scale, pk, true); ww[j] = (unsigned)pk; }
    w.x = ww[0]; w.y = ww[1]; w.z = ww[2]; w.w = ww[3];
    *(pg8::u32x4*)(dst + i * 16) = w;
#endif
}

#ifndef CPU_EMU
__device__ __forceinline__ float wave_maxf(float v) {
#pragma unroll
    for (int o = 32; o > 0; o >>= 1) v = fmaxf(v, __shfl_xor(v, o));
    return v; }
__device__ __forceinline__ unsigned q8pack(float a, float b, float c, float d, float inv) {
    const unsigned ia = __float_as_uint(a * inv + 12582912.f), ib = __float_as_uint(b * inv + 12582912.f), ic = __float_as_uint(c * inv + 12582912.f), id = __float_as_uint(d * inv + 12582912.f);
    return (ia & 255u) | ((ib & 255u) << 8) | ((ic & 255u) << 16) | (id << 24); }
__device__ __forceinline__ void cvt_row_i8(const float* src, unsigned char* dst, float* usc, size_t row, int lane) {
    const float* sp = src + row * D_ + 16 * lane; pg8::f32x4 a[4]; float mx = 0.f;
#pragma unroll
    for (int j = 0; j < 4; ++j) { a[j] = *(const pg8::f32x4*)(sp + 4 * j); mx = fmaxf(mx, fmaxf(fmaxf(fabsf(a[j][0]), fabsf(a[j][1])), fmaxf(fabsf(a[j][2]), fabsf(a[j][3])))); }
    mx = wave_maxf(mx); const float inv = mx > 0.f ? 127.f / mx : 0.f; pg8::u32x4 w;
    w.x = q8pack(a[0][0], a[0][1], a[0][2], a[0][3], inv); w.y = q8pack(a[1][0], a[1][1], a[1][2], a[1][3], inv); w.z = q8pack(a[2][0], a[2][1], a[2][2], a[2][3], inv); w.w = q8pack(a[3][0], a[3][1], a[3][2], a[3][3], inv);
    *(pg8::u32x4*)(dst + row * D_ + 16 * lane) = w; if (lane == 0) usc[row] = mx * (1.f / 127.f); }
__device__ __forceinline__ void ph_cvt_tab_i8(const float* src, unsigned char* dst, float* usc, int wg0 = 0, int nwg = 0) {
    if (nwg == 0) nwg = (int)gridDim.x;
    const int tn_ = (int)tid_now(), lane = tn_ & 63, gw = ((int)blockIdx.x - wg0) * 8 + (tn_ >> 6), nw = nwg * 8;
    for (int row = gw; row < 16384; row += nw) cvt_row_i8(src, dst, usc, (size_t)row, lane); }
#endif
__device__ __forceinline__ void ph_wprep(const float* W, int K, int N, int Npad, AT* WT) {
    GSTRIDE(idx, (size_t)Npad * K) { int n = (int)(idx / K), k = (int)(idx % K); stf(WT + idx, n < N ? W[(size_t)k * N + n] : 0.f); }
}
__device__ __forceinline__ void ph_xs(const AT* H, const float* mu, AT* XS, AT* HX) {
    GSTRIDE(idx, (size_t)NTOK * D_) { int m = (int)(idx / D_), k = (int)(idx % D_);
        TokInfo ti = tokinfo(m); float cur = ldf(H + idx);
        float prev = ti.pos > 0 ? ldf(H + idx - D_) : 0.f, nxt = ti.pos < ti.len - 1 ? ldf(H + idx + D_) : 0.f;
        float xx = 0.5f * (prev + nxt) - cur;
        stf(HX + (size_t)m * 2048 + k, cur); stf(HX + (size_t)m * 2048 + 1024 + k, xx);
        stf(XS + idx, cur + xx * mu[0 * D_ + k]); stf(XS + (ROWB / SA) + idx, cur + xx * mu[2 * D_ + k]); stf(XS + 2 * (ROWB / SA) + idx, cur + xx * mu[3 * D_ + k]); }
}

__device__ __forceinline__ void ph_adaln(const float* c, const float* c_ctx, const float* ada_w, const float* ada_b, float* MOD) {
    GSTRIDE(i_, 2 * (B_ + 1) * D6) { int idx = (int)i_;
        int col = idx % D6, row = (idx / D6) % (B_ + 1), layer = idx / (D6 * (B_ + 1));
        const float* cv = row < B_ ? c + row * D_ : c_ctx;
        const float* w = ada_w + (size_t)layer * D_ * D6;
        float acc = ada_b[layer * D6 + col];
        for (int k = 0; k < D_; ++k) { float x = cv[k]; acc += x * sigmoidf_(x) * w[(size_t)k * D6 + col]; }
        MOD[idx] = acc; }
}
__device__ __forceinline__ void ph_init_xc(const float* x, const float* ctx, float* XC) {
    GSTRIDE(idx, (size_t)NTOK * D_) XC[idx] = idx < (size_t)NLAT * D_ ? x[idx] : ctx[idx - (size_t)NLAT * D_];
}
__device__ __forceinline__ void ph_modnorm(float* lds, int ntok, const float* XC, const float* g, const float* MODL, int ishift, int iscale, AT* out, float* fout, const float* xsrc = nullptr, const float* csrc = nullptr) {
    const int half = threadIdx.x >> 8, tid = threadIdx.x & 255; float* red = lds + half * 256;
    const int stride = gridDim.x * 2, iters = (ntok + stride - 1) / stride;
    for (int it = 0; it < iters; ++it) {
        const int m = it * stride + blockIdx.x * 2 + half; const bool act = m < ntok;
        float v[4] = {0.f, 0.f, 0.f, 0.f}, ss = 0.f;
        if (act) { const float* xr = xsrc ? (m < NLAT ? xsrc + (size_t)m * D_ : csrc + (size_t)(m - NLAT) * D_) : XC + (size_t)m * D_;
#pragma unroll
            for (int i = 0; i < 4; ++i) { v[i] = xr[tid + 256 * i]; ss += v[i] * v[i]; } }
        __syncthreads();
        red[tid] = ss; __syncthreads();
        float tot = 0.f; for (int i = 0; i < 256; ++i) tot += red[i];
        float rs = rsqrtf(tot / D_ + 1e-6f);
        if (act) {
            if (fout) {
#pragma unroll
                for (int i = 0; i < 4; ++i) { int d = tid + 256 * i; fout[(size_t)m * D_ + d] = v[i] * rs * g[d]; }
            } else { const float* mr = MODL + (size_t)tok_row(m) * D6;
#pragma unroll
                for (int i = 0; i < 4; ++i) { int d = tid + 256 * i; float y = v[i] * rs * g[d] * (1.f + mr[iscale * D_ + d]) + mr[ishift * D_ + d]; stf(out + (size_t)m * D_ + d, y); } }
        }
    }
}

struct ALPlain { const AT* p; int lda; __device__ __forceinline__ float operator()(int m, int k) const { return ldf(p + (size_t)m * lda + k); } };
struct ALMix { const AT* h; const float* mu;
    __device__ __forceinline__ float operator()(int m, int k) const {
        TokInfo ti = tokinfo(m); float cur = ldf(h + (size_t)m * D_ + k);
        float prev = ti.pos > 0 ? ldf(h + (size_t)(m - 1) * D_ + k) : 0.f;
        float nxt = ti.pos < ti.len - 1 ? ldf(h + (size_t)(m + 1) * D_ + k) : 0.f;
        return cur + (0.5f * (prev + nxt) - cur) * mu[k]; } };
struct EPStore { AT* o; int ldo; int act;
    __device__ __forceinline__ void operator()(int m, int n, float a) const { if (act == 1) a = tanhf(a); if (act == 2) a = sigmoidf_(a); stf(o + (size_t)m * ldo + n, a); } };
struct EPResid { float* XC; const float* MODL; int igate;
    __device__ __forceinline__ void operator()(int m, int n, float a) const { XC[(size_t)m * D_ + n] += MODL[(size_t)tok_row(m) * D6 + igate * D_ + n] * a; } };
struct EPDecay { DT* o; const float* w0z; int z;
    __device__ __forceinline__ void operator()(int m, int n, float a) const { float lw = w0z[n] + a; o[((size_t)m * 2 + z) * D_ + n] = (DT)expf(-0.6065306597f * sigmoidf_(lw)); } };
struct EPAgate { AT* o; const float* a0z; int z;
    __device__ __forceinline__ void operator()(int m, int n, float a) const { stf(o + ((size_t)m * 2 + z) * D_ + n, sigmoidf_(a0z[n] + a)); } };

template <class AL, class EP>
__device__ __forceinline__ void ph_gemm(int M, int N, int K, AL al, const float* Bm, int ldb, EP ep) {
    const int n4 = N / 4;
    GSTRIDE(idx, (size_t)(M / 4) * n4) {
        int m0 = (int)(idx / n4) * 4, n0 = (int)(idx % n4) * 4;
        float acc[4][4];
#pragma unroll
        for (int i = 0; i < 4; ++i)
#pragma unroll
            for (int j = 0; j < 4; ++j) acc[i][j] = 0.f;
        for (int k = 0; k < K; ++k) {
            float a[4], b[4];
#pragma unroll
            for (int i = 0; i < 4; ++i) a[i] = al(m0 + i, k);
#pragma unroll
            for (int j = 0; j < 4; ++j) b[j] = Bm[(size_t)k * ldb + n0 + j];
#pragma unroll
            for (int i = 0; i < 4; ++i)
#pragma unroll
                for (int j = 0; j < 4; ++j) acc[i][j] += a[i] * b[j];
        }
#pragma unroll
        for (int i = 0; i < 4; ++i)
#pragma unroll
            for (int j = 0; j < 4; ++j) ep(m0 + i, n0 + j, acc[i][j]);
    }
}

__device__ __forceinline__ void ph_rope(AT* PROJ) {
    GSTRIDE(idx, (size_t)NLAT * 320) {
        int f = idx % 32, hd = (idx / 32) % 10; int m = (int)(idx / 320);
        int t = m % T_; int axis = f / 16, fr = f % 16;
        float pos = axis == 0 ? (float)(t / 64) : (float)(t % 64);
        float inv = expf(-(float)fr * (9.210340371976184f / 16.f));
        float ang = pos * inv, cs = cosf(ang), sn = sinf(ang);
        AT* p = PROJ + (size_t)m * PROJW + (hd < 8 ? C_SQ + hd * 64 : C_SK + (hd - 8) * 64) + axis * 32 + fr;
        float a = ldf(p), b = ldf(p + 16);
        stf(p, a * cs - b * sn); stf(p + 16, b * cs + a * sn); }
}
__device__ __forceinline__ void ph_gla_loga(const AT* PROJ, const float* dec_w2, const float* dec_b, float* LOGA) {
    GSTRIDE(idx, (size_t)NTOK * 512) {
        int e = idx % 256, z = (idx / 256) % 2; int m = (int)(idx / 512);
        float acc = dec_b[z * 256 + e];
        for (int r = 0; r < 16; ++r) acc += ldf(PROJ + (size_t)m * PROJW + C_LR + z * 16 + r) * dec_w2[(z * 16 + r) * 256 + e];
        float ls = fminf(acc, 0.f) - log1pf(expf(-fabsf(acc)));
        LOGA[idx] = ls * (1.f / 16.f); }
}
__device__ __forceinline__ int scan_token(int b, int z, int step) {
    if (step < L_) { int p = z == 0 ? step : L_ - 1 - step; return NLAT + b * L_ + p; }
    int s2 = step - L_; int p = z == 0 ? s2 : T_ - 1 - s2; return b * T_ + p;
}
constexpr int GLA_THREADS = B_ * 4 * 2 * 128;
__device__ __forceinline__ void ph_gla_scan(const AT* PROJ, const float* LOGA, float* GLAO) {
    GSTRIDE(i_, GLA_THREADS) { int idx = (int)i_;
        int vv = idx % 128, z = (idx / 128) % 2, h = (idx / 256) % 4, b = idx / 1024;
        float S[64];
#pragma unroll
        for (int d = 0; d < 64; ++d) S[d] = 0.f;
        for (int step = 0; step < L_ + T_; ++step) {
            int m = scan_token(b, z, step);
            const AT* pr = PROJ + (size_t)m * PROJW; const float* la = LOGA + ((size_t)m * 2 + z) * 256 + h * 64;
            float vval = ldf(pr + C_GV + h * 128 + vv), o = 0.f;
#pragma unroll
            for (int d = 0; d < 64; ++d) {
                float a = expf(la[d]); float q = ldf(pr + C_GQ + h * 64 + d) * 0.125f, k = ldf(pr + C_GK + h * 64 + d);
                float s = S[d] * a; if (z == 1) o += q * s; s += k * vval; if (z == 0) o += q * s; S[d] = s;
            }
            GLAO[((size_t)z * NTOK + m) * 512 + h * 128 + vv] = o;
        } }
}
__device__ __forceinline__ void ph_gla_out(const AT* PROJ, const float* GLAO, const float* gn, AT* MIX) {
    GSTRIDE(i_, NTOK * 4) { int idx = (int)i_;
        int h = idx % 4, m = idx / 4;
        const float* o0 = GLAO + (size_t)m * 512 + h * 128; const float* o1 = GLAO + ((size_t)NTOK + m) * 512 + h * 128;
        float ss = 0.f; for (int v = 0; v < 128; ++v) { float o = o0[v] + o1[v]; ss += o * o; }
        float rs = rsqrtf(ss / 128.f + 1e-6f);
        for (int v = 0; v < 128; ++v) { float o = o0[v] + o1[v]; float gt = ldf(PROJ + (size_t)m * PROJW + C_GG + h * 128 + v);
            stf(MIX + (size_t)m * D_ + h * 128 + v, o * rs * gn[h * 128 + v] * gt * sigmoidf_(gt)); } }
}
__device__ __forceinline__ void ph_swa(const AT* PROJ, const float* sink, AT* MIX, int skip) {
    const size_t gt = (size_t)blockIdx.x * NT + threadIdx.x, gs = (size_t)gridDim.x * NT;
    if (gt < (size_t)skip) return;
    for (size_t i_ = gt - skip; i_ < (size_t)NTOK * 8; i_ += gs - skip) { int idx = (int)i_;
        int hq = idx % 8, m = idx / 8, g = hq / 4;
        TokInfo ti = tokinfo(m);
        float q[64], acc[64];
#pragma unroll
        for (int d = 0; d < 64; ++d) { q[d] = ldf(PROJ + (size_t)m * PROJW + C_SQ + hq * 64 + d) * 0.125f; acc[d] = 0.f; }
        float mx = sink[hq], l = 1.f;
        int nloc = 0, j0 = 0;
        if (m < NLAT) { j0 = ti.pos - 128 < 0 ? 0 : ti.pos - 128; int j1 = ti.pos + 128 > T_ - 1 ? T_ - 1 : ti.pos + 128; nloc = j1 - j0 + 1; }
        for (int jj = 0; jj < nloc + L_; ++jj) {
            int row = jj < nloc ? ti.b * T_ + j0 + jj : NLAT + ti.b * L_ + (jj - nloc);
            const AT* kp = PROJ + (size_t)row * PROJW + C_SK + g * 64; const AT* vp = PROJ + (size_t)row * PROJW + C_SV + g * 64;
            float s = 0.f;
#pragma unroll
            for (int d = 0; d < 64; ++d) s += q[d] * ldf(kp + d);
            if (s > mx) { float sc = expf(mx - s); l *= sc;
#pragma unroll
                for (int d = 0; d < 64; ++d) acc[d] *= sc;
                mx = s; }
            float p = expf(s - mx); l += p;
#pragma unroll
            for (int d = 0; d < 64; ++d) acc[d] += p * ldf(vp + d);
        }
        float il = 1.f / l;
#pragma unroll
        for (int d = 0; d < 64; ++d) stf(MIX + (size_t)m * D_ + 512 + hq * 64 + d, acc[d] * il); }
}

constexpr int PT_WORDS = 4864;
__device__ __forceinline__ void ph_peer_topk(float* lds, int ntok, const float* SC, int* PIDX, float* PGATE) {
    const int half = threadIdx.x >> 8, tid = threadIdx.x & 255; float* base = lds + half * PT_WORDS;
    float (*sc)[128] = (float (*)[128])base; float (*tv)[16] = (float (*)[16])(base + 2048); int (*ti)[16] = (int (*)[16])(base + 2304);
    float (*cv)[256] = (float (*)[256])(base + 2560); float (*ss)[16] = (float (*)[16])(base + 4608); int (*si)[16] = (int (*)[16])(base + 4736);
    const int stride = gridDim.x * 2, iters = (ntok + stride - 1) / stride;
    for (int it = 0; it < iters; ++it) {
        const int m = it * stride + blockIdx.x * 2 + half; const bool act = m < ntok;
        __syncthreads();
        if (act) for (int i = 0; i < 8; ++i) { int e = tid + 256 * i; sc[e / 128][e % 128] = SC[(size_t)m * 2048 + e]; }
        __syncthreads();
        if (act) for (int i = 0; i < 8; ++i) { int e = tid + 256 * i; int list = e / 128, n = e % 128; float s = sc[list][n]; int r = 0;
            for (int j = 0; j < 128; ++j) { float o = sc[list][j]; r += (o > s || (o == s && j < n)) ? 1 : 0; }
            if (r < 16) { tv[list][r] = s; ti[list][r] = n; } }
        __syncthreads();
        if (act) for (int i = 0; i < 8; ++i) { int e = tid + 256 * i; int h = e / 256, c = e % 256; cv[h][c] = tv[2 * h][c / 16] + tv[2 * h + 1][c % 16]; }
        __syncthreads();
        if (act) for (int i = 0; i < 8; ++i) { int e = tid + 256 * i; int h = e / 256, c = e % 256; float s = cv[h][c]; int r = 0;
            for (int j = 0; j < 256; ++j) { float o = cv[h][j]; r += (o > s || (o == s && j < c)) ? 1 : 0; }
            if (r < 16) { ss[h][r] = s; si[h][r] = ti[2 * h][c / 16] * 128 + ti[2 * h + 1][c % 16]; } }
        __syncthreads();
        if (act && tid < 128) { int h = tid / 16, r = tid % 16; float mx = ss[h][0], sum = 0.f;
            for (int j = 0; j < 16; ++j) sum += expf(ss[h][j] - mx);
            PIDX[(size_t)m * 128 + tid] = si[h][r]; PGATE[(size_t)m * 128 + tid] = expf(ss[h][r] - mx) / sum; }
    }
}
constexpr int PA_WORDS = 1536;
__device__ __forceinline__ void ph_peer_apply(float* lds, int ntok, const AT* F, const int* PIDX, const float* PGATE, const float* U, const float* V, const float* MODL, float* XC) {
    const int half = threadIdx.x >> 8, tid = threadIdx.x & 255; float* base = lds + half * PA_WORDS;
    float* tvec = base; float* part = base + 1024; float* coef = base + 1280; int* eid = (int*)(base + 1408);
    const int stride = gridDim.x * 2, iters = (ntok + stride - 1) / stride;
    for (int it = 0; it < iters; ++it) {
        const int m = it * stride + blockIdx.x * 2 + half; const bool act = m < ntok;
        __syncthreads();
        if (act) { for (int i = 0; i < 4; ++i) tvec[tid + 256 * i] = ldf(F + (size_t)m * D_ + tid + 256 * i);
            if (tid < 128) eid[tid] = PIDX[(size_t)m * 128 + tid]; }
        __syncthreads();
        if (act) { int e = tid / 2, hf = tid % 2; const float* ur = U + (size_t)eid[e] * D_ + hf * 512; float s = 0.f;
            for (int d = 0; d < 512; ++d) s += ur[d] * (1.f / 32.f) * tvec[hf * 512 + d];
            part[tid] = s; }
        __syncthreads();
        if (act && tid < 128) { float a = part[2 * tid] + part[2 * tid + 1]; coef[tid] = PGATE[(size_t)m * 128 + tid] * 0.5f * a * (1.f + erff(a * 0.70710678118f)); }
        __syncthreads();
        if (act) { const float* mr = MODL + (size_t)tok_row(m) * D6 + 5 * D_;
            for (int i = 0; i < 4; ++i) { int col = tid + 256 * i; float acc = 0.f;
                for (int e = 0; e < 128; ++e) acc += coef[e] * V[(size_t)eid[e] * D_ + col];
                XC[(size_t)m * D_ + col] += mr[col] * acc; } }
    }
}

__device__ __forceinline__ void ph_rw_kk(const AT* K, const float* k_k, AT* KK) {
    GSTRIDE(i_, NTOK * 16) { int idx = (int)i_;
        int h = idx % 16, m = idx / 16; float ss = 0.f;
        for (int n = 0; n < 64; ++n) { float x = ldf(K + (size_t)m * D_ + h * 64 + n) * k_k[h * 64 + n]; ss += x * x; }
        float rs = rsqrtf(fmaxf(ss, 1e-24f));
        for (int n = 0; n < 64; ++n) stf(KK + (size_t)m * D_ + h * 64 + n, ldf(K + (size_t)m * D_ + h * 64 + n) * k_k[h * 64 + n] * rs); }
}
__device__ __forceinline__ void ph_rw_scan(const AT* R, const AT* K, const AT* V, const AT* KK, const AT* A, const AT* DEC, const float* w0, const float* a0, const float* k_a, AT* Y0, AT* Y1) {
    GSTRIDE(i_, B_ * 16 * 2 * 64) { int idx = (int)i_;
        int vv = idx % 64, z = (idx / 64) % 2, h = (idx / 128) % 16, b = idx / 2048;
        float S[64];
#pragma unroll
        for (int d = 0; d < 64; ++d) S[d] = 0.f;
        AT* Y = z == 0 ? Y0 : Y1;
        for (int step = 0; step < L_ + T_; ++step) {
            int m = scan_token(b, z, step);
            size_t o1 = (size_t)m * D_ + h * 64, o2 = ((size_t)m * 2 + z) * D_ + h * 64;
            float sa = 0.f;
#pragma unroll
            for (int d = 0; d < 64; ++d) sa += S[d] * ldf(KK + o1 + d);
            float vval = ldf(V + o1 + vv), y = 0.f;
            bool lat = m < NLAT;
#pragma unroll
            for (int d = 0; d < 64; ++d) {
                float w = decay_of(ldf(DEC + o2 + d) + w0[z * D_ + h * 64 + d]), a = sigmoidf_(ldf(A + o2 + d) + a0[z * D_ + h * 64 + d]), k = ldf(K + o1 + d), kk = ldf(KK + o1 + d);
                float kd = k * (1.f + (a - 1.f) * k_a[h * 64 + d]);
                float s = S[d] * w - sa * (kk * a) + vval * kd; S[d] = s;
                if (lat) y += s * ldf(R + o1 + d);
            }
            if (lat) stf(Y + o1 + vv, y);
        } }
}

#ifndef CPU_EMU
typedef float f4_t __attribute__((ext_vector_type(4)));
typedef float f2_t __attribute__((ext_vector_type(2)));
typedef unsigned u2_t __attribute__((ext_vector_type(2)));
typedef _Float16 h4_t __attribute__((ext_vector_type(4)));
#define DPP_ADD(v, ctrl) v += __int_as_float(__builtin_amdgcn_update_dpp(0, __float_as_int(v), ctrl, 0xF, 0xF, true))
__device__ __forceinline__ float allsum16(float v) {
    DPP_ADD(v, 0xB1); DPP_ADD(v, 0x4E); DPP_ADD(v, 0x141); DPP_ADD(v, 0x140); return v; }
__device__ __forceinline__ f4_t bf4(u2_t u) { f4_t r; r.x = __uint_as_float(u.x << 16); r.y = __uint_as_float(u.x & 0xffff0000u); r.z = __uint_as_float(u.y << 16); r.w = __uint_as_float(u.y & 0xffff0000u); return r; }
__device__ __forceinline__ unsigned short f2bf_bits(float f) { unsigned u = __float_as_uint(f); return (unsigned short)((u + 0x7fffu + ((u >> 16) & 1u)) >> 16); }

constexpr int RTS = 32;
__device__ __forceinline__ void ph_rw_scan2(unsigned char* lds, const AT* R, const AT* K, const AT* V, const float* k_k, const AT* A, const AT* DEC, const float* w0, const float* a0, const float* k_a, AT* Y0, AT* Y1) {
    float* buf = (float*)lds;
    float* yb = buf + 2 * 6 * RTS * 64;
    const int tid = (int)tid_now(), w = tid >> 6, l = tid & 63, rp = l >> 4, kc = l & 15;
    const int v0 = w * 8 + rp * 2, k0 = kc * 4;
    const int ss = tid >> 4, kq = tid & 15;
    constexpr int NCH = (L_ + T_) / RTS;
    for (int sc = blockIdx.x; sc < B_ * 32; sc += gridDim.x) {
        const int z = sc & 1, h = (sc >> 1) & 15, b = sc >> 5;
        AT* Y = z == 0 ? Y0 : Y1;
        const f4_t ka4 = *(const f4_t*)(k_a + h * 64 + kq * 4), w04 = *(const f4_t*)(w0 + z * D_ + h * 64 + kq * 4), a04 = *(const f4_t*)(a0 + z * D_ + h * 64 + kq * 4), kk4c = *(const f4_t*)(k_k + h * 64 + kq * 4);
        f4_t S0 = {0.f, 0.f, 0.f, 0.f}, S1 = {0.f, 0.f, 0.f, 0.f};
        u2_t gk, gv, gr, gd, ga;
#define RW_LOAD(c) do { const int m_ = scan_token(b, z, (c) * RTS + ss); const size_t o1_ = (size_t)m_ * D_ + h * 64 + kq * 4, o2_ = ((size_t)m_ * 2 + z) * D_ + h * 64 + kq * 4; \
        gk = *(const u2_t*)(K + o1_); gv = *(const u2_t*)(V + o1_); ga = *(const u2_t*)(A + o2_); gd = *(const u2_t*)(DEC + o2_); \
        if (m_ < NLAT) gr = *(const u2_t*)(R + o1_); else { gr.x = 0u; gr.y = 0u; } } while (0)
#define RW_STORE(bi) do { float* q_ = buf + (bi) * 6 * RTS * 64 + ss * 64 + kq * 4; const f4_t k_ = bf4(gk), ar_ = bf4(ga) + a04, wr_ = bf4(gd) + w04; f4_t a_, w_, kk_ = k_ * kk4c; \
        kk_ = kk_ * rsqrtf(fmaxf(allsum16(kk_.x * kk_.x + kk_.y * kk_.y + kk_.z * kk_.z + kk_.w * kk_.w), 1e-24f)); \
        a_.x = fsig(ar_.x); a_.y = fsig(ar_.y); a_.z = fsig(ar_.z); a_.w = fsig(ar_.w); \
        w_.x = __expf(-0.6065306597f * fsig(wr_.x)); w_.y = __expf(-0.6065306597f * fsig(wr_.y)); w_.z = __expf(-0.6065306597f * fsig(wr_.z)); w_.w = __expf(-0.6065306597f * fsig(wr_.w)); \
        *(f4_t*)(q_) = w_; *(f4_t*)(q_ + RTS * 64) = kk_ * a_; *(f4_t*)(q_ + 2 * RTS * 64) = k_ * (1.f + (a_ - 1.f) * ka4); *(f4_t*)(q_ + 3 * RTS * 64) = kk_; \
        *(f4_t*)(q_ + 4 * RTS * 64) = bf4(gr); *(f4_t*)(q_ + 5 * RTS * 64) = bf4(gv); } while (0)
        RW_LOAD(0); RW_STORE(0); __syncthreads();
        for (int c = 0; c < NCH; ++c) {
            if (c + 1 < NCH) RW_LOAD(c + 1);
            const float* bb = buf + (c & 1) * 6 * RTS * 64; float* yo = yb + (c & 1) * RTS * 64;
            f4_t w4 = *(const f4_t*)(bb + k0), kka4 = *(const f4_t*)(bb + RTS * 64 + k0), kd4 = *(const f4_t*)(bb + 2 * RTS * 64 + k0);
            f4_t kk4 = *(const f4_t*)(bb + 3 * RTS * 64 + k0), r4 = *(const f4_t*)(bb + 4 * RTS * 64 + k0);
            f2_t vv = *(const f2_t*)(bb + 5 * RTS * 64 + v0);
            f4_t rp = r4;
#pragma unroll 4
            for (int s = 0; s < RTS; ++s) {
                const int sn = (s + 1 < RTS ? s + 1 : s) * 64;
                const f4_t nw4 = *(const f4_t*)(bb + sn + k0), nkka4 = *(const f4_t*)(bb + RTS * 64 + sn + k0), nkd4 = *(const f4_t*)(bb + 2 * RTS * 64 + sn + k0);
                const f4_t nkk4 = *(const f4_t*)(bb + 3 * RTS * 64 + sn + k0), nr4 = *(const f4_t*)(bb + 4 * RTS * 64 + sn + k0);
                const f2_t nvv = *(const f2_t*)(bb + 5 * RTS * 64 + sn + v0);
                float sa0 = S0.x * kk4.x + S0.y * kk4.y + S0.z * kk4.z + S0.w * kk4.w;
                float sa1 = S1.x * kk4.x + S1.y * kk4.y + S1.z * kk4.z + S1.w * kk4.w;
                float y0 = S0.x * rp.x + S0.y * rp.y + S0.z * rp.z + S0.w * rp.w;
                float y1 = S1.x * rp.x + S1.y * rp.y + S1.z * rp.z + S1.w * rp.w;
                sa0 = allsum16(sa0); sa1 = allsum16(sa1); y0 = allsum16(y0); y1 = allsum16(y1);
                if (kc == 0 && s > 0) { f2_t yy; yy.x = y0; yy.y = y1; *(f2_t*)(yo + (s - 1) * 64 + v0) = yy; }
                S0 = S0 * w4 - sa0 * kka4 + vv.x * kd4;
                S1 = S1 * w4 - sa1 * kka4 + vv.y * kd4;
                rp = r4;
                w4 = nw4; kka4 = nkka4; kd4 = nkd4; kk4 = nkk4; r4 = nr4; vv = nvv;
            }
            { float y0 = S0.x * rp.x + S0.y * rp.y + S0.z * rp.z + S0.w * rp.w, y1 = S1.x * rp.x + S1.y * rp.y + S1.z * rp.z + S1.w * rp.w;
              y0 = allsum16(y0); y1 = allsum16(y1);
              if (kc == 0) { f2_t yy; yy.x = y0; yy.y = y1; *(f2_t*)(yo + (RTS - 1) * 64 + v0) = yy; } }
            if (c + 1 < NCH) RW_STORE((c + 1) & 1);
            __syncthreads();
            if (c * RTS >= L_) {
#pragma unroll
                for (int i = 0; i < 4; ++i) { const int e = tid + 512 * i, s = e >> 6, vx = e & 63; const int m = scan_token(b, z, c * RTS + s);
                    stf(Y + (size_t)m * D_ + h * 64 + vx, yo[s * 64 + vx]); }
            }
        }
        __syncthreads();
#undef RW_LOAD
#undef RW_STORE
    }
}

constexpr int GTS = 32;
__device__ __forceinline__ void ph_gla_scan2(unsigned char* lds, const AT* PROJ, const float* dec_w2, const float* dec_b, float* GLAO) {
    float* buf = (float*)lds;
    constexpr int BSZ = 3 * GTS * 64 + GTS * 32;
    float* ob = buf + 2 * BSZ;
    float* w2s = ob + 2 * GTS * 32;
    const int tid = (int)tid_now(), col = tid >> 4, dc = tid & 15, d0 = dc * 4;
    const int ss = tid >> 4, dq = tid & 15;
    constexpr int NCH = (L_ + T_) / GTS;
    for (int it = blockIdx.x; it < B_ * 32; it += gridDim.x) {
        const int vq = it & 3, z = (it >> 2) & 1, h = (it >> 3) & 3, b = it >> 5;
        __syncthreads();
        for (int i = tid; i < 16 * 64; i += NT) w2s[i] = dec_w2[(z * 16 + (i >> 6)) * 256 + h * 64 + (i & 63)];
        const f4_t db4 = *(const f4_t*)(dec_b + z * 256 + h * 64 + dq * 4);
        __syncthreads();
        f4_t S = {0.f, 0.f, 0.f, 0.f};
        u2_t gq, gk, gv; pg8::u32x4 glr0, glr1;
#define GL_LOAD(c) do { const int m_ = scan_token(b, z, (c) * GTS + ss); const AT* pr_ = PROJ + (size_t)m_ * PROJW; \
        gq = *(const u2_t*)(pr_ + C_GQ + h * 64 + dq * 4); gk = *(const u2_t*)(pr_ + C_GK + h * 64 + dq * 4); \
        glr0 = *(const pg8::u32x4*)(pr_ + C_LR + z * 16); glr1 = *(const pg8::u32x4*)(pr_ + C_LR + z * 16 + 8); \
        if (dq < 8) gv = *(const u2_t*)(pr_ + C_GV + h * 128 + vq * 32 + dq * 4); } while (0)
#define GL_STORE(bi) do { float* q_ = buf + (bi) * BSZ + ss * 64 + dq * 4; f4_t x_ = db4; \
        const unsigned lr_[8] = {glr0.x, glr0.y, glr0.z, glr0.w, glr1.x, glr1.y, glr1.z, glr1.w}; \
        _Pragma("unroll") for (int r_ = 0; r_ < 8; ++r_) { const float l0_ = __uint_as_float(lr_[r_] << 16), l1_ = __uint_as_float(lr_[r_] & 0xffff0000u); \
            x_ += l0_ * *(const f4_t*)(w2s + (2 * r_) * 64 + dq * 4); x_ += l1_ * *(const f4_t*)(w2s + (2 * r_ + 1) * 64 + dq * 4); } \
        f4_t a_; a_.x = expf((fminf(x_.x, 0.f) - log1pf(expf(-fabsf(x_.x)))) * 0.0625f); a_.y = expf((fminf(x_.y, 0.f) - log1pf(expf(-fabsf(x_.y)))) * 0.0625f); \
        a_.z = expf((fminf(x_.z, 0.f) - log1pf(expf(-fabsf(x_.z)))) * 0.0625f); a_.w = expf((fminf(x_.w, 0.f) - log1pf(expf(-fabsf(x_.w)))) * 0.0625f); \
        *(f4_t*)(q_) = a_; *(f4_t*)(q_ + GTS * 64) = bf4(gq) * 0.125f; *(f4_t*)(q_ + 2 * GTS * 64) = bf4(gk); \
        if (dq < 8) *(f4_t*)(buf + (bi) * BSZ + 3 * GTS * 64 + ss * 32 + dq * 4) = bf4(gv); } while (0)
        GL_LOAD(0); GL_STORE(0); __syncthreads();
        for (int c = 0; c < NCH; ++c) {
            if (c + 1 < NCH) GL_LOAD(c + 1);
            const float* bb = buf + (c & 1) * BSZ; float* oo = ob + (c & 1) * GTS * 32;
            f4_t a4 = *(const f4_t*)(bb + d0), q4 = *(const f4_t*)(bb + GTS * 64 + d0), k4 = *(const f4_t*)(bb + 2 * GTS * 64 + d0); float vv = bb[3 * GTS * 64 + col];
#define GL_STEPS(INCL) _Pragma("unroll 8") for (int s = 0; s < GTS; ++s) { const int sn = s + 1 < GTS ? s + 1 : s; \
                const f4_t na4 = *(const f4_t*)(bb + sn * 64 + d0), nq4 = *(const f4_t*)(bb + GTS * 64 + sn * 64 + d0), nk4 = *(const f4_t*)(bb + 2 * GTS * 64 + sn * 64 + d0); \
                const float nvv = bb[3 * GTS * 64 + sn * 32 + col]; float o; \
                if (INCL) { S = S * a4 + k4 * vv; o = S.x * q4.x + S.y * q4.y + S.z * q4.z + S.w * q4.w; } \
                else { S = S * a4; o = S.x * q4.x + S.y * q4.y + S.z * q4.z + S.w * q4.w; S = S + k4 * vv; } \
                o = allsum16(o); if (dc == 0) oo[s * 32 + col] = o; \
                a4 = na4; q4 = nq4; k4 = nk4; vv = nvv; }
            if (z == 0) { GL_STEPS(true) } else { GL_STEPS(false) }
#undef GL_STEPS
            if (c + 1 < NCH) GL_STORE((c + 1) & 1);
            __syncthreads();
#pragma unroll
            for (int i = 0; i < 2; ++i) { const int e = tid + 512 * i, s = e >> 5, vx = e & 31; const int m = scan_token(b, z, c * GTS + s);
                GLAO[((size_t)z * NTOK + m) * 512 + h * 128 + vq * 32 + vx] = oo[s * 32 + vx]; }
        }
        __syncthreads();
#undef GL_LOAD
#undef GL_STORE
    }
}

typedef __bf16 bf16x2_t __attribute__((ext_vector_type(2)));
__device__ __forceinline__ float dot2bf(unsigned a, unsigned b, float acc) { return __builtin_amdgcn_fdot2_f32_bf16(__builtin_bit_cast(bf16x2_t, a), __builtin_bit_cast(bf16x2_t, b), acc, false); }
__device__ __forceinline__ float wave_total(float v) {
    v = allsum16(v);
    v += __int_as_float(__builtin_amdgcn_update_dpp(0, __float_as_int(v), 0x142, 0xA, 0xF, false));
    v += __int_as_float(__builtin_amdgcn_update_dpp(0, __float_as_int(v), 0x143, 0xC, 0xF, false));
    return __int_as_float(__builtin_amdgcn_readlane(__float_as_int(v), 63));
}
__device__ __forceinline__ unsigned f2key(float f) { const unsigned u = __float_as_uint(f); return u ^ ((unsigned)((int)u >> 31) | 0x80000000u); }
__device__ __forceinline__ float key2f(unsigned k) { return __uint_as_float((k & 0x80000000u) ? (k ^ 0x80000000u) : ~k); }
#define INS16(r, x_) do { unsigned x__ = (x_); _Pragma("unroll") for (int i_ = 0; i_ < 16; ++i_) { const unsigned hi_ = r[i_] > x__ ? r[i_] : x__; x__ = r[i_] > x__ ? x__ : r[i_]; r[i_] = hi_; } } while (0)
__device__ __forceinline__ void ph_topk2(int ntok, const float* SC, int* PIDX, float* PGATE) {
    const int tn_ = (int)tid_now(), lane = tn_ & 63, gw = blockIdx.x * 8 + (tn_ >> 6), nw = gridDim.x * 8;
    const int ntask = (ntok / 64) * 8;
    for (int it = 0;; ++it) { const int task = it == 0 ? gw : (((tn_ >> 6) == 0) ? nw + (int)blockIdx.x + (it - 1) * (int)gridDim.x : ntask); if (task >= ntask) { if (it == 0) continue; break; }
        const int tile = task >> 3, h = task & 7, m = tile * 64 + lane;
        const float* row = SC + (size_t)m * 2048 + h * 256;
        unsigned r1[16], r2[16];
#define TK_CE(a_, b_) do { const unsigned hi_ = a_ > b_ ? a_ : b_, lo_ = a_ > b_ ? b_ : a_; a_ = hi_; b_ = lo_; } while (0)
#define TK_SORT16(x_) do { _Pragma("unroll") for (int k_ = 2; k_ <= 16; k_ <<= 1) { _Pragma("unroll") for (int j_ = k_ >> 1; j_ > 0; j_ >>= 1) { _Pragma("unroll") for (int i_ = 0; i_ < 16; ++i_) { const int l_ = i_ ^ j_; \
        if (l_ > i_) { if ((i_ & k_) == 0) TK_CE(x_[i_], x_[l_]); else TK_CE(x_[l_], x_[i_]); } } } } } while (0)
#define TK_MERGE16(x_) do { _Pragma("unroll") for (int j_ = 8; j_ > 0; j_ >>= 1) { _Pragma("unroll") for (int i_ = 0; i_ < 16; ++i_) { const int l_ = i_ ^ j_; if (l_ > i_) TK_CE(x_[i_], x_[l_]); } } } while (0)
#define TK_LOADSORT(xg_, base_, gq_) do { _Pragma("unroll") for (int q_ = 0; q_ < 4; ++q_) { const f4_t v_ = *(const f4_t*)((base_) + (gq_) * 16 + q_ * 4); const int j0_ = (gq_) * 16 + q_ * 4; \
                xg_[4 * q_] = (f2key(v_.x) & ~127u) | (unsigned)(127 - j0_); xg_[4 * q_ + 1] = (f2key(v_.y) & ~127u) | (unsigned)(126 - j0_); xg_[4 * q_ + 2] = (f2key(v_.z) & ~127u) | (unsigned)(125 - j0_); xg_[4 * q_ + 3] = (f2key(v_.w) & ~127u) | (unsigned)(124 - j0_); } \
            TK_SORT16(xg_); } while (0)
#define TK_LIST(rr_, base_) do { TK_LOADSORT(rr_, base_, 0); \
        for (int gq_ = 1; gq_ < 8; ++gq_) { unsigned xg_[16]; TK_LOADSORT(xg_, base_, gq_); \
            _Pragma("unroll") for (int i_ = 0; i_ < 16; ++i_) rr_[i_] = rr_[i_] > xg_[15 - i_] ? rr_[i_] : xg_[15 - i_]; TK_MERGE16(rr_); __builtin_amdgcn_sched_barrier(0); } } while (0)
        TK_LIST(r1, row); TK_LIST(r2, row + 128);
#undef TK_LIST
#undef TK_LOADSORT
#undef TK_MERGE16
#undef TK_SORT16
#undef TK_CE
        unsigned ck[16]; int cp[16];
#pragma unroll
        for (int i = 0; i < 16; ++i) ck[i] = 0u;
#pragma unroll
        for (int a = 0; a < 16; ++a)
#pragma unroll
            for (int b = 0; b < 16; ++b) if ((a + 1) * (b + 1) <= 16) {
                unsigned key = (f2key(key2f(r1[a] & ~127u) + key2f(r2[b] & ~127u)) & ~255u) | (unsigned)(a * 16 + b);
#pragma unroll
                for (int i = 0; i < 16; ++i) { const unsigned hi_ = key > ck[i] ? key : ck[i], lo_ = key > ck[i] ? ck[i] : key; ck[i] = hi_; key = lo_; }
                __builtin_amdgcn_sched_barrier(0);
            }
        { unsigned p1[4], p2[4];
#pragma unroll
          for (int d = 0; d < 4; ++d) { p1[d] = (r1[4 * d] & 127u) | ((r1[4 * d + 1] & 127u) << 8) | ((r1[4 * d + 2] & 127u) << 16) | ((r1[4 * d + 3] & 127u) << 24);
              p2[d] = (r2[4 * d] & 127u) | ((r2[4 * d + 1] & 127u) << 8) | ((r2[4 * d + 2] & 127u) << 16) | ((r2[4 * d + 3] & 127u) << 24); }
#pragma unroll
          for (int i = 0; i < 16; ++i) { const unsigned ab = ck[i] & 255u, a = ab >> 4, b = ab & 15u;
              const unsigned s1 = (a & 8u) ? ((a & 4u) ? p1[3] : p1[2]) : ((a & 4u) ? p1[1] : p1[0]), s2 = (b & 8u) ? ((b & 4u) ? p2[3] : p2[2]) : ((b & 4u) ? p2[1] : p2[0]);
              const unsigned f1 = (s1 >> ((a & 3u) * 8u)) & 127u, f2 = (s2 >> ((b & 3u) * 8u)) & 127u;
              cp[i] = (int)((127u - f1) * 128u + (127u - f2)); ck[i] &= ~255u; } }
        const float mx = key2f(ck[0]); float e[16], sum = 0.f;
#pragma unroll
        for (int i = 0; i < 16; ++i) { e[i] = __expf(key2f(ck[i]) - mx); sum += e[i]; }
        const float inv = 1.f / sum;
        int* pi = PIDX + (size_t)m * 128 + h * 16; float* pg = PGATE + (size_t)m * 128 + h * 16;
#pragma unroll
        for (int i = 0; i < 16; i += 4) { pg8::u32x4 w; w.x = (unsigned)cp[i]; w.y = (unsigned)cp[i + 1]; w.z = (unsigned)cp[i + 2]; w.w = (unsigned)cp[i + 3]; *(pg8::u32x4*)(pi + i) = w;
            f4_t g; g.x = e[i] * inv; g.y = e[i + 1] * inv; g.z = e[i + 2] * inv; g.w = e[i + 3] * inv; *(f4_t*)(pg + i) = g; }
    }
}
__device__ __forceinline__ void unpk8(pg8::u32x4 u, float (&o)[8]) {
    o[0] = __uint_as_float(u.x << 16); o[1] = __uint_as_float(u.x & 0xffff0000u); o[2] = __uint_as_float(u.y << 16); o[3] = __uint_as_float(u.y & 0xffff0000u);
    o[4] = __uint_as_float(u.z << 16); o[5] = __uint_as_float(u.z & 0xffff0000u); o[6] = __uint_as_float(u.w << 16); o[7] = __uint_as_float(u.w & 0xffff0000u); }
__device__ __forceinline__ void cvt16(pg8::u32x4 w, float (&o)[16]) {
    const unsigned ww[4] = {w.x, w.y, w.z, w.w};
#pragma unroll
    for (int j = 0; j < 4; ++j) { const f2_t lo = __builtin_amdgcn_cvt_pk_f32_fp8((int)ww[j], false), hi = __builtin_amdgcn_cvt_pk_f32_fp8((int)ww[j], true); o[4 * j] = lo.x; o[4 * j + 1] = lo.y; o[4 * j + 2] = hi.x; o[4 * j + 3] = hi.y; }
}
template <int NTK, int BS>
__device__ __forceinline__ void ph_peer_apply2(int ntok, const AT* F, const int* PIDX, const float* PGATE, const TT* TU, const TT* TV, const float* MODL, float* XC, float gscale, const float* fin_g = nullptr, float* fin_out = nullptr) {
    const int tn_ = (int)tid_now(), lane = tn_ & 63, gw = blockIdx.x * 8 + (tn_ >> 6), nw = gridDim.x * 8;
    for (int m0 = gw; m0 < ntok; m0 += nw * NTK) {
        f2_t t2[NTK][8]; int eh[NTK][2]; float gh[NTK][2], dh[NTK][2]; bool ok[NTK];
#pragma unroll
        for (int q = 0; q < NTK; ++q) { const int m = m0 + q * nw; ok[q] = m < ntok; const int mm = ok[q] ? m : m0; dh[q][0] = 0.f; dh[q][1] = 0.f;
            { const pg8::u32x4 ta = *(const pg8::u32x4*)(F + (size_t)mm * D_ + 16 * lane), tb = *(const pg8::u32x4*)(F + (size_t)mm * D_ + 16 * lane + 8); float x0[8], x1[8]; unpk8(ta, x0); unpk8(tb, x1);
#pragma unroll
              for (int j = 0; j < 4; ++j) { t2[q][j].x = x0[2 * j]; t2[q][j].y = x0[2 * j + 1]; t2[q][4 + j].x = x1[2 * j]; t2[q][4 + j].y = x1[2 * j + 1]; } }
            unsigned k0 = ((unsigned)PIDX[(size_t)mm * 128 + lane] << 7) | (unsigned)lane, k1 = ((unsigned)PIDX[(size_t)mm * 128 + 64 + lane] << 7) | (unsigned)(64 + lane);
#pragma unroll
            for (int k = 2; k <= 128; k <<= 1)
#pragma unroll
                for (int j = k >> 1; j > 0; j >>= 1) {
                    if (j == 64) { const unsigned lo = k0 < k1 ? k0 : k1, hi = k0 < k1 ? k1 : k0; k0 = lo; k1 = hi; }
                    else { const unsigned p0 = (unsigned)__shfl_xor((int)k0, j), p1 = (unsigned)__shfl_xor((int)k1, j);
                        const bool low = (lane & j) == 0; const bool asc0 = (lane & k) == 0, asc1 = ((64 + lane) & k) == 0; const bool min0 = low == asc0, min1 = low == asc1;
                        k0 = min0 ? (k0 < p0 ? k0 : p0) : (k0 > p0 ? k0 : p0); k1 = min1 ? (k1 < p1 ? k1 : p1) : (k1 > p1 ? k1 : p1); } }
            eh[q][0] = (int)(k0 >> 7); eh[q][1] = (int)(k1 >> 7); gh[q][0] = PGATE[(size_t)mm * 128 + (k0 & 127u)]; gh[q][1] = PGATE[(size_t)mm * 128 + (k1 & 127u)]; }
        __syncthreads();
        static_assert(BS == 4, "the batched reduction below sums four experts at a time");
        const __amdgpu_buffer_rsrc_t ru = __builtin_amdgcn_make_buffer_rsrc((void*)TU, 0, 16384 * D_, 0x00020000), rv = __builtin_amdgcn_make_buffer_rsrc((void*)TV, 0, 16384 * D_, 0x00020000);
        const int voff = 16 * lane;
        pg8::u32x4 rw[NTK][BS];
#define PA_LOADQ(rs, q, hf, jb_) do { _Pragma("unroll") for (int j = 0; j < BS; ++j) { \
            const int e = __builtin_amdgcn_readlane(eh[q][hf], (jb_) + j); rw[q][j] = __builtin_amdgcn_raw_buffer_load_b128(rs, voff, e << 10, 0); } } while (0)
#define PA_UCOMPQ(q, hf, jb) do { float p[4]; \
            _Pragma("unroll") for (int j = 0; j < 4; ++j) { const unsigned ww[4] = {rw[q][j].x, rw[q][j].y, rw[q][j].z, rw[q][j].w}; f2_t ac = {0.f, 0.f}; \
                _Pragma("unroll") for (int k = 0; k < 4; ++k) { ac += __builtin_amdgcn_cvt_pk_f32_fp8((int)ww[k], false) * t2[q][2 * k]; ac += __builtin_amdgcn_cvt_pk_f32_fp8((int)ww[k], true) * t2[q][2 * k + 1]; } \
                p[j] = ac.x + ac.y; } \
            const bool b0 = (lane & 1) != 0, b1 = (lane & 2) != 0; \
            float ra = b0 ? p[1] : p[0], sa = b0 ? p[0] : p[1], rc = b0 ? p[3] : p[2], sc = b0 ? p[2] : p[3]; \
            ra += __int_as_float(__builtin_amdgcn_update_dpp(0, __float_as_int(sa), 0xB1, 0xF, 0xF, true)); rc += __int_as_float(__builtin_amdgcn_update_dpp(0, __float_as_int(sc), 0xB1, 0xF, 0xF, true)); \
            float rd = b1 ? rc : ra, sd = b1 ? ra : rc; \
            rd += __int_as_float(__builtin_amdgcn_update_dpp(0, __float_as_int(sd), 0x4E, 0xF, 0xF, true)); \
            rd += __int_as_float(__builtin_amdgcn_update_dpp(0, __float_as_int(rd), 0x124, 0xF, 0xF, true)); \
            rd += __int_as_float(__builtin_amdgcn_update_dpp(0, __float_as_int(rd), 0x128, 0xF, 0xF, true)); \
            rd += __shfl_xor(rd, 16); rd += __shfl_xor(rd, 32); \
            dh[q][hf] = ((lane >> 2) == ((jb) >> 2)) ? rd : dh[q][hf]; } while (0)
#define PA_VCOMPQ(q, hf, jb) do { _Pragma("unroll") for (int j = 0; j < BS; ++j) { \
            const float c = __int_as_float(__builtin_amdgcn_readlane(__float_as_int(cf[q][hf]), (jb) + j)); float x[16]; cvt16(rw[q][j], x); \
            _Pragma("unroll") for (int i = 0; i < 16; ++i) acc[q][i] += c * x[i]; } } while (0)
#define PA_SWEEP(rs, COMPQ, rs_next) do { \
            for (int jb = 0; jb < 60; jb += 4) { _Pragma("unroll") for (int q = 0; q < NTK; ++q) { COMPQ(q, 0, jb); __builtin_amdgcn_sched_barrier(0); PA_LOADQ(rs, q, 0, jb + 4); __builtin_amdgcn_sched_barrier(0); } } \
            _Pragma("unroll") for (int q = 0; q < NTK; ++q) { COMPQ(q, 0, 60); __builtin_amdgcn_sched_barrier(0); PA_LOADQ(rs, q, 1, 0); __builtin_amdgcn_sched_barrier(0); } \
            for (int jb = 0; jb < 60; jb += 4) { _Pragma("unroll") for (int q = 0; q < NTK; ++q) { COMPQ(q, 1, jb); __builtin_amdgcn_sched_barrier(0); PA_LOADQ(rs, q, 1, jb + 4); __builtin_amdgcn_sched_barrier(0); } } \
            _Pragma("unroll") for (int q = 0; q < NTK; ++q) { COMPQ(q, 1, 60); __builtin_amdgcn_sched_barrier(0); if (rs_next) { PA_LOADQ(rv, q, 0, 0); __builtin_amdgcn_sched_barrier(0); } } } while (0)
#pragma unroll
        for (int q = 0; q < NTK; ++q) PA_LOADQ(ru, q, 0, 0);
        __builtin_amdgcn_sched_barrier(0);
        PA_SWEEP(ru, PA_UCOMPQ, true);
        float cf[NTK][2];
#pragma unroll
        for (int q = 0; q < NTK; ++q)
#pragma unroll
            for (int hf = 0; hf < 2; ++hf) { const float a = dh[q][hf] * (1.f / 32.f); cf[q][hf] = gscale * gh[q][hf] * 0.5f * a * (1.f + erff(a * 0.70710678118f)); }
        float acc[NTK][16];
#pragma unroll
        for (int q = 0; q < NTK; ++q)
#pragma unroll
            for (int i = 0; i < 16; ++i) acc[q][i] = 0.f;
        PA_SWEEP(rv, PA_VCOMPQ, false);
#undef PA_LOADQ
#undef PA_UCOMPQ
#undef PA_VCOMPQ
#undef PA_SWEEP
#pragma unroll
        for (int q = 0; q < NTK; ++q) if (ok[q]) { const int m = m0 + q * nw;
            const float* gr = MODL + (size_t)tok_row(m) * D6 + 5 * D_ + 16 * lane; float* xr = XC + (size_t)m * D_ + 16 * lane;
            f4_t xo[4]; float ssq = 0.f;
#pragma unroll
            for (int j = 0; j < 4; ++j) { f4_t a; a.x = acc[q][4 * j]; a.y = acc[q][4 * j + 1]; a.z = acc[q][4 * j + 2]; a.w = acc[q][4 * j + 3]; xo[j] = *(const f4_t*)(xr + 4 * j) + *(const f4_t*)(gr + 4 * j) * a;
                ssq += xo[j].x * xo[j].x + xo[j].y * xo[j].y + xo[j].z * xo[j].z + xo[j].w * xo[j].w; }
            if (fin_out) { const float rsn = rsqrtf(wave_total(ssq) * (1.f / D_) + 1e-6f);
#pragma unroll
                for (int j = 0; j < 4; ++j) *(f4_t*)(fin_out + (size_t)m * D_ + 16 * lane + 4 * j) = xo[j] * rsn * *(const f4_t*)(fin_g + 16 * lane + 4 * j);
            } else {
#pragma unroll
                for (int j = 0; j < 4; ++j) *(f4_t*)(xr + 4 * j) = xo[j]; } }
    }
}
#define L3 __attribute__((address_space(3)))
template <int NTK>
__device__ __forceinline__ void ph_peer_apply4(unsigned char* lds, int ntok, const AT* F, const int* PIDX, const float* PGATE, const TT* TU, const float* USCL, const TT* TV, const float* MODL, float* XC, float gscale, const float* fin_g = nullptr, float* fin_out = nullptr) {
    const int tn_ = (int)tid_now(), lane = tn_ & 63, wv = tn_ >> 6, gw = blockIdx.x * 8 + wv, nw = gridDim.x * 8;
    L3 unsigned char* TQ = (L3 unsigned char*)lds + wv * (NTK * 1024);
    for (int m0 = gw; m0 < ntok; m0 += nw * NTK) {
        int eh[NTK][2]; float gh[NTK][2], tsc[NTK]; bool ok[NTK];
#pragma unroll
        for (int q = 0; q < NTK; ++q) { const int m = m0 + q * nw; ok[q] = m < ntok; const int mm = ok[q] ? m : m0;
            { const pg8::u32x4 ta = *(const pg8::u32x4*)(F + (size_t)mm * D_ + 16 * lane), tb = *(const pg8::u32x4*)(F + (size_t)mm * D_ + 16 * lane + 8); float x0[8], x1[8]; unpk8(ta, x0); unpk8(tb, x1);
              float mx = 0.f;
#pragma unroll
              for (int i = 0; i < 8; ++i) mx = fmaxf(mx, fmaxf(fabsf(x0[i]), fabsf(x1[i])));
              mx = wave_maxf(mx); const float inv = mx > 0.f ? 127.f / mx : 0.f; tsc[q] = mx * (1.f / 127.f); pg8::u32x4 w;
              w.x = q8pack(x0[0], x0[1], x0[2], x0[3], inv); w.y = q8pack(x0[4], x0[5], x0[6], x0[7], inv); w.z = q8pack(x1[0], x1[1], x1[2], x1[3], inv); w.w = q8pack(x1[4], x1[5], x1[6], x1[7], inv);
              *(L3 pg8::u32x4*)(TQ + q * 1024 + 16 * lane) = w; }
            unsigned k0 = ((unsigned)PIDX[(size_t)mm * 128 + lane] << 7) | (unsigned)lane, k1 = ((unsigned)PIDX[(size_t)mm * 128 + 64 + lane] << 7) | (unsigned)(64 + lane);
#pragma unroll
            for (int k = 2; k <= 128; k <<= 1)
#pragma unroll
                for (int j = k >> 1; j > 0; j >>= 1) {
                    if (j == 64) { const unsigned lo = k0 < k1 ? k0 : k1, hi = k0 < k1 ? k1 : k0; k0 = lo; k1 = hi; }
                    else { const unsigned p0 = (unsigned)__shfl_xor((int)k0, j), p1 = (unsigned)__shfl_xor((int)k1, j);
                        const bool low = (lane & j) == 0; const bool asc0 = (lane & k) == 0, asc1 = ((64 + lane) & k) == 0; const bool min0 = low == asc0, min1 = low == asc1;
                        k0 = min0 ? (k0 < p0 ? k0 : p0) : (k0 > p0 ? k0 : p0); k1 = min1 ? (k1 < p1 ? k1 : p1) : (k1 > p1 ? k1 : p1); } }
            eh[q][0] = (int)(k0 >> 7); eh[q][1] = (int)(k1 >> 7); gh[q][0] = PGATE[(size_t)mm * 128 + (k0 & 127u)]; gh[q][1] = PGATE[(size_t)mm * 128 + (k1 & 127u)]; }
        __syncthreads();
        const __amdgpu_buffer_rsrc_t ru = __builtin_amdgcn_make_buffer_rsrc((void*)TU, 0, 16384 * D_, 0x00020000), rv = __builtin_amdgcn_make_buffer_rsrc((void*)TV, 0, 16384 * D_, 0x00020000);
        const int voff = 16 * lane;
        constexpr int RU = 4, RV = NTK <= 3 ? 8 : 4;
        pg8::u32x4 rw[NTK][RV > RU ? RV : RU]; int idh[NTK][2];
        {
            pg8::u32x4 tq[NTK];
#pragma unroll
            for (int q = 0; q < NTK; ++q) { idh[q][0] = 0; idh[q][1] = 0; tq[q] = *(L3 const pg8::u32x4*)(TQ + q * 1024 + 16 * lane); }
#define P4_ULOAD1(q, j, hf, jb_) do { const int e = __builtin_amdgcn_readlane(eh[q][hf], (jb_) + (j)); rw[q][j] = __builtin_amdgcn_raw_buffer_load_b128(ru, voff, e << 10, 0); } while (0)
#define P4_USTEP(q, hf, jb, NEXT) do { int p[4]; \
            _Pragma("unroll") for (int j = 0; j < 4; ++j) { int s_ = __builtin_amdgcn_sdot4((int)rw[q][j].x, (int)tq[q].x, 0, false); s_ = __builtin_amdgcn_sdot4((int)rw[q][j].y, (int)tq[q].y, s_, false); \
                s_ = __builtin_amdgcn_sdot4((int)rw[q][j].z, (int)tq[q].z, s_, false); p[j] = __builtin_amdgcn_sdot4((int)rw[q][j].w, (int)tq[q].w, s_, false); __builtin_amdgcn_sched_barrier(0); NEXT(q, j); __builtin_amdgcn_sched_barrier(0); } \
            const bool b0 = (lane & 1) != 0, b1 = (lane & 2) != 0; \
            int ra = b0 ? p[1] : p[0], sa = b0 ? p[0] : p[1], rc = b0 ? p[3] : p[2], sc = b0 ? p[2] : p[3]; \
            ra += __builtin_amdgcn_update_dpp(0, sa, 0xB1, 0xF, 0xF, true); rc += __builtin_amdgcn_update_dpp(0, sc, 0xB1, 0xF, 0xF, true); \
            int rd = b1 ? rc : ra, sd = b1 ? ra : rc; \
            rd += __builtin_amdgcn_update_dpp(0, sd, 0x4E, 0xF, 0xF, true); \
            rd += __builtin_amdgcn_update_dpp(0, rd, 0x124, 0xF, 0xF, true); \
            rd += __builtin_amdgcn_update_dpp(0, rd, 0x128, 0xF, 0xF, true); \
            rd += __shfl_xor(rd, 16); rd += __shfl_xor(rd, 32); \
            idh[q][hf] = ((lane >> 2) == ((jb) >> 2)) ? rd : idh[q][hf]; } while (0)
#define P4_UN0(q, j) P4_ULOAD1(q, j, 0, jb + 4)
#define P4_UN01(q, j) P4_ULOAD1(q, j, 1, 0)
#define P4_UN1(q, j) P4_ULOAD1(q, j, 1, jb + 4)
#define P4_UNV(q, j) P4_VLOAD1(q, j, 0, 0)
#define P4_VLOAD1(q, j, hf, jb_) do { const int e = __builtin_amdgcn_readlane(eh[q][hf], (jb_) + (j)); rw[q][j] = __builtin_amdgcn_raw_buffer_load_b128(rv, voff, e << 10, 0); } while (0)
#pragma unroll
            for (int q = 0; q < NTK; ++q)
#pragma unroll
                for (int j = 0; j < 4; ++j) P4_ULOAD1(q, j, 0, 0);
            __builtin_amdgcn_sched_barrier(0);
            for (int jb = 0; jb < 60; jb += 4) {
#pragma unroll
                for (int q = 0; q < NTK; ++q) P4_USTEP(q, 0, jb, P4_UN0); }
#pragma unroll
            for (int q = 0; q < NTK; ++q) P4_USTEP(q, 0, 60, P4_UN01);
            for (int jb = 0; jb < 60; jb += 4) {
#pragma unroll
                for (int q = 0; q < NTK; ++q) P4_USTEP(q, 1, jb, P4_UN1); }
#pragma unroll
            for (int q = 0; q < NTK; ++q) P4_USTEP(q, 1, 60, P4_UNV);
#pragma unroll
            for (int q = 0; q < NTK; ++q)
#pragma unroll
                for (int j = 4; j < RV; ++j) P4_VLOAD1(q, j, 0, 0);
#undef P4_USTEP
#undef P4_UN0
#undef P4_UN01
#undef P4_UN1
#undef P4_UNV
#undef P4_ULOAD1
        }
        float cf[NTK][2];
#pragma unroll
        for (int q = 0; q < NTK; ++q)
#pragma unroll
            for (int hf = 0; hf < 2; ++hf) { const float a = (float)idh[q][hf] * (tsc[q] * USCL[eh[q][hf]]); cf[q][hf] = gscale * gh[q][hf] * 0.5f * a * (1.f + erff(a * 0.70710678118f)); }
        f2_t acc[NTK][8];
#pragma unroll
        for (int q = 0; q < NTK; ++q)
#pragma unroll
            for (int i = 0; i < 8; ++i) acc[q][i] = f2_t{0.f, 0.f};
#define P4_VSTEP(q, hf, jb, NEXT) do { _Pragma("unroll") for (int j = 0; j < RV; ++j) { \
            const float c = __int_as_float(__builtin_amdgcn_readlane(__float_as_int(cf[q][hf]), (jb) + j)); const unsigned ww_[4] = {rw[q][j].x, rw[q][j].y, rw[q][j].z, rw[q][j].w}; \
            _Pragma("unroll") for (int k = 0; k < 4; ++k) { acc[q][2 * k] += __builtin_amdgcn_cvt_pk_f32_fp8((int)ww_[k], false) * c; acc[q][2 * k + 1] += __builtin_amdgcn_cvt_pk_f32_fp8((int)ww_[k], true) * c; } \
            asm volatile("" : "+v"(acc[q][0]), "+v"(acc[q][1]), "+v"(acc[q][2]), "+v"(acc[q][3]), "+v"(acc[q][4]), "+v"(acc[q][5]), "+v"(acc[q][6]), "+v"(acc[q][7]));   \
            __builtin_amdgcn_sched_barrier(0); NEXT(q, j); __builtin_amdgcn_sched_barrier(0); } } while (0)
#define P4_VN0(q, j) P4_VLOAD1(q, j, 0, jb + RV)
#define P4_VN01(q, j) P4_VLOAD1(q, j, 1, 0)
#define P4_VN1(q, j) P4_VLOAD1(q, j, 1, jb + RV)
#define P4_VNONE(q, j) do { } while (0)
        for (int jb = 0; jb < 64 - RV; jb += RV) {
#pragma unroll
            for (int q = 0; q < NTK; ++q) P4_VSTEP(q, 0, jb, P4_VN0); }
#pragma unroll
        for (int q = 0; q < NTK; ++q) P4_VSTEP(q, 0, 64 - RV, P4_VN01);
        for (int jb = 0; jb < 64 - RV; jb += RV) {
#pragma unroll
            for (int q = 0; q < NTK; ++q) P4_VSTEP(q, 1, jb, P4_VN1); }
#pragma unroll
        for (int q = 0; q < NTK; ++q) P4_VSTEP(q, 1, 64 - RV, P4_VNONE);
#undef P4_VSTEP
#undef P4_VN0
#undef P4_VN01
#undef P4_VN1
#undef P4_VNONE
#undef P4_VLOAD1
#pragma unroll
        for (int q = 0; q < NTK; ++q) if (ok[q]) { const int m = m0 + q * nw;
            const float* gr = MODL + (size_t)tok_row(m) * D6 + 5 * D_ + 16 * lane; unsigned short* xr = (unsigned short*)XC + (size_t)m * D_ + 16 * lane;
            f4_t xo[4]; float ssq = 0.f; float xin[16];
            { const pg8::u32x4 xa = *(const pg8::u32x4*)xr, xb = *(const pg8::u32x4*)(xr + 8); float x0[8], x1[8]; unpk8(xa, x0); unpk8(xb, x1);
#pragma unroll
              for (int i = 0; i < 8; ++i) { xin[i] = x0[i]; xin[8 + i] = x1[i]; } }
#pragma unroll
            for (int j = 0; j < 4; ++j) { f4_t a; a.x = acc[q][2 * j].x; a.y = acc[q][2 * j].y; a.z = acc[q][2 * j + 1].x; a.w = acc[q][2 * j + 1].y; f4_t xi; xi.x = xin[4 * j]; xi.y = xin[4 * j + 1]; xi.z = xin[4 * j + 2]; xi.w = xin[4 * j + 3];
                xo[j] = xi + *(const f4_t*)(gr + 4 * j) * a;
                ssq += xo[j].x * xo[j].x + xo[j].y * xo[j].y + xo[j].z * xo[j].z + xo[j].w * xo[j].w; }
            if (fin_out) { const float rsn = rsqrtf(wave_total(ssq) * (1.f / D_) + 1e-6f);
#pragma unroll
                for (int j = 0; j < 4; ++j) *(f4_t*)(fin_out + (size_t)m * D_ + 16 * lane + 4 * j) = xo[j] * rsn * *(const f4_t*)(fin_g + 16 * lane + 4 * j);
            } else { pg8::u32x4 w0, w1;
                w0.x = pg8::cvt_pk_bf16(xo[0].x, xo[0].y); w0.y = pg8::cvt_pk_bf16(xo[0].z, xo[0].w); w0.z = pg8::cvt_pk_bf16(xo[1].x, xo[1].y); w0.w = pg8::cvt_pk_bf16(xo[1].z, xo[1].w);
                w1.x = pg8::cvt_pk_bf16(xo[2].x, xo[2].y); w1.y = pg8::cvt_pk_bf16(xo[2].z, xo[2].w); w1.z = pg8::cvt_pk_bf16(xo[3].x, xo[3].y); w1.w = pg8::cvt_pk_bf16(xo[3].z, xo[3].w);
                *(pg8::u32x4*)xr = w0; *(pg8::u32x4*)(xr + 8) = w1; } }
    }
}
#undef L3
typedef short bf16x8_t __attribute__((ext_vector_type(8)));
typedef short s16x4_t __attribute__((ext_vector_type(4)));
typedef float f32x16_t __attribute__((ext_vector_type(16)));
#define MFMA32(a, b, c) __builtin_amdgcn_mfma_f32_32x32x16_bf16((a), (b), (c), 0, 0, 0)
__device__ __forceinline__ unsigned pkbf(float a, float b) { f2_t v; v.x = a; v.y = b; return __builtin_bit_cast(unsigned, __builtin_convertvector(v, bf16x2_t)); }
constexpr int SW_KST = 72, SW_VST = 68;
__device__ __forceinline__ void ph_swa2(unsigned char* lds, const AT* PROJ, const float* sink, AT* MIX) {
    unsigned short* KS = (unsigned short*)lds;
    unsigned short* VT = KS + 2 * 64 * SW_KST;
    float* cosT = (float*)(VT + 2 * 64 * SW_VST);
    float* sinT = cosT + 96 * 16;
    const int tid = (int)tid_now(), w = tid >> 6, lane = tid & 63, r = lane & 31, h = lane >> 5;
    const int skey = tid >> 3, spart = tid & 7;
    __syncthreads();
    for (int i = tid; i < 96 * 16; i += NT) { const int p = i >> 4, f = i & 15; const float pos = p < 32 ? (float)p : (float)(p - 32);
        const float ang = pos * __expf(-(float)f * (9.210340371976184f / 16.f)); cosT[i] = __cosf(ang); sinT[i] = __sinf(ang); }
    __syncthreads();
    constexpr int NBLK = T_ / 64, NLU = B_ * 2 * NBLK, NCB = L_ / 64, NCU = B_ * 2 * NCB, CEND = 5 + NCB;
    f32x16_t zero;
#pragma unroll
    for (int i = 0; i < 16; ++i) zero[i] = 0.f;
    for (int u = blockIdx.x; u < NLU + NCU; u += gridDim.x) {
        const bool isl = u < NLU; int b, g, blk;
        if (isl) { blk = u % NBLK; g = (u / NBLK) & 1; b = u / (2 * NBLK); } else { const int v = u - NLU; blk = v % NCB; g = (v / NCB) & 1; b = v / (2 * NCB); }
        const int Q0 = blk * 64, qrow0 = isl ? b * T_ + Q0 : NLAT + b * L_ + Q0;
        const int hq = g * 4 + (w >> 1), ql = (w & 1) * 32 + r;
        bf16x8_t qf[4];
        { const AT* qp = PROJ + (size_t)(qrow0 + ql) * PROJW + C_SQ + hq * 64 + 8 * h; float x[4][8];
#pragma unroll
          for (int s2 = 0; s2 < 4; ++s2) unpk8(*(const pg8::u32x4*)(qp + 16 * s2), x[s2]);
          if (isl) { const int t = Q0 + ql;
#pragma unroll
              for (int ax = 0; ax < 2; ++ax) { const int p = ax == 0 ? (t >> 6) : 32 + (t & 63);
#pragma unroll
                  for (int j = 0; j < 8; ++j) { const float cs = cosT[p * 16 + 8 * h + j], sn = sinT[p * 16 + 8 * h + j]; const float a = x[2 * ax][j], bb = x[2 * ax + 1][j];
                      x[2 * ax][j] = a * cs - bb * sn; x[2 * ax + 1][j] = bb * cs + a * sn; } } }
#pragma unroll
          for (int s2 = 0; s2 < 4; ++s2) { pg8::u32x4 pk; pk.x = pkbf(x[s2][0] * 0.125f, x[s2][1] * 0.125f); pk.y = pkbf(x[s2][2] * 0.125f, x[s2][3] * 0.125f);
              pk.z = pkbf(x[s2][4] * 0.125f, x[s2][5] * 0.125f); pk.w = pkbf(x[s2][6] * 0.125f, x[s2][7] * 0.125f); qf[s2] = __builtin_bit_cast(bf16x8_t, pk); } }
        f32x16_t O0 = zero, O1 = zero; float mrun = sink[hq], lrun = (h == 0) ? 1.f : 0.f;
        pg8::u32x4 gA, gB;
#define SW_OK(ci) ((ci) >= 5 || (isl && Q0 - 128 + 64 * (ci) >= 0 && Q0 - 128 + 64 * (ci) + 64 <= T_))
#define SW_ROW0(ci) ((ci) < 5 ? b * T_ + Q0 - 128 + 64 * (ci) : NLAT + b * L_ + 64 * ((ci) - 5))
#define SW_LOAD(ci) do { const AT* pr_ = PROJ + (size_t)(SW_ROW0(ci) + skey) * PROJW; \
        if (spart < 4) { const int d0_ = (spart & 1) * 8 + (spart >> 1) * 32; gA = *(const pg8::u32x4*)(pr_ + C_SK + g * 64 + d0_); gB = *(const pg8::u32x4*)(pr_ + C_SK + g * 64 + d0_ + 16); } \
        else { gA = *(const pg8::u32x4*)(pr_ + C_SV + g * 64 + (spart - 4) * 16); gB = *(const pg8::u32x4*)(pr_ + C_SV + g * 64 + (spart - 4) * 16 + 8); } } while (0)
#define SW_STORE(ci, bi) do { \
        if (spart < 4) { const int d0_ = (spart & 1) * 8 + (spart >> 1) * 32; unsigned short* kd_ = KS + (bi) * 64 * SW_KST + skey * SW_KST + d0_; pg8::u32x4 oa_ = gA, ob_ = gB; \
            if ((ci) < 5) { float a_[8], b_[8]; unpk8(gA, a_); unpk8(gB, b_); const int t_ = Q0 - 128 + 64 * (ci) + skey; const int p_ = (spart >> 1) == 0 ? (t_ >> 6) : 32 + (t_ & 63); const int f0_ = (spart & 1) * 8; \
                float ra_[8], rb_[8]; _Pragma("unroll") for (int j_ = 0; j_ < 8; ++j_) { const float cs_ = cosT[p_ * 16 + f0_ + j_], sn_ = sinT[p_ * 16 + f0_ + j_]; ra_[j_] = a_[j_] * cs_ - b_[j_] * sn_; rb_[j_] = b_[j_] * cs_ + a_[j_] * sn_; } \
                oa_.x = pkbf(ra_[0], ra_[1]); oa_.y = pkbf(ra_[2], ra_[3]); oa_.z = pkbf(ra_[4], ra_[5]); oa_.w = pkbf(ra_[6], ra_[7]); ob_.x = pkbf(rb_[0], rb_[1]); ob_.y = pkbf(rb_[2], rb_[3]); ob_.z = pkbf(rb_[4], rb_[5]); ob_.w = pkbf(rb_[6], rb_[7]); } \
            *(pg8::u32x4*)kd_ = oa_; *(pg8::u32x4*)(kd_ + 16) = ob_; } \
        else { unsigned short* vd_ = VT + (bi) * 64 * SW_VST + ((spart - 4) * 16) * SW_VST + skey; const unsigned va_[4] = {gA.x, gA.y, gA.z, gA.w}, vb_[4] = {gB.x, gB.y, gB.z, gB.w}; \
            _Pragma("unroll") for (int j_ = 0; j_ < 4; ++j_) { vd_[(2 * j_) * SW_VST] = (unsigned short)(va_[j_] & 0xffffu); vd_[(2 * j_ + 1) * SW_VST] = (unsigned short)(va_[j_] >> 16); \
                vd_[(8 + 2 * j_) * SW_VST] = (unsigned short)(vb_[j_] & 0xffffu); vd_[(9 + 2 * j_) * SW_VST] = (unsigned short)(vb_[j_] >> 16); } } } while (0)
        int ci = isl ? 0 : 5; while (!SW_OK(ci)) ++ci;
        int bi = 0;
        __syncthreads();
        SW_LOAD(ci); SW_STORE(ci, 0); __syncthreads();
        while (ci < CEND) {
            int cn = ci + 1; while (cn < CEND && !SW_OK(cn)) ++cn;
            if (cn < CEND) SW_LOAD(cn);
            const unsigned short* KSb = KS + bi * 64 * SW_KST; const unsigned short* VTb = VT + bi * 64 * SW_VST;
            const int mt = ci == 0 ? 1 : (ci == 4 ? 2 : 0);
            f32x16_t S[2];
#pragma unroll
            for (int kb = 0; kb < 2; ++kb) { f32x16_t acc = zero;
#pragma unroll
                for (int s2 = 0; s2 < 4; ++s2) { const bf16x8_t kf = *(const bf16x8_t*)(KSb + (kb * 32 + r) * SW_KST + 16 * s2 + 8 * h); acc = MFMA32(kf, qf[s2], acc); }
                S[kb] = acc; }
            if (mt) {
#pragma unroll
                for (int kb = 0; kb < 2; ++kb)
#pragma unroll
                    for (int i = 0; i < 16; ++i) { const int kk = 32 * kb + (i & 3) + 8 * (i >> 2) + 4 * h; const bool ok = mt == 1 ? kk >= ql : kk <= ql; S[kb][i] = ok ? S[kb][i] : -INFINITY; } }
            float cm = -INFINITY;
#pragma unroll
            for (int kb = 0; kb < 2; ++kb)
#pragma unroll
                for (int i = 0; i < 16; ++i) cm = fmaxf(cm, S[kb][i]);
            cm = fmaxf(cm, __shfl_xor(cm, 32));
            const float mn = fmaxf(mrun, cm), alpha = __expf(mrun - mn); mrun = mn; lrun *= alpha; O0 *= alpha; O1 *= alpha;
            float ls = 0.f;
#pragma unroll
            for (int kb = 0; kb < 2; ++kb)
#pragma unroll
                for (int i = 0; i < 16; ++i) { const float pv = __expf(S[kb][i] - mn); S[kb][i] = pv; ls += pv; }
            lrun += ls;
#pragma unroll
            for (int kb = 0; kb < 2; ++kb)
#pragma unroll
                for (int s2 = 0; s2 < 2; ++s2) { pg8::u32x4 pk; pk.x = pkbf(S[kb][8 * s2], S[kb][8 * s2 + 1]); pk.y = pkbf(S[kb][8 * s2 + 2], S[kb][8 * s2 + 3]);
                    pk.z = pkbf(S[kb][8 * s2 + 4], S[kb][8 * s2 + 5]); pk.w = pkbf(S[kb][8 * s2 + 6], S[kb][8 * s2 + 7]); const bf16x8_t pf = __builtin_bit_cast(bf16x8_t, pk);
                    const unsigned short* vp = VTb + r * SW_VST + kb * 32 + 16 * s2 + 4 * h;
                    { const s16x4_t lo = *(const s16x4_t*)vp, hi = *(const s16x4_t*)(vp + 8); O0 = MFMA32(__builtin_shufflevector(lo, hi, 0, 1, 2, 3, 4, 5, 6, 7), pf, O0); }
                    { const s16x4_t lo = *(const s16x4_t*)(vp + 32 * SW_VST), hi = *(const s16x4_t*)(vp + 32 * SW_VST + 8); O1 = MFMA32(__builtin_shufflevector(lo, hi, 0, 1, 2, 3, 4, 5, 6, 7), pf, O1); } }
            if (cn < CEND) SW_STORE(cn, bi ^ 1);
            __syncthreads();
            ci = cn; bi ^= 1;
        }
        { const float lt = lrun + __shfl_xor(lrun, 32), inv = 1.f / lt;
          pg8::bf16_t* op = (pg8::bf16_t*)MIX + (size_t)(qrow0 + ql) * D_ + 512 + hq * 64 + 4 * h;
#pragma unroll
          for (int g4 = 0; g4 < 4; ++g4) { u2_t wv; wv.x = pkbf(O0[4 * g4] * inv, O0[4 * g4 + 1] * inv); wv.y = pkbf(O0[4 * g4 + 2] * inv, O0[4 * g4 + 3] * inv); *(u2_t*)(op + 8 * g4) = wv;
              wv.x = pkbf(O1[4 * g4] * inv, O1[4 * g4 + 1] * inv); wv.y = pkbf(O1[4 * g4 + 2] * inv, O1[4 * g4 + 3] * inv); *(u2_t*)(op + 32 + 8 * g4) = wv; } }
#undef SW_OK
#undef SW_ROW0
#undef SW_LOAD
#undef SW_STORE
    }
    __syncthreads();
}

constexpr int GC_QST = 72, GC_VST = 68;
__device__ __forceinline__ void ph_gla_chunk(unsigned char* lds, const AT* PROJ, const float* dec_w2, const float* dec_b, float* GLAO) {
    unsigned short* QI = (unsigned short*)lds;
    unsigned short* KI = QI + 2 * 64 * GC_QST;
    unsigned short* KOT = KI + 2 * 64 * GC_QST;
    unsigned short* VT = KOT + 2 * 64 * GC_QST;
    unsigned short* ST = VT + 2 * 32 * GC_VST;
    float* TOT = (float*)(ST + 2 * 32 * GC_QST);
    float* ETOT = TOT + 8 * 64;
    unsigned short* LRS = (unsigned short*)(ETOT + 2 * 64);
    const int tid = (int)tid_now(), w = tid >> 6, lane = tid & 63, r = lane & 31, h = lane >> 5;
    const int d = lane;
    constexpr int NCH = (L_ + T_) / 64;
    f32x16_t zero;
#pragma unroll
    for (int i = 0; i < 16; ++i) zero[i] = 0.f;
    for (int it = blockIdx.x; it < B_ * 32; it += gridDim.x) {
        const int vq = it & 3, z = (it >> 2) & 1, hh = (it >> 3) & 3, b = it >> 5;
        float w2c[16];
#pragma unroll
        for (int rr = 0; rr < 16; ++rr) w2c[rr] = dec_w2[(z * 16 + rr) * 256 + hh * 64 + d];
        const float dbc = dec_b[z * 256 + hh * 64 + d];
        f32x16_t Sst0 = zero, Sst1 = zero;
        __syncthreads();
        if (w == 2) {
#pragma unroll
            for (int i = 0; i < 18; ++i) ((unsigned*)(ST))[lane + 64 * i] = 0u; }
        float gq[8], gk[8], gla[8]; unsigned short gv[4]; pg8::u32x4 glr;
#define GC_LOADLR(c) do { if (tid < 128) { const int m_ = scan_token(b, z, (c) * 64 + (tid >> 1)); glr = *(const pg8::u32x4*)(PROJ + (size_t)m_ * PROJW + C_LR + z * 16 + (tid & 1) * 8); } } while (0)
#define GC_STORELR(bi) do { if (tid < 128) *(pg8::u32x4*)(LRS + (bi) * 1024 + (tid >> 1) * 16 + (tid & 1) * 8) = glr; } while (0)
#define GC_LOADQKV(c) do { _Pragma("unroll") for (int t_ = 0; t_ < 8; ++t_) { const int m_ = scan_token(b, z, (c) * 64 + w * 8 + t_); const AT* pr_ = PROJ + (size_t)m_ * PROJW; \
            gq[t_] = ldf(pr_ + C_GQ + hh * 64 + d) * 0.125f; gk[t_] = ldf(pr_ + C_GK + hh * 64 + d); } \
        _Pragma("unroll") for (int q_ = 0; q_ < 4; ++q_) { const int e_ = tid + 512 * q_, j_ = e_ >> 5, v_ = e_ & 31; const int m_ = scan_token(b, z, (c) * 64 + j_); \
            gv[q_] = ((const unsigned short*)(PROJ + (size_t)m_ * PROJW + C_GV + hh * 128 + vq * 32))[v_]; } } while (0)
#define GC_LA(bi) do { _Pragma("unroll") for (int t_ = 0; t_ < 8; ++t_) { const unsigned short* lp_ = LRS + (bi) * 1024 + (w * 8 + t_) * 16; const pg8::u32x4 l0_ = *(const pg8::u32x4*)lp_, l1_ = *(const pg8::u32x4*)(lp_ + 8); \
            float a8_[8], b8_[8]; unpk8(l0_, a8_); unpk8(l1_, b8_); float x_ = dbc; _Pragma("unroll") for (int q_ = 0; q_ < 8; ++q_) { x_ += a8_[q_] * w2c[q_]; x_ += b8_[q_] * w2c[8 + q_]; } \
            gla[t_] = (fminf(x_, 0.f) - __logf(1.f + __expf(-fabsf(x_)))) * 0.0625f; } } while (0)
#define GC_STORE1() do { float run_ = 0.f; _Pragma("unroll") for (int t_ = 0; t_ < 8; ++t_) { run_ += gla[t_]; gla[t_] = run_; } TOT[w * 64 + d] = run_; } while (0)
#define GC_STORE2(bi) do { float off_ = 0.f, tot_ = 0.f; _Pragma("unroll") for (int q_ = 0; q_ < 8; ++q_) { const float x_ = TOT[q_ * 64 + d]; tot_ += x_; off_ += q_ < w ? x_ : 0.f; } \
        if (w == 0) ETOT[(bi) * 64 + d] = __expf(tot_); \
        _Pragma("unroll") for (int t_ = 0; t_ < 8; ++t_) { const float bc_ = gla[t_] + off_; const int tt_ = w * 8 + t_; \
            QI[(bi) * 64 * GC_QST + tt_ * GC_QST + d] = f2bf_bits(gq[t_] * __expf(bc_)); KI[(bi) * 64 * GC_QST + tt_ * GC_QST + d] = f2bf_bits(gk[t_] * __expf(-bc_)); \
            KOT[(bi) * 64 * GC_QST + d * GC_QST + tt_] = f2bf_bits(gk[t_] * __expf(tot_ - bc_)); } \
        _Pragma("unroll") for (int q_ = 0; q_ < 4; ++q_) { const int e_ = tid + 512 * q_, j_ = e_ >> 5, v_ = e_ & 31; VT[(bi) * 32 * GC_VST + v_ * GC_VST + j_] = gv[q_]; } } while (0)
        GC_LOADLR(0); GC_LOADQKV(0); GC_STORELR(0); __syncthreads();
        GC_LA(0); GC_STORE1(); if (NCH > 1) GC_LOADLR(1); __syncthreads(); GC_STORE2(0); if (NCH > 1) GC_STORELR(1); __syncthreads();
        for (int c = 0; c < NCH; ++c) {
            const int bi = c & 1;
            if (c + 1 < NCH) GC_LOADQKV(c + 1);
            if (c + 2 < NCH) GC_LOADLR(c + 2);
            const unsigned short* QIb = QI + bi * 64 * GC_QST; const unsigned short* KIb = KI + bi * 64 * GC_QST; const unsigned short* KOTb = KOT + bi * 64 * GC_QST;
            const unsigned short* VTb = VT + bi * 32 * GC_VST; const unsigned short* STb = ST + bi * 32 * GC_QST;
            if (w < 2) {
                bf16x8_t qf[4];
#pragma unroll
                for (int s2 = 0; s2 < 4; ++s2) qf[s2] = *(const bf16x8_t*)(QIb + (w * 32 + r) * GC_QST + 16 * s2 + 8 * h);
                f32x16_t O = zero;
#pragma unroll
                for (int s2 = 0; s2 < 4; ++s2) { const bf16x8_t sf = *(const bf16x8_t*)(STb + r * GC_QST + 16 * s2 + 8 * h); O = MFMA32(sf, qf[s2], O); }
#pragma unroll
                for (int jb = 0; jb < 2; ++jb) if (jb <= w) {
                    f32x16_t A = zero;
#pragma unroll
                    for (int s2 = 0; s2 < 4; ++s2) { const bf16x8_t kf = *(const bf16x8_t*)(KIb + (jb * 32 + r) * GC_QST + 16 * s2 + 8 * h); A = MFMA32(kf, qf[s2], A); }
                    if (jb == w) {
#pragma unroll
                        for (int i = 0; i < 16; ++i) { const int jj = (i & 3) + 8 * (i >> 2) + 4 * h; const bool ok = z == 0 ? jj <= r : jj < r; A[i] = ok ? A[i] : 0.f; } }
#pragma unroll
                    for (int s2 = 0; s2 < 2; ++s2) { pg8::u32x4 pk; pk.x = pkbf(A[8 * s2], A[8 * s2 + 1]); pk.y = pkbf(A[8 * s2 + 2], A[8 * s2 + 3]); pk.z = pkbf(A[8 * s2 + 4], A[8 * s2 + 5]); pk.w = pkbf(A[8 * s2 + 6], A[8 * s2 + 7]);
                        const unsigned short* vp = VTb + r * GC_VST + jb * 32 + 16 * s2 + 4 * h; const s16x4_t lo = *(const s16x4_t*)vp, hi = *(const s16x4_t*)(vp + 8);
                        O = MFMA32(__builtin_shufflevector(lo, hi, 0, 1, 2, 3, 4, 5, 6, 7), __builtin_bit_cast(bf16x8_t, pk), O); } }
                const int m = scan_token(b, z, c * 64 + w * 32 + r);
                unsigned short* op = (unsigned short*)GLAO + ((size_t)z * NTOK + m) * 512 + hh * 128 + vq * 32 + 4 * h;
#pragma unroll
                for (int g4 = 0; g4 < 4; ++g4) { u2_t o4; o4.x = pkbf(O[4 * g4], O[4 * g4 + 1]); o4.y = pkbf(O[4 * g4 + 2], O[4 * g4 + 3]); *(u2_t*)(op + 8 * g4) = o4; }
            } else if (w == 2) {
                f32x16_t D0 = zero, D1 = zero;
#pragma unroll
                for (int s2 = 0; s2 < 4; ++s2) { const unsigned short* vq_ = VTb + r * GC_VST + 16 * s2 + 8 * h; const s16x4_t vlo = *(const s16x4_t*)vq_, vhi = *(const s16x4_t*)(vq_ + 4); const bf16x8_t vf = __builtin_shufflevector(vlo, vhi, 0, 1, 2, 3, 4, 5, 6, 7);
                    const bf16x8_t k0 = *(const bf16x8_t*)(KOTb + r * GC_QST + 16 * s2 + 8 * h), k1 = *(const bf16x8_t*)(KOTb + (32 + r) * GC_QST + 16 * s2 + 8 * h);
                    D0 = MFMA32(k0, vf, D0); D1 = MFMA32(k1, vf, D1); }
                unsigned short* sn = ST + (bi ^ 1) * 32 * GC_QST + r * GC_QST;
#pragma unroll
                for (int g4 = 0; g4 < 4; ++g4) { const int d0 = 8 * g4 + 4 * h; const f4_t e0 = *(const f4_t*)(ETOT + bi * 64 + d0), e1 = *(const f4_t*)(ETOT + bi * 64 + 32 + d0);
                    Sst0[4 * g4] = Sst0[4 * g4] * e0.x + D0[4 * g4]; Sst0[4 * g4 + 1] = Sst0[4 * g4 + 1] * e0.y + D0[4 * g4 + 1]; Sst0[4 * g4 + 2] = Sst0[4 * g4 + 2] * e0.z + D0[4 * g4 + 2]; Sst0[4 * g4 + 3] = Sst0[4 * g4 + 3] * e0.w + D0[4 * g4 + 3];
                    Sst1[4 * g4] = Sst1[4 * g4] * e1.x + D1[4 * g4]; Sst1[4 * g4 + 1] = Sst1[4 * g4 + 1] * e1.y + D1[4 * g4 + 1]; Sst1[4 * g4 + 2] = Sst1[4 * g4 + 2] * e1.z + D1[4 * g4 + 2]; Sst1[4 * g4 + 3] = Sst1[4 * g4 + 3] * e1.w + D1[4 * g4 + 3];
                    u2_t w0; w0.x = pkbf(Sst0[4 * g4], Sst0[4 * g4 + 1]); w0.y = pkbf(Sst0[4 * g4 + 2], Sst0[4 * g4 + 3]); *(u2_t*)(sn + d0) = w0;
                    u2_t w1; w1.x = pkbf(Sst1[4 * g4], Sst1[4 * g4 + 1]); w1.y = pkbf(Sst1[4 * g4 + 2], Sst1[4 * g4 + 3]); *(u2_t*)(sn + 32 + d0) = w1; }
            }
            if (c + 1 < NCH) { GC_LA(bi ^ 1); GC_STORE1(); }
            __syncthreads();
            if (c + 1 < NCH) GC_STORE2(bi ^ 1);
            if (c + 2 < NCH) GC_STORELR(bi);
            __syncthreads();
        }
#undef GC_LOADLR
#undef GC_STORELR
#undef GC_LOADQKV
#undef GC_LA
#undef GC_STORE1
#undef GC_STORE2
    }
    __syncthreads();
}

typedef float f32x4m_t __attribute__((ext_vector_type(4)));
__device__ __forceinline__ bf16x8_t cvt8bf(f4_t a, f4_t b) { pg8::u32x4 pk; pk.x = pkbf(a.x, a.y); pk.y = pkbf(a.z, a.w); pk.z = pkbf(b.x, b.y); pk.w = pkbf(b.z, b.w); return __builtin_bit_cast(bf16x8_t, pk); }
__device__ __forceinline__ void ph_rw_scan3(unsigned char* lds, const AT* R, const AT* K, const AT* V, const float* k_k, const AT* A, const AT* DEC, const float* w0, const float* a0, const float* k_a, AT* Y0, AT* Y1,
                                            const float* tsrc_u, const float* tsrc_v, TT* tdst, float* tusc) {
    constexpr int TS = 64, NST = L_ + T_, NCH = NST / TS, RING = 128;
    static_assert(NST % TS == 0 && (TS * 16) % 256 == 0 && RING >= 2 * TS, "scan chunking");
    float* VEC = (float*)lds;
    unsigned short* KKR = (unsigned short*)(VEC + 2 * 2 * TS * 64);
    unsigned short* VV = KKR + 2 * TS * 128;
    unsigned short* YB = VV + 2 * TS * 64;
    unsigned short* ZR = (unsigned short*)(lds + 131072);
    static_assert(2 * 2 * TS * 64 * 4 + 2 * TS * 128 * 2 + 2 * TS * 64 * 2 + RING * 64 * 2 <= 131072, "scan LDS images");
    const int tid = (int)tid_now(), w = tid >> 6, lane = tid & 63, Rl = lane & 15, g = lane >> 4, row = 16 * (w & 3) + Rl, msel = Rl & 3;
    const int tt = tid - 256;
    bf16x8_t zf;
#pragma unroll
    for (int i = 0; i < 8; ++i) zf[i] = 0;
    for (int sc = blockIdx.x; sc < B_ * 32; sc += gridDim.x) {
        const int z = sc & 1, h = (sc >> 1) & 15, b = sc >> 5;
        AT* Y = z == 0 ? Y0 : Y1;
        __syncthreads();
        if (tid < 32) ((unsigned*)ZR)[tid] = 0u;
        f4_t SaL = {0.f, 0.f, 0.f, 0.f}, SaH = SaL, SbL = SaL, SbH = SaL;
        bf16x8_t ra0 = zf, ra1 = zf;
#define RW3_STAGE(c, bi) do { _Pragma("unroll") for (int q_ = 0; q_ < TS * 16 / 256; ++q_) { const int i_ = tt + 256 * q_, ss_ = i_ >> 4, kq_ = i_ & 15; \
            const int m_ = scan_token(b, z, (c) * TS + ss_); const size_t o1_ = (size_t)m_ * D_ + h * 64 + kq_ * 4, o2_ = ((size_t)m_ * 2 + z) * D_ + h * 64 + kq_ * 4; \
            const u2_t gk_ = *(const u2_t*)(K + o1_), gv_ = *(const u2_t*)(V + o1_), ga_ = *(const u2_t*)(A + o2_), gd_ = *(const u2_t*)(DEC + o2_); u2_t gr_; \
            if (m_ < NLAT) gr_ = *(const u2_t*)(R + o1_); else { gr_.x = 0u; gr_.y = 0u; } \
            const f4_t ka4_ = *(const f4_t*)(k_a + h * 64 + kq_ * 4), w04_ = *(const f4_t*)(w0 + z * D_ + h * 64 + kq_ * 4), a04_ = *(const f4_t*)(a0 + z * D_ + h * 64 + kq_ * 4), kk4c_ = *(const f4_t*)(k_k + h * 64 + kq_ * 4); \
            const f4_t k_ = bf4(gk_), ar_ = bf4(ga_) + a04_, wr_ = bf4(gd_) + w04_; f4_t a_, w_, kk_ = k_ * kk4c_; \
            kk_ = kk_ * rsqrtf(fmaxf(allsum16(kk_.x * kk_.x + kk_.y * kk_.y + kk_.z * kk_.z + kk_.w * kk_.w), 1e-24f)); \
            a_.x = fsig(ar_.x); a_.y = fsig(ar_.y); a_.z = fsig(ar_.z); a_.w = fsig(ar_.w); \
            w_.x = __expf(-0.6065306597f * fsig(wr_.x)); w_.y = __expf(-0.6065306597f * fsig(wr_.y)); w_.z = __expf(-0.6065306597f * fsig(wr_.z)); w_.w = __expf(-0.6065306597f * fsig(wr_.w)); \
            float* vq_ = VEC + (bi) * 2 * TS * 64 + ss_ * 64 + kq_ * 4; *(f4_t*)vq_ = w_; \
            { const f4_t qk_ = kk_ * a_, dk_ = k_ * (1.f + (a_ - 1.f) * ka4_); unsigned* qd_ = (unsigned*)(VEC + (bi) * 2 * TS * 64 + TS * 64) + ss_ * 64 + (4 * (kq_ & 3)) * 4 + (kq_ >> 2); \
              qd_[0] = pkbf(qk_.x, dk_.x); qd_[4] = pkbf(qk_.y, dk_.y); qd_[8] = pkbf(qk_.z, dk_.z); qd_[12] = pkbf(qk_.w, dk_.w); }     \
            u2_t kb_; kb_.x = pkbf(kk_.x, kk_.y); kb_.y = pkbf(kk_.z, kk_.w); unsigned short* kr_ = KKR + (bi) * TS * 128 + ss_ * 128 + 32 * (kq_ >> 3) + 8 * (kq_ & 3) + 4 * ((kq_ >> 2) & 1); *(u2_t*)kr_ = kb_; *(u2_t*)(kr_ + 64) = gr_;     \
            *(u2_t*)(VV + (bi) * TS * 64 + ss_ * 64 + kq_ * 4) = gv_; } } while (0)
        if (w >= 4) RW3_STAGE(0, 0);
        __syncthreads();
        for (int c = 0; c < NCH; ++c) {
            const int bi = c & 1;
            if (w >= 4) { if (c + 1 < NCH) RW3_STAGE(c + 1, bi ^ 1);
                { constexpr size_t NG = (size_t)16384 * D_ / 16; const size_t per = (size_t)gridDim.x * NCH * 256; const size_t base = ((size_t)blockIdx.x * NCH + c) * 256 + tt;
                  for (size_t gi = base; gi < 2 * NG; gi += per) { if (gi < NG) cvt_row_i8(tsrc_u, tdst, tusc, gi >> 6, (int)(gi & 63)); else cvt_tab16(tsrc_v, tdst + (size_t)16384 * D_, gi - NG, 1.f); } } }
            else {
                __builtin_amdgcn_s_setprio(3);
                const float* vb = VEC + bi * 2 * TS * 64 + 4 * g; const unsigned short* vvb = VV + bi * TS * 64 + row;
                const unsigned* qp = g == 0 ? (const unsigned*)(VEC + bi * 2 * TS * 64 + TS * 64) + Rl * 4 : (const unsigned*)ZR; const int q_str = g == 0 ? 64 : 0;
                const unsigned short* pa = msel == 0 ? KKR + bi * TS * 128 + 8 * g : (msel == 1 ? KKR + bi * TS * 128 - 128 + 64 + 8 * g : ZR + 8 * g); const int sa_str = msel < 2 ? 128 : 0;
                bf16x8_t a0f = msel == 1 ? ra0 : *(const bf16x8_t*)(pa), a1f = msel == 1 ? ra1 : *(const bf16x8_t*)(pa + 32);
                f4_t wA = *(const f4_t*)(vb), wB = *(const f4_t*)(vb + 16), wC = *(const f4_t*)(vb + 32), wD = *(const f4_t*)(vb + 48);
                pg8::u32x4 qd = *(const pg8::u32x4*)qp;
                float vr = __uint_as_float((unsigned)vvb[0] << 16);
#pragma unroll 8
                for (int s = 0; s < TS; ++s) {
                    const int sn = s + 1 < TS ? s + 1 : s;
                    const bf16x8_t na0 = *(const bf16x8_t*)(pa + sn * sa_str), na1 = *(const bf16x8_t*)(pa + sn * sa_str + 32);
                    const f4_t nwA = *(const f4_t*)(vb + sn * 64), nwB = *(const f4_t*)(vb + sn * 64 + 16), nwC = *(const f4_t*)(vb + sn * 64 + 32), nwD = *(const f4_t*)(vb + sn * 64 + 48);
                    const pg8::u32x4 nqd = *(const pg8::u32x4*)(qp + sn * q_str);
                    const float nvr = __uint_as_float((unsigned)vvb[sn * 64] << 16);
                    const f32x4m_t Dz = {0.f, 0.f, 0.f, 0.f};
                    const f32x4m_t D1 = __builtin_amdgcn_mfma_f32_16x16x32_bf16(a0f, cvt8bf(SaL, SaH), Dz, 0, 0, 0);
                    const f32x4m_t D2 = __builtin_amdgcn_mfma_f32_16x16x32_bf16(a1f, cvt8bf(SbL, SbH), Dz, 0, 0, 0);
                    SaL = SaL * wA; SaH = SaH * wB; SbL = SbL * wC; SbH = SbH * wD;
                    const float sa = D1[0] + D2[0];
                    if (g == 0) YB[((c * TS + s - 1) & (RING - 1)) * 64 + row] = f2bf_bits(D1[1] + D2[1]);
                    { u2_t bq; bq.x = g == 0 ? pkbf(-sa, vr) : 0u; bq.y = 0u; const s16x4_t bsv = __builtin_bit_cast(s16x4_t, bq);
                      u2_t aq; aq.y = 0u;
                      aq.x = qd.x; SaL = __builtin_amdgcn_mfma_f32_16x16x16bf16_1k(__builtin_bit_cast(s16x4_t, aq), bsv, SaL, 0, 0, 0);
                      aq.x = qd.y; SaH = __builtin_amdgcn_mfma_f32_16x16x16bf16_1k(__builtin_bit_cast(s16x4_t, aq), bsv, SaH, 0, 0, 0);
                      aq.x = qd.z; SbL = __builtin_amdgcn_mfma_f32_16x16x16bf16_1k(__builtin_bit_cast(s16x4_t, aq), bsv, SbL, 0, 0, 0);
                      aq.x = qd.w; SbH = __builtin_amdgcn_mfma_f32_16x16x16bf16_1k(__builtin_bit_cast(s16x4_t, aq), bsv, SbH, 0, 0, 0); }
                    a0f = na0; a1f = na1; wA = nwA; wB = nwB; wC = nwC; wD = nwD; qd = nqd; vr = nvr;
                }
                __builtin_amdgcn_s_setprio(0);
                if (msel == 1) { ra0 = *(const bf16x8_t*)(KKR + bi * TS * 128 + (TS - 1) * 128 + 64 + 8 * g); ra1 = *(const bf16x8_t*)(KKR + bi * TS * 128 + (TS - 1) * 128 + 64 + 8 * g + 32); }
                if (c == NCH - 1) {
                    f32x4m_t Dm = {0.f, 0.f, 0.f, 0.f};
                    Dm = __builtin_amdgcn_mfma_f32_16x16x32_bf16(msel == 1 ? ra0 : zf, cvt8bf(SaL, SaH), Dm, 0, 0, 0);
                    Dm = __builtin_amdgcn_mfma_f32_16x16x32_bf16(msel == 1 ? ra1 : zf, cvt8bf(SbL, SbH), Dm, 0, 0, 0);
                    if (g == 0) YB[((NST - 1) & (RING - 1)) * 64 + row] = f2bf_bits(Dm[1]);
                }
            }
            __syncthreads();
            if (w >= 4) {
#pragma unroll
                for (int i = 0; i < TS * 64 / 256; ++i) { const int e = tt + 256 * i, sl = e >> 6, vx = e & 63; const int G = c * TS - 1 + sl;
                    if (G >= L_) { const int m = scan_token(b, z, G); ((unsigned short*)Y)[(size_t)m * D_ + h * 64 + vx] = YB[(G & (RING - 1)) * 64 + vx]; } } }
            if (c == NCH - 1 && tid < 64) { const int G = NST - 1; const int m = scan_token(b, z, G); ((unsigned short*)Y)[(size_t)m * D_ + h * 64 + tid] = YB[(G & (RING - 1)) * 64 + tid]; }
        }
#undef RW3_STAGE
    }
    __syncthreads();
}

__device__ __forceinline__ void ph_wc2(float* ldsf, const float* peer_wq, const float* peer_k1, const float* peer_k2, AT* WQ0) {
    unsigned short* KA = (unsigned short*)ldsf;
    unsigned short* WB = KA + 128 * 136;
    const int tid = (int)tid_now(), w = tid >> 6, lane = tid & 63, r = lane & 31, h = lane >> 5;
    f32x16_t zero;
#pragma unroll
    for (int i = 0; i < 16; ++i) zero[i] = 0.f;
    for (int tile = blockIdx.x; tile < 256; tile += gridDim.x) {
        const int layer = tile >> 7, g = (tile >> 3) & 15, kt = tile & 7;
        const float* key = ((g & 1) ? peer_k2 : peer_k1) + (size_t)layer * 8 * 128 * 128 + (size_t)(g >> 1) * 128 * 128;
        const float* wq = peer_wq + (size_t)layer * D_ * 2048 + (size_t)(kt * 128) * 2048 + g * 128;
        __syncthreads();
#pragma unroll
        for (int i = 0; i < 8; ++i) { const int e = tid * 4 + i * 2048, row = e >> 7, col = e & 127; const f4_t v = *(const f4_t*)(key + e), u = *(const f4_t*)(wq + (size_t)row * 2048 + col);
            u2_t a; a.x = pkbf(v.x, v.y); a.y = pkbf(v.z, v.w); *(u2_t*)(KA + row * 136 + col) = a; u2_t bq; bq.x = pkbf(u.x, u.y); bq.y = pkbf(u.z, u.w); *(u2_t*)(WB + row * 136 + col) = bq; }
        __syncthreads();
        const int nb = w & 3, kh = w >> 2;
        f32x16_t acc0 = zero, acc1 = zero;
#pragma unroll
        for (int s2 = 0; s2 < 8; ++s2) { const bf16x8_t af = *(const bf16x8_t*)(KA + (nb * 32 + r) * 136 + 16 * s2 + 8 * h);
            const bf16x8_t b0 = *(const bf16x8_t*)(WB + (kh * 64 + r) * 136 + 16 * s2 + 8 * h), b1 = *(const bf16x8_t*)(WB + (kh * 64 + 32 + r) * 136 + 16 * s2 + 8 * h);
            acc0 = MFMA32(af, b0, acc0); acc1 = MFMA32(af, b1, acc1); }
        pg8::bf16_t* out = (pg8::bf16_t*)WQ0 + (size_t)layer * 2048 * D_ + (size_t)(g * 128 + nb * 32) * D_ + kt * 128 + kh * 64 + r;
#pragma unroll
        for (int i = 0; i < 16; ++i) { const int n = (i & 3) + 8 * (i >> 2) + 4 * h; out[(size_t)n * D_] = f2bf_bits(acc0[i]); out[(size_t)n * D_ + 32] = f2bf_bits(acc1[i]); }
    }
    __syncthreads();
}
__device__ __forceinline__ float wave_allsum(float v) { return wave_total(v); }
__device__ __forceinline__ unsigned pk_bf16(float a, float b) { return pg8::cvt_pk_bf16(a, b); }
__device__ __forceinline__ void ph_wc2(float* ldsf, const float* peer_wq, const float* peer_k1, const float* peer_k2, AT* WQ0);
__device__ __forceinline__ void wprep_items(float* scr, int lane, int gw, int nw, const float* W, int K, int N, int Npad, AT* WT) {
    const int nblk = Npad / 32, nitems = (K / 64) * nblk;
    for (int it = gw; it < nitems; it += nw) { const int kb = it / nblk, nb = it % nblk, k0 = 64 * kb, n0 = 32 * nb; const int nn = n0 + (lane & 31);
        { const int c4 = lane & 7; pg8::f32x4 v[8];
#pragma unroll
          for (int i = 0; i < 8; ++i) { const int kk = 8 * i + (lane >> 3); v[i] = n0 < N ? *(const pg8::f32x4*)(W + (size_t)(k0 + kk) * N + n0 + 4 * c4) : pg8::f32x4{0.f, 0.f, 0.f, 0.f}; }
#pragma unroll
          for (int i = 0; i < 8; ++i) { const int kk = 8 * i + (lane >> 3); float* d = scr + kk * 33 + 4 * c4; d[0] = v[i][0]; d[1] = v[i][1]; d[2] = v[i][2]; d[3] = v[i][3]; } }
        asm volatile("s_waitcnt lgkmcnt(0)" ::: "memory");
        const int c = lane & 7;
#pragma unroll
        for (int j = 0; j < 4; ++j) { const int n = (lane >> 3) + 8 * j; const float* q = scr + (8 * c) * 33 + n; pg8::u32x4 o;
            o.x = pk_bf16(q[0], q[33]); o.y = pk_bf16(q[2 * 33], q[3 * 33]); o.z = pk_bf16(q[4 * 33], q[5 * 33]); o.w = pk_bf16(q[6 * 33], q[7 * 33]);
            *(pg8::u32x4*)((pg8::bf16_t*)WT + (size_t)(n0 + n) * K + k0 + 8 * c) = o; }
        asm volatile("s_waitcnt lgkmcnt(0)" ::: "memory"); }
}
__device__ __forceinline__ void ph_adaln2(float* ldsf, const float* c, const float* c_ctx, const float* ada_w, const float* ada_b, float* MOD) {
    static_assert(B_ + 1 <= 12, "adaln row padding");
    float* sv = ldsf;
    float* part = ldsf + D_ * 12;
    const int tid = (int)tid_now(), w = tid >> 6, lane = tid & 63;
    __syncthreads();
    for (int i = tid; i < D_ * 12; i += NT) { const int k = i / 12, rr = i % 12; float x = 0.f; if (rr < B_) x = c[rr * D_ + k]; else if (rr == B_) x = c_ctx[k]; sv[i] = rr <= B_ ? x * fsig(x) : 0.f; }
    __syncthreads();
    const int nitem = 2 * (D6 / 64);
    for (int it = blockIdx.x; it < nitem; it += gridDim.x) { const int layer = it / (D6 / 64), col = (it % (D6 / 64)) * 64 + lane;
        const float* wp = ada_w + (size_t)layer * D_ * D6 + (size_t)(w * 128) * D6 + col; const float* sp = sv + (w * 128) * 12;
        float acc[12];
#pragma unroll
        for (int rr = 0; rr < 12; ++rr) acc[rr] = 0.f;
#pragma unroll 32
        for (int k = 0; k < 128; ++k) { const float wv = wp[(size_t)k * D6]; const f4_t s0 = *(const f4_t*)(sp + k * 12), s1 = *(const f4_t*)(sp + k * 12 + 4), s2 = *(const f4_t*)(sp + k * 12 + 8);
            acc[0] += s0.x * wv; acc[1] += s0.y * wv; acc[2] += s0.z * wv; acc[3] += s0.w * wv; acc[4] += s1.x * wv; acc[5] += s1.y * wv; acc[6] += s1.z * wv; acc[7] += s1.w * wv;
            acc[8] += s2.x * wv; acc[9] += s2.y * wv; acc[10] += s2.z * wv; acc[11] += s2.w * wv; }
        __syncthreads();
#pragma unroll
        for (int rr = 0; rr < 12; ++rr) part[(w * 12 + rr) * 64 + lane] = acc[rr];
        __syncthreads();
        for (int o = tid; o < (B_ + 1) * 64; o += NT) { const int rr = o >> 6, cl = o & 63; float t = ada_b[layer * D6 + (it % (D6 / 64)) * 64 + cl];
#pragma unroll
            for (int q = 0; q < 8; ++q) t += part[(q * 12 + rr) * 64 + cl];
            MOD[((size_t)layer * (B_ + 1) + rr) * D6 + (it % (D6 / 64)) * 64 + cl] = t; }
    }
    __syncthreads();
}
__device__ __forceinline__ float row_rs(const float* xr, int lane, f4_t (&v)[4]) {
    float ss = 0.f;
#pragma unroll
    for (int j = 0; j < 4; ++j) { v[j] = *(const f4_t*)(xr + lane * 4 + 256 * j); ss += v[j].x * v[j].x + v[j].y * v[j].y + v[j].z * v[j].z + v[j].w * v[j].w; }
    return rsqrtf(wave_allsum(ss) * (1.f / D_) + 1e-6f);
}
__device__ __forceinline__ float row_rs16(const unsigned short* xr, int lane, f4_t (&v)[4]) {
    float ss = 0.f;
#pragma unroll
    for (int j = 0; j < 4; ++j) { const u2_t q = *(const u2_t*)(xr + lane * 4 + 256 * j); v[j] = bf4(q); ss += v[j].x * v[j].x + v[j].y * v[j].y + v[j].z * v[j].z + v[j].w * v[j].w; }
    return rsqrtf(wave_allsum(ss) * (1.f / D_) + 1e-6f);
}
__device__ __forceinline__ void mod_row(const f4_t (&v)[4], float rs, const float* g, const float* mr, int ishift, int iscale, int lane, f4_t (&y)[4]) {
#pragma unroll
    for (int j = 0; j < 4; ++j) { const int cI = lane * 4 + 256 * j; const f4_t gg = *(const f4_t*)(g + cI), sc = *(const f4_t*)(mr + iscale * D_ + cI), sh = *(const f4_t*)(mr + ishift * D_ + cI);
        y[j] = v[j] * rs * gg * (1.f + sc) + sh; }
}
__device__ __forceinline__ void st_row_bf16(AT* o, int lane, const f4_t (&y)[4]) {
#pragma unroll
    for (int j = 0; j < 4; ++j) { u2_t w; w.x = pk_bf16(y[j].x, y[j].y); w.y = pk_bf16(y[j].z, y[j].w); *(u2_t*)((pg8::bf16_t*)o + lane * 4 + 256 * j) = w; }
}
__device__ __forceinline__ void ph_modnorm2(int ntok, const float* XC, const float* g, const float* MODL, int ishift, int iscale, AT* out, float* fout, const float* xsrc = nullptr, const float* csrc = nullptr) {
    const int tn_ = (int)tid_now(), lane = tn_ & 63, gw = blockIdx.x * 8 + (tn_ >> 6), nw = gridDim.x * 8;
    for (int m = gw; m < ntok; m += nw) { f4_t v[4], y[4]; const float rs = xsrc ? row_rs(m < NLAT ? xsrc + (size_t)m * D_ : csrc + (size_t)(m - NLAT) * D_, lane, v) : row_rs16((const unsigned short*)XC + (size_t)m * D_, lane, v);
        if (fout) {
#pragma unroll
            for (int j = 0; j < 4; ++j) { const int cI = lane * 4 + 256 * j; *(f4_t*)(fout + (size_t)m * D_ + cI) = v[j] * rs * *(const f4_t*)(g + cI); }
        } else { mod_row(v, rs, g, MODL + (size_t)tok_row(m) * D6, ishift, iscale, lane, y); st_row_bf16(out + (size_t)m * D_, lane, y); } }
}
__device__ __forceinline__ void ph_norm_mix(const float* XC, const float* g, const float* MODL, const float* mu, AT* XS, AT* HX) {
    const int tn_ = (int)tid_now(), lane = tn_ & 63, gw = blockIdx.x * 8 + (tn_ >> 6), nw = gridDim.x * 8;
    for (int m = gw; m < NTOK; m += nw) { const TokInfo ti = tokinfo(m); const float* mr = MODL + (size_t)tok_row(m) * D6;
        f4_t v[4], h[4], hp[4], hn[4];
        { const float rs = row_rs16((const unsigned short*)XC + (size_t)m * D_, lane, v); mod_row(v, rs, g, mr, 0, 1, lane, h); }
        if (ti.pos > 0) { const float rs = row_rs16((const unsigned short*)XC + (size_t)(m - 1) * D_, lane, v); mod_row(v, rs, g, mr, 0, 1, lane, hp); }
        else {
#pragma unroll
            for (int j = 0; j < 4; ++j) hp[j] = (f4_t){0.f, 0.f, 0.f, 0.f}; }
        if (ti.pos < ti.len - 1) { const float rs = row_rs16((const unsigned short*)XC + (size_t)(m + 1) * D_, lane, v); mod_row(v, rs, g, mr, 0, 1, lane, hn); }
        else {
#pragma unroll
            for (int j = 0; j < 4; ++j) hn[j] = (f4_t){0.f, 0.f, 0.f, 0.f}; }
        f4_t xx[4], y[4];
#pragma unroll
        for (int j = 0; j < 4; ++j) xx[j] = 0.5f * (hp[j] + hn[j]) - h[j];
        st_row_bf16(HX + (size_t)m * 2048, lane, h); st_row_bf16(HX + (size_t)m * 2048 + 1024, lane, xx);
#pragma unroll
        for (int q = 0; q < 3; ++q) { const float* muq = mu + (q == 0 ? 0 : (q == 1 ? 2 : 3)) * D_;
#pragma unroll
            for (int j = 0; j < 4; ++j) y[j] = h[j] + xx[j] * *(const f4_t*)(muq + lane * 4 + 256 * j);
            st_row_bf16(XS + (size_t)q * (ROWB / SA) + (size_t)m * D_, lane, y); }
    }
}
__device__ __forceinline__ void ph_gla_out2(const AT* PROJ, const float* GLAO, const float* gn, AT* MIX) {
    const int tn_ = (int)tid_now(), lane = tn_ & 63, gw = blockIdx.x * 8 + (tn_ >> 6), nw = gridDim.x * 8;
    for (int m = gw; m < NTOK; m += nw) {
        const unsigned short* o0 = (const unsigned short*)GLAO + (size_t)m * 512 + lane * 8; const unsigned short* o1 = (const unsigned short*)GLAO + ((size_t)NTOK + m) * 512 + lane * 8;
        float x0_[8], x1_[8]; unpk8(*(const pg8::u32x4*)o0, x0_); unpk8(*(const pg8::u32x4*)o1, x1_);
        f4_t a0, a1; a0.x = x0_[0] + x1_[0]; a0.y = x0_[1] + x1_[1]; a0.z = x0_[2] + x1_[2]; a0.w = x0_[3] + x1_[3]; a1.x = x0_[4] + x1_[4]; a1.y = x0_[5] + x1_[5]; a1.z = x0_[6] + x1_[6]; a1.w = x0_[7] + x1_[7];
        float ss = a0.x * a0.x + a0.y * a0.y + a0.z * a0.z + a0.w * a0.w + a1.x * a1.x + a1.y * a1.y + a1.z * a1.z + a1.w * a1.w;
        const float rs = rsqrtf(allsum16(ss) * (1.f / 128.f) + 1e-6f);
        const pg8::u32x4 gt = *(const pg8::u32x4*)(PROJ + (size_t)m * PROJW + C_GG + lane * 8);
        u2_t q; q.x = gt.x; q.y = gt.y; const f4_t g0 = bf4(q); q.x = gt.z; q.y = gt.w; const f4_t g1 = bf4(q);
        const f4_t n0 = *(const f4_t*)(gn + lane * 8), n1 = *(const f4_t*)(gn + lane * 8 + 4);
        f4_t s0, s1; s0.x = g0.x * fsig(g0.x); s0.y = g0.y * fsig(g0.y); s0.z = g0.z * fsig(g0.z); s0.w = g0.w * fsig(g0.w);
        s1.x = g1.x * fsig(g1.x); s1.y = g1.y * fsig(g1.y); s1.z = g1.z * fsig(g1.z); s1.w = g1.w * fsig(g1.w);
        const f4_t r0 = a0 * rs * n0 * s0, r1 = a1 * rs * n1 * s1; pg8::u32x4 w;
        w.x = pk_bf16(r0.x, r0.y); w.y = pk_bf16(r0.z, r0.w); w.z = pk_bf16(r1.x, r1.y); w.w = pk_bf16(r1.z, r1.w);
        *(pg8::u32x4*)((pg8::bf16_t*)MIX + (size_t)m * D_ + lane * 8) = w; }
}
__device__ __forceinline__ void ld16(const AT* p, f4_t (&o)[4]) { const pg8::u32x4 a = *(const pg8::u32x4*)p, b = *(const pg8::u32x4*)(p + 8); u2_t q;
    q.x = a.x; q.y = a.y; o[0] = bf4(q); q.x = a.z; q.y = a.w; o[1] = bf4(q); q.x = b.x; q.y = b.y; o[2] = bf4(q); q.x = b.z; q.y = b.w; o[3] = bf4(q); }
__device__ __forceinline__ float hsum4(f4_t a) { return a.x + a.y + a.z + a.w; }
__device__ __forceinline__ float quadsum(float v) { DPP_ADD(v, 0xB1); DPP_ADD(v, 0x4E); return v; }
__device__ __forceinline__ void ph_rw_out2(const AT* Y0, const AT* Y1, const AT* R, const AT* K, const AT* V, const AT* A, const float* a0, const AT* G, const float* k_a, const float* r_k,
                                           const float* ln_g, const float* ln_b, AT* OUT) {
    const int tn_ = (int)tid_now(), lane = tn_ & 63, gw = blockIdx.x * 8 + (tn_ >> 6), nw = gridDim.x * 8;
    for (int m = gw; m < NLAT; m += nw) { int ln_ = lane; asm volatile("" : "+v"(ln_)); const size_t o1 = (size_t)m * D_ + ln_ * 16; const int cI = ln_ * 16;
        f4_t y[4], t[4], r[4], k[4];
        ld16(Y0 + o1, y); ld16(Y1 + o1, t);
        float s = 0.f;
#pragma unroll
        for (int j = 0; j < 4; ++j) { y[j] += t[j]; s += hsum4(y[j]); }
        const float mean = quadsum(s) * (1.f / 64.f); float q = 0.f;
#pragma unroll
        for (int j = 0; j < 4; ++j) { y[j] -= mean; q += hsum4(y[j] * y[j]); }
        const float rs = rsqrtf(quadsum(q) * (1.f / 64.f) + 64e-5f);
        ld16(R + o1, r); ld16(K + o1, k);
        float bs = 0.f;
#pragma unroll
        for (int z = 0; z < 2; ++z) { ld16(A + ((size_t)m * 2 + z) * D_ + cI, t);
#pragma unroll
            for (int j = 0; j < 4; ++j) { f4_t ar = t[j] + *(const f4_t*)(a0 + z * D_ + cI + 4 * j); f4_t a; a.x = fsig(ar.x); a.y = fsig(ar.y); a.z = fsig(ar.z); a.w = fsig(ar.w);
                bs += hsum4(r[j] * k[j] * (1.f + (a - 1.f) * *(const f4_t*)(k_a + cI + 4 * j)) * *(const f4_t*)(r_k + cI + 4 * j)); } }
        const float bonus = quadsum(bs);
        ld16(V + o1, r); ld16(G + o1, k);
        pg8::u32x4 w0, w1; f4_t o[4];
#pragma unroll
        for (int j = 0; j < 4; ++j) o[j] = (y[j] * rs * *(const f4_t*)(ln_g + cI + 4 * j) + *(const f4_t*)(ln_b + cI + 4 * j) + bonus * r[j]) * k[j];
        w0.x = pk_bf16(o[0].x, o[0].y); w0.y = pk_bf16(o[0].z, o[0].w); w0.z = pk_bf16(o[1].x, o[1].y); w0.w = pk_bf16(o[1].z, o[1].w);
        w1.x = pk_bf16(o[2].x, o[2].y); w1.y = pk_bf16(o[2].z, o[2].w); w1.z = pk_bf16(o[3].x, o[3].y); w1.w = pk_bf16(o[3].z, o[3].w);
        *(pg8::u32x4*)((pg8::bf16_t*)OUT + o1) = w0; *(pg8::u32x4*)((pg8::bf16_t*)OUT + o1 + 8) = w1; }
}
#endif
__device__ __forceinline__ void ph_rw_out(const AT* Y0, const AT* Y1, const AT* R, const AT* K, const AT* V, const AT* A, const float* a0, const AT* G, const float* k_a, const float* r_k,
                                          const float* ln_g, const float* ln_b, AT* OUT) {
    GSTRIDE(i_, NLAT * 16) { int idx = (int)i_;
        int h = idx % 16, m = idx / 16; size_t o1 = (size_t)m * D_ + h * 64;
        float mean = 0.f; for (int n = 0; n < 64; ++n) mean += ldf(Y0 + o1 + n) + ldf(Y1 + o1 + n); mean *= (1.f / 64.f);
        float var = 0.f; for (int n = 0; n < 64; ++n) { float d = ldf(Y0 + o1 + n) + ldf(Y1 + o1 + n) - mean; var += d * d; } var *= (1.f / 64.f);
        float rs = rsqrtf(var + 64e-5f);
        float bonus = 0.f;
        for (int z = 0; z < 2; ++z) for (int n = 0; n < 64; ++n) { float a = sigmoidf_(ldf(A + ((size_t)m * 2 + z) * D_ + h * 64 + n) + a0[z * D_ + h * 64 + n]); float k = ldf(K + o1 + n);
            bonus += ldf(R + o1 + n) * k * (1.f + (a - 1.f) * k_a[h * 64 + n]) * r_k[h * 64 + n]; }
        for (int n = 0; n < 64; ++n) { float y = ldf(Y0 + o1 + n) + ldf(Y1 + o1 + n);
            float o = ((y - mean) * rs * ln_g[h * 64 + n] + ln_b[h * 64 + n] + bonus * ldf(V + o1 + n)) * ldf(G + o1 + n);
            stf(OUT + o1 + n, o); } }
}

struct Params { const float* in[36]; float* out; char* ws; int ph_lo, ph_hi; };
#ifdef CPU_EMU
#define KP (&p)
#else
typedef const Params __attribute__((address_space(4))) CParams;
__device__ __forceinline__ CParams* kp_now() { CParams* q = (CParams*)__builtin_amdgcn_kernarg_segment_ptr(); asm volatile("" : "+s"(q)); return q; }
#define KP (kp_now())
#endif
constexpr int N_PHASES = 23;
constexpr int LDS_BYTES = 131072 + 1024;
constexpr size_t OFF_CTL = WS_END;
constexpr size_t CTL_BYTES = 16384;
constexpr size_t OFF_USC = OFF_CTL + CTL_BYTES;
constexpr size_t WS_TOTAL = OFF_USC + (size_t)2 * 16384 * 4;

#ifndef CPU_EMU
#define LAS __attribute__((address_space(3)))
#define XB_TMO      128
#define XB_XCNT(j)  (256  + 64 * (j))
#define XB_XSUB(j)  (1280 + 64 * (j))
#define XB_XGEN(j)  (2304 + 64 * (j))
#define XB_TOP      3328
#define XB_TOPGEN   3392
#define XCD_BAR_WORDS 3456
#define XB_SPIN_CAP (1u << 26)
__device__ __forceinline__ unsigned xb_ld(unsigned* p)              { return __hip_atomic_load(p, __ATOMIC_RELAXED, __HIP_MEMORY_SCOPE_AGENT); }
__device__ __forceinline__ unsigned xb_add(unsigned* p, unsigned v) { return __hip_atomic_fetch_add(p, v, __ATOMIC_RELAXED, __HIP_MEMORY_SCOPE_AGENT); }
__device__ __forceinline__ unsigned xb_xcc_id() { return (unsigned)__builtin_amdgcn_s_getreg((3 << 11) | 20) & 0xFu; }
#define XB_SPIN(cond, bar) do { unsigned _sp = 0; while (cond) { __builtin_amdgcn_s_sleep(1); \
    if ((++_sp & 255u) == 0u) { if (xb_ld(&(bar)[XB_TMO])) break; if (_sp > XB_SPIN_CAP) { atomicAdd(&(bar)[XB_TMO], 1u); break; } } } } while (0)
struct XcdBarrier { unsigned* bar; unsigned x; volatile LAS unsigned* st; };
__device__ __forceinline__ XcdBarrier xcd_barrier_post(unsigned* bar, volatile LAS unsigned* st) {
    XcdBarrier b; b.bar = bar; b.x = xb_xcc_id(); b.st = st;
    if (tid_now() == 0u) (void)xb_add(&bar[XB_XCNT(b.x)], 1u);
    return b;
}
__device__ __forceinline__ void xcd_barrier_complete(unsigned* bar, unsigned x, unsigned& nloc, unsigned& nx) {
    const unsigned G = gridDim.x * gridDim.y * gridDim.z;
    unsigned sum, cnt, mine, sp = 0u;
    for (;;) {
        sum = 0u; cnt = 0u; mine = 0u;
#pragma unroll
        for (unsigned j = 0; j < 16; ++j) { const unsigned c = xb_ld(&bar[XB_XCNT(j)]); sum += c; cnt += (c > 0u) ? 1u : 0u; mine = (j == x) ? c : mine; }
        if (sum == G) break;
        __builtin_amdgcn_s_sleep(1);
        if ((++sp & 255u) == 0u) { if (xb_ld(&bar[XB_TMO])) break; if (sp > XB_SPIN_CAP) { atomicAdd(&bar[XB_TMO], 1u); break; } }
    }
    nloc = mine > 0u ? mine : 1u; nx = cnt > 0u ? cnt : 1u;
}
__device__ __forceinline__ void xcd_barrier(const XcdBarrier& b) {
    asm volatile("s_waitcnt vmcnt(0)" ::: "memory");
    __syncthreads();
    if (tid_now() == 0u) {
        unsigned* bar = b.bar;
        __builtin_amdgcn_s_waitcnt(0);
        unsigned nloc = b.st[0], nx = b.st[1];
        if (nloc == 0u) { xcd_barrier_complete(bar, b.x, nloc, nx); b.st[0] = nloc; b.st[1] = nx; }
        const unsigned old = xb_add(&bar[XB_XSUB(b.x)], 1u);
        const unsigned gen = old / nloc;
        if (old + 1u == (gen + 1u) * nloc) {
            __builtin_amdgcn_fence(__ATOMIC_RELEASE, "agent");
            asm volatile("s_waitcnt vmcnt(0)" ::: "memory");
            const unsigned og = xb_add(&bar[XB_TOP], 1u);
            const unsigned tg = og / nx;
            if (og + 1u == (tg + 1u) * nx) xb_add(&bar[XB_TOPGEN], 1u);
            else XB_SPIN(xb_ld(&bar[XB_TOPGEN]) == tg, bar);
            __builtin_amdgcn_fence(__ATOMIC_ACQUIRE, "agent");
            xb_add(&bar[XB_XGEN(b.x)], 1u);
            asm volatile("s_waitcnt vmcnt(0)" ::: "memory");
        } else {
            XB_SPIN(xb_ld(&bar[XB_XGEN(b.x)]) == gen, bar);
            __builtin_amdgcn_fence(__ATOMIC_ACQUIRE, "agent");
            asm volatile("s_waitcnt vmcnt(0)" ::: "memory");
        }
    }
    __syncthreads();
}
#endif

#define x_in (KP->in[0])
#define c_in (KP->in[1])
#define ctx (KP->in[2])
#define c_ctx (KP->in[3])
#define ada_w (KP->in[4])
#define ada_b (KP->in[5])
#define norm1_g (KP->in[6])
#define norm2_g (KP->in[7])
#define w_in (KP->in[8])
#define dec_w2 (KP->in[9])
#define dec_b (KP->in[10])
#define gla_g (KP->in[11])
#define sink (KP->in[12])
#define w_out (KP->in[13])
#define rw_mu (KP->in[14])
#define w_rkv (KP->in[15])
#define w_o (KP->in[16])
#define rw_w0 (KP->in[17])
#define rw_w1 (KP->in[18])
#define rw_w2 (KP->in[19])
#define rw_a0 (KP->in[20])
#define rw_a1 (KP->in[21])
#define rw_a2 (KP->in[22])
#define rw_g1 (KP->in[23])
#define rw_g2 (KP->in[24])
#define k_k (KP->in[25])
#define k_a (KP->in[26])
#define r_k (KP->in[27])
#define ln_g (KP->in[28])
#define ln_b (KP->in[29])
#define peer_wq (KP->in[30])
#define peer_k1 (KP->in[31])
#define peer_k2 (KP->in[32])
#define peer_u (KP->in[33])
#define peer_v (KP->in[34])
#define final_g (KP->in[35])
#define MOD ((float*)(KP->ws + OFF_MOD))
#define XC ((float*)(KP->ws + OFF_XC))
#define U ((AT*)(KP->ws + OFF_U))
#define MIX ((AT*)(KP->ws + OFF_MIX))
#define WIN ((AT*)(KP->ws + OFF_WIN))
#define WOUT ((AT*)(KP->ws + OFF_WOUT))
#define WQ0 ((AT*)(KP->ws + OFF_WQ0))
#define WQ1 ((AT*)(KP->ws + OFF_WQ1))
#define WRKV ((AT*)(KP->ws + OFF_WRKV))
#define WO ((AT*)(KP->ws + OFF_WO))
#define H ((AT*)(KP->ws + OFF_H))
#define XS ((AT*)(KP->ws + OFF_XS))
#define Y0 ((AT*)(KP->ws + OFF_Y0))
#define Y1 ((AT*)(KP->ws + OFF_Y1))
#define PROJ ((AT*)(KP->ws + OFF_PROJ))
#define LOGA ((float*)(KP->ws + OFF_LOGA))
#define GLAO ((float*)(KP->ws + OFF_GLAO))
#define SC ((float*)(KP->ws + OFF_SC))
#define TAB0 ((TT*)(KP->ws + OFF_TAB0))
#define TAB1 ((TT*)(KP->ws + OFF_TAB1))
#define USC ((float*)(KP->ws + OFF_USC))
#define PIDX ((int*)(KP->ws + OFF_PIDX))
#define PGATE ((float*)(KP->ws + OFF_PGATE))
#define R ((AT*)(KP->ws + OFF_R))
#define K ((AT*)(KP->ws + OFF_K))
#define V ((AT*)(KP->ws + OFF_V))
#define KK ((AT*)(KP->ws + OFF_KK))
#define U1 ((AT*)(KP->ws + OFF_U1))
#define SC1 ((float*)(KP->ws + OFF_SC1))
#define G ((AT*)(KP->ws + OFF_G))
#define A ((AT*)(KP->ws + OFF_A))
#define DEC ((AT*)(KP->ws + OFF_DEC))
#define RWOUT ((AT*)(KP->ws + OFF_DEC))
#define T1 ((AT*)(KP->ws + OFF_T1))
#define T2 ((AT*)(KP->ws + OFF_T2))
#define HX ((AT*)(KP->ws + OFF_HX))
#define WL1 ((AT*)(KP->ws + OFF_WL1))
#define WL2A ((AT*)(KP->ws + OFF_WL2A))
#define WL2B ((AT*)(KP->ws + OFF_WL2B))
#define MOD0 ((const float*)MOD)
#define MOD1 ((const float*)(MOD + (size_t)(B_ + 1) * D6))
__global__ void __launch_bounds__(NT, 2) mega(Params p) {
#ifdef CPU_EMU
    static unsigned char lds_raw[LDS_BYTES]; unsigned char* lds = lds_raw;
#else
    extern __shared__ __attribute__((aligned(16))) unsigned char lds[];
#endif
    float* ldsf = (float*)lds;
    const size_t PE = (size_t)16384 * D_;
    const int lo = p.ph_lo, hi = p.ph_hi;
#ifndef CPU_EMU
    volatile LAS unsigned* st = (volatile LAS unsigned*)(lds + LDS_BYTES - 16);
    if (threadIdx.x < 4) st[threadIdx.x] = 0u;
    if ((threadIdx.x & 63u) == 0u) *(volatile LAS unsigned*)(lds + TID_TAB_OFF + 4 * hw_slot()) = threadIdx.x >> 6;
    __syncthreads();
    XcdBarrier bar = xcd_barrier_post((unsigned*)(KP->ws + OFF_CTL), st);
#define SEAM(k) do { if (hi - lo > 1) xcd_barrier(bar); } while (0)
#else
#define SEAM(k) do { } while (0)
#endif
#define IN(k) (lo <= (k) && (k) < hi)
#ifdef CPU_EMU
    if (IN(0)) { ph_adaln(c_in, c_ctx, ada_w, ada_b, MOD);
        ph_wprep(w_in, D_, 2336, PROJW, WIN); ph_wprep(w_out, D_, D_, D_, WOUT); ph_wc(peer_wq, peer_k1, peer_k2, WQ0); ph_wc(peer_wq + (size_t)D_ * 2048, peer_k1 + (size_t)8 * 128 * 128, peer_k2 + (size_t)8 * 128 * 128, WQ1);
        ph_cvt_tab(peer_u, TAB0, PE, 32.f); ph_cvt_tab(peer_v, TAB0 + PE, PE, 1.f);
        for (int j = 0; j < 3; ++j) ph_wprep(w_rkv + (size_t)j * D_ * D_, D_, D_, D_, WRKV + (size_t)j * D_ * D_);
        ph_wprep(w_o, D_, D_, D_, WO); ph_wlora(rw_mu, rw_w1, rw_a1, rw_g1, rw_w2, rw_a2, rw_g2, WL1, WL2A, WL2B); SEAM(0); }
#else
    if (IN(0)) {
        ph_wc2(ldsf, peer_wq, peer_k1, peer_k2, WQ0);
        ph_adaln2(ldsf, c_in, c_ctx, ada_w, ada_b, MOD);
        { const int tn_ = (int)tid_now(), lane = tn_ & 63, wv = tn_ >> 6, gw = blockIdx.x * 8 + wv, nw = gridDim.x * 8; float* scr = ldsf + wv * (64 * 33);
          wprep_items(scr, lane, gw, nw, w_in, D_, 2336, PROJW, WIN); wprep_items(scr, lane, gw, nw, w_out, D_, D_, D_, WOUT);
          if ((int)gridDim.x * 3 <= (NTOK / 256) * (PROJW / 256) || (int)gridDim.x * 2 >= (NTOK / 256) * (PROJW / 256)) {
              for (int j = 0; j < 3; ++j) wprep_items(scr, lane, gw, nw, w_rkv + (size_t)j * D_ * D_, D_, D_, D_, WRKV + (size_t)j * D_ * D_);
              wprep_items(scr, lane, gw, nw, w_o, D_, D_, D_, WO); } }
        ph_wlora(rw_mu, rw_w1, rw_a1, rw_g1, rw_w2, rw_a2, rw_g2, WL1, WL2A, WL2B, 0, (int)gridDim.x);
        SEAM(0); }
#endif
#ifdef CPU_EMU
    if (IN(1)) { ph_modnorm(ldsf, NTOK, XC, norm1_g, MOD0, 0, 1, U, nullptr, x_in, ctx); SEAM(1); }
#else
    if (IN(1)) { ph_modnorm2(NTOK, XC, norm1_g, MOD0, 0, 1, U, nullptr, x_in, ctx); SEAM(1); }
#endif
    if (IN(2)) { run_gemm(lds, U, WIN, NTOK, PROJW, D_, EpiStore16{PROJ, PROJW});
#ifndef CPU_EMU
        { const int nun_ = (NTOK / 256) * (PROJW / 256), ngr_ = (int)gridDim.x, first_ = nun_ - 2 * ngr_;
          if (ngr_ * 3 > nun_ && ngr_ * 2 < nun_ && (int)blockIdx.x >= first_) {
              __syncthreads();
              const int tn_ = (int)tid_now(), lane = tn_ & 63, wv = tn_ >> 6, gw = ((int)blockIdx.x - first_) * 8 + wv, nw = (ngr_ - first_) * 8; float* scr = ldsf + wv * (64 * 33);
              for (int j = 0; j < 3; ++j) wprep_items(scr, lane, gw, nw, w_rkv + (size_t)j * D_ * D_, D_, D_, D_, WRKV + (size_t)j * D_ * D_);
              wprep_items(scr, lane, gw, nw, w_o, D_, D_, D_, WO); } }
#endif
        SEAM(2); }
    #ifdef CPU_EMU
    if (IN(3)) { ph_rope(PROJ); ph_gla_loga(PROJ, dec_w2, dec_b, LOGA); SEAM(3); }
    if (IN(4)) { ph_gla_scan(PROJ, LOGA, GLAO); ph_swa(PROJ, sink, MIX, GLA_THREADS); SEAM(4); }
#else
    if (IN(4)) { ph_gla_chunk(lds, PROJ, dec_w2, dec_b, GLAO); ph_swa2(lds, PROJ, sink, MIX); SEAM(4); }
#endif
#ifdef CPU_EMU
    if (IN(5)) { ph_gla_out(PROJ, GLAO, gla_g, MIX); SEAM(5); }
#else
    if (IN(5)) { ph_gla_out2(PROJ, GLAO, gla_g, MIX); SEAM(5); }
#endif
    if (IN(6)) { run_gemm(lds, MIX, WOUT, NTOK, D_, D_, EpiResid{XC, MOD0 + 2 * D_, x_in, ctx});
#ifndef CPU_EMU
        if ((int)blockIdx.x >= 32) ph_cvt_tab_i8(peer_u, TAB0, USC, 32, 224);
#endif
        SEAM(6); }
#ifdef CPU_EMU
    if (IN(7)) { ph_modnorm(ldsf, NTOK, XC, norm2_g, MOD0, 3, 4, U, nullptr); SEAM(7); }
#else
    if (IN(7)) { ph_modnorm2(NTOK, XC, norm2_g, MOD0, 3, 4, U, nullptr); SEAM(7); }
#endif
    if (IN(8)) { run_gemm(lds, U, WQ0, NTOK, 2048, D_, EpiStoreF32{SC, 2048});
#ifndef CPU_EMU
        if ((int)blockIdx.x >= 64) ph_cvt_tab(peer_v, TAB0 + PE, PE, 1.f, 64, 192);
#endif
        SEAM(8); }
    #ifdef CPU_EMU
    if (IN(9)) { ph_peer_topk(ldsf, NTOK, SC, PIDX, PGATE); SEAM(9); }
    if (IN(10)) { ph_peer_apply(ldsf, NTOK, U, PIDX, PGATE, TAB0, TAB0 + PE, MOD0, XC); SEAM(10); }
#else
    if (IN(9)) { ph_topk2(NTOK, SC, PIDX, PGATE); SEAM(9); }
    if (IN(10)) { ph_peer_apply4<3>(lds, NTOK, U, PIDX, PGATE, TAB0, USC, TAB0 + PE, MOD0, XC, 1.f); SEAM(10); }
#endif
#ifdef CPU_EMU
    if (IN(11)) { ph_modnorm(ldsf, NTOK, XC, norm1_g + D_, MOD1, 0, 1, H, nullptr); SEAM(11); }
    if (IN(22)) { ph_xs(H, rw_mu, XS, HX); SEAM(22); }
#else
    if (IN(11)) { ph_norm_mix(XC, norm1_g + D_, MOD1, rw_mu, XS, HX); SEAM(11); }
#endif
    if (IN(12)) {
        for (int j = 0; j < 3; ++j) run_gemm(lds, XS + (size_t)j * (ROWB / SA), WRKV + (size_t)j * D_ * D_, j == 0 ? NLAT : NTOK, D_, D_, EpiStore16{j == 0 ? R : (j == 1 ? K : V), D_}, j == 2 ? 224 : 0);
        run_gemm(lds, HX, WL1, NTOK, 512, 2048, EpiLora1{T1, T2}, 144);
        SEAM(12); }
    if (IN(13)) {
        run_gemm(lds, T1, WL2A, NTOK, 2048, 256, EpiStore16{DEC, 2048});
        run_gemm(lds, T1, WL2A + (size_t)2048 * 256, NTOK, 2048, 256, EpiStore16{A, 2048}, 192);
        run_gemm(lds, T2, WL2B, NLAT, D_, 256, EpiStore16{G, D_});
#ifdef CPU_EMU
        ph_rw_kk(K, k_k, KK);
#else

#endif
        SEAM(13); }
    #ifdef CPU_EMU
    if (IN(14)) { ph_rw_scan(R, K, V, KK, A, DEC, rw_w0, rw_a0, k_a, Y0, Y1); SEAM(14); }
#else
    if (IN(14)) { ph_rw_scan3(lds, R, K, V, k_k, A, DEC, rw_w0, rw_a0, k_a, Y0, Y1, peer_u + PE, peer_v + PE, TAB1, USC + 16384); SEAM(14); }
#endif
#ifdef CPU_EMU
    if (IN(15)) { ph_rw_out(Y0, Y1, R, K, V, A, rw_a0, G, k_a, r_k, ln_g, ln_b, RWOUT); SEAM(15); }
#else
    if (IN(15)) { ph_rw_out2(Y0, Y1, R, K, V, A, rw_a0, G, k_a, r_k, ln_g, ln_b, RWOUT); SEAM(15); }
#endif
#ifdef CPU_EMU
    if (IN(16)) { ph_cvt_tab(peer_u + PE, TAB1, PE, 32.f); ph_cvt_tab(peer_v + PE, TAB1 + PE, PE, 1.f); run_gemm(lds, RWOUT, WO, NLAT, D_, D_, EpiResid{XC, MOD1 + 2 * D_, nullptr, nullptr}); SEAM(16); }
#else
    if (IN(16)) { run_gemm(lds, RWOUT, WO, NLAT, D_, D_, EpiResid{XC, MOD1 + 2 * D_, nullptr, nullptr}); SEAM(16); }
#endif
#ifdef CPU_EMU
    if (IN(17)) { ph_modnorm(ldsf, NLAT, XC, norm2_g + D_, MOD1, 3, 4, U1, nullptr); SEAM(17); }
#else
    if (IN(17)) { ph_modnorm2(NLAT, XC, norm2_g + D_, MOD1, 3, 4, U1, nullptr); SEAM(17); }
#endif
    if (IN(18)) { run_gemm(lds, U1, WQ1, NLAT, 2048, D_, EpiStoreF32{SC1, 2048}); SEAM(18); }
    #ifdef CPU_EMU
    if (IN(19)) { ph_peer_topk(ldsf, NLAT, SC1, PIDX, PGATE); SEAM(19); }
    if (IN(20)) { ph_peer_apply(ldsf, NLAT, U1, PIDX, PGATE, TAB1, TAB1 + PE, MOD1, XC); SEAM(20); }
#else
    if (IN(19)) { ph_topk2(NLAT, SC1, PIDX, PGATE); SEAM(19); }
    if (IN(20)) { ph_peer_apply4<4>(lds, NLAT, U1, PIDX, PGATE, TAB1, USC + 16384, TAB1 + PE, MOD1, XC, 1.f, final_g, KP->out); }
#endif
#ifdef CPU_EMU
    if (IN(21)) { ph_modnorm(ldsf, NLAT, XC, final_g, nullptr, 0, 0, nullptr, p.out); }
#endif
}

#undef x_in
#undef c_in
#undef ctx
#undef c_ctx
#undef ada_w
#undef ada_b
#undef norm1_g
#undef norm2_g
#undef w_in
#undef dec_w2
#undef dec_b
#undef gla_g
#undef sink
#undef w_out
#undef rw_mu
#undef w_rkv
#undef w_o
#undef rw_w0
#undef rw_w1
#undef rw_w2
#undef rw_a0
#undef rw_a1
#undef rw_a2
#undef rw_g1
#undef rw_g2
#undef k_k
#undef k_a
#undef r_k
#undef ln_g
#undef ln_b
#undef peer_wq
#undef peer_k1
#undef peer_k2
#undef peer_u
#undef peer_v
#undef final_g
#undef MOD
#undef XC
#undef U
#undef MIX
#undef WIN
#undef WOUT
#undef WQ0
#undef WQ1
#undef WRKV
#undef WO
#undef H
#undef XS
#undef Y0
#undef Y1
#undef PROJ
#undef LOGA
#undef GLAO
#undef SC
#undef TAB0
#undef TAB1
#undef USC
#undef PIDX
#undef PGATE
#undef R
#undef K
#undef V
#undef KK
#undef U1
#undef SC1
#undef G
#undef A
#undef DEC
#undef RWOUT
#undef T1
#undef T2
#undef HX
#undef WL1
#undef WL2A
#undef WL2B
#undef MOD0
#undef MOD1

extern "C" void kernel_launch(void* const* d_in, const int* in_sizes, int n_in, void* d_out, int out_size, void* d_ws, size_t ws_size, hipStream_t stream) {
    if (ws_size < WS_TOTAL || n_in != 36) { fprintf(stderr, "kernel_launch: ws too small (%zu < %zu) or n_in %d != 36\n", ws_size, (size_t)WS_TOTAL, n_in); return; }
    Params p{};
    for (int i = 0; i < 36; ++i) p.in[i] = (const float*)d_in[i];
    p.out = (float*)d_out; p.ws = (char*)d_ws;
#ifdef CPU_EMU
    { const int order[N_PHASES] = {0,1,2,3,4,5,6,7,8,9,10,11,22,12,13,14,15,16,17,18,19,20,21};
      for (int i = 0; i < N_PHASES; ++i) { int ph = order[i]; p.ph_lo = ph; p.ph_hi = ph + 1; emu_launch(true, 8, NT, [=] { mega(p); }); emu_phase_hook(ph, (char*)d_ws); } }
#else
    static int grid = 0;
    if (grid == 0) {
        int dev = 0, cus = 0;
        if (hipGetDevice(&dev) != hipSuccess || hipDeviceGetAttribute(&cus, hipDeviceAttributeMultiprocessorCount, dev) != hipSuccess) { grid = -1; return; }
        if (hipFuncSetAttribute((const void*)mega, hipFuncAttributeMaxDynamicSharedMemorySize, LDS_BYTES) != hipSuccess) { grid = -1; return; }
        grid = cus;
    }
    if (grid < 0) return;
    (void)hipMemsetAsync((char*)d_ws + OFF_CTL, 0, CTL_BYTES, stream);
    p.ph_lo = 0; p.ph_hi = N_PHASES;
    hipLaunchKernelGGL(mega, dim3(grid), dim3(NT), LDS_BYTES, stream, p);
#endif
}
```

```cpp
#ifndef CPU_EMU
#include <hip/hip_runtime.h>
#define DUMP(name, ptr, count)
#define DUMPD(name, ptr, count)
#endif
#include <stdint.h>
#include <string.h>
#include <stdio.h>

#ifndef CFG_B
#define CFG_B 8
#define CFG_T 2048
#define CFG_L 256
#endif
constexpr int B_ = CFG_B, T_ = CFG_T, L_ = CFG_L, D_ = 1024;
constexpr int NLAT = B_ * T_, NCTX = B_ * L_, NTOK = NLAT + NCTX;
constexpr int PROJW = 2560;
constexpr int C_GQ = 0, C_GK = 256, C_GV = 512, C_GG = 1024, C_LR = 1536, C_SQ = 1568, C_SK = 2080, C_SV = 2208;
constexpr int D6 = 6 * D_;

struct bf16 { unsigned short v; };
#ifdef AT_F32
typedef float AT;
#else
typedef bf16 AT;
#endif
#ifdef CPU_EMU
typedef float DT;
#else
typedef _Float16 DT;
#endif
__device__ __forceinline__ float ldf(const float* p) { return *p; }
__device__ __forceinline__ void stf(float* p, float v) { *p = v; }
__device__ __forceinline__ float ldf(const bf16* p) { unsigned u = (unsigned)p->v << 16; float f; memcpy(&f, &u, 4); return f; }
__device__ __forceinline__ void stf(bf16* p, float f) { unsigned u; memcpy(&u, &f, 4); u = (u + 0x7fffu + ((u >> 16) & 1u)) >> 16; p->v = (unsigned short)u; }
__device__ __forceinline__ float sigmoidf_(float x) { return 1.f / (1.f + expf(-x)); }
#ifdef CPU_EMU
__device__ __forceinline__ float fsig(float x) { return sigmoidf_(x); }
__device__ __forceinline__ float ftanh(float x) { return tanhf(x); }
#else
__device__ __forceinline__ float fsig(float x) { return __builtin_amdgcn_rcpf(1.f + __expf(-x)); }
__device__ __forceinline__ float ftanh(float x) { return 2.f * __builtin_amdgcn_rcpf(1.f + __expf(-2.f * x)) - 1.f; }
#endif

struct TokInfo { int b, pos, len; };
__device__ __forceinline__ TokInfo tokinfo(int m) {
    TokInfo t; if (m < NLAT) { t.b = m / T_; t.pos = m % T_; t.len = T_; } else { int c = m - NLAT; t.b = c / L_; t.pos = c % L_; t.len = L_; } return t; }
__device__ __forceinline__ int tok_row(int m) { return m < NLAT ? m / T_ : B_; }

constexpr size_t al_(size_t x) { return (x + 255) & ~(size_t)255; }
constexpr size_t SA = sizeof(AT), SD = sizeof(DT);
constexpr size_t ROWB = al_((size_t)NTOK * D_ * SA);
constexpr size_t OFF_MOD = 0;
constexpr size_t OFF_XC = al_(OFF_MOD + (size_t)2 * (B_ + 1) * D6 * 4);
constexpr size_t OFF_WB = al_(OFF_XC + (size_t)NTOK * D_ * 4);
constexpr size_t WSZ = (size_t)D_ * D_ * SA;
constexpr size_t OFF_WIN = OFF_WB;
constexpr size_t OFF_WOUT = OFF_WIN + (size_t)PROJW * D_ * SA;
constexpr size_t OFF_WQ0 = OFF_WOUT + WSZ;
constexpr size_t OFF_WQ1 = OFF_WQ0 + 2 * WSZ;
constexpr size_t OFF_WRKV = OFF_WQ1 + 2 * WSZ;
constexpr size_t OFF_WO = OFF_WRKV + 3 * WSZ;
constexpr size_t OFF_WL1 = OFF_WO + WSZ;
constexpr size_t OFF_WL2A = OFF_WL1 + (size_t)512 * 2048 * SA;
constexpr size_t OFF_WL2B = OFF_WL2A + (size_t)4096 * 256 * SA;
constexpr size_t OFF_X = al_(OFF_WL2B + (size_t)1024 * 256 * SA);
constexpr size_t OFF_Y = OFF_X + 6 * ROWB;
constexpr size_t SZ_TAB = (size_t)2 * 16384 * D_ * (SA == 4 ? 4 : 1);
constexpr size_t mx_(size_t a, size_t b) { return a > b ? a : b; }
constexpr size_t SZ_Y = mx_(mx_(al_((size_t)NTOK * PROJW * SA), 3 * ROWB + 2 * al_((size_t)NTOK * 256 * SA)), SZ_TAB);
constexpr size_t OFF_Z = OFF_Y + SZ_Y;
constexpr size_t SZ_Z = mx_(mx_(ROWB, 2 * al_((size_t)NLAT * D_ * SA)), SZ_TAB);
constexpr size_t WS_END = OFF_Z + SZ_Z;
constexpr size_t OFF_U = OFF_X;
constexpr size_t OFF_MIX = OFF_X + ROWB;
constexpr size_t OFF_LOGA = OFF_X + 2 * ROWB;
constexpr size_t OFF_GLAO = OFF_LOGA + al_((size_t)NTOK * 512 * 4);
static_assert(OFF_GLAO + (size_t)2 * NTOK * 512 * 4 <= OFF_Y || SA == 4, "layer-0 view overflows region X");
constexpr size_t OFF_GIMG = OFF_X + 4 * ROWB;
constexpr size_t OFF_PROJ = OFF_Y;
constexpr size_t OFF_SC = OFF_X + ROWB;
constexpr size_t OFF_PIDX = OFF_X + 5 * ROWB;
constexpr size_t OFF_PGATE = OFF_PIDX + al_((size_t)NTOK * 128 * 4);
static_assert(OFF_SC + (size_t)NTOK * 2048 * 4 <= OFF_PIDX && OFF_PGATE + (size_t)NTOK * 128 * 4 <= OFF_X + 6 * ROWB, "peer view overflows region X");
#ifdef CPU_EMU
constexpr size_t OFF_TAB0 = OFF_Z, OFF_TAB1 = OFF_Y;
constexpr size_t OFF_U1 = OFF_U, OFF_SC1 = OFF_SC;
#else
constexpr size_t OFF_TAB0 = OFF_Z, OFF_TAB1 = OFF_X + 4 * ROWB;
constexpr size_t OFF_U1 = OFF_Y, OFF_SC1 = OFF_X;
static_assert((size_t)2 * 16384 * D_ <= ROWB && (size_t)NLAT * 2048 * 4 <= 4 * ROWB, "layer-1 PEER view");
#endif
constexpr size_t OFF_H = OFF_Z;
constexpr size_t OFF_XS = OFF_X;
constexpr size_t OFF_R = OFF_Y, OFF_K = OFF_Y + ROWB, OFF_V = OFF_Y + 2 * ROWB;
constexpr size_t OFF_T1 = OFF_Y + 3 * ROWB;
constexpr size_t OFF_T2 = OFF_T1 + al_((size_t)NTOK * 256 * SA);
constexpr size_t OFF_HX = OFF_X + 3 * ROWB;
constexpr size_t OFF_DEC = OFF_X;
constexpr size_t OFF_A = OFF_X + 2 * ROWB;
constexpr size_t OFF_KK = OFF_A + 2 * ROWB;
constexpr size_t OFF_G = OFF_KK + ROWB;
constexpr size_t OFF_Y0 = OFF_Z, OFF_Y1 = OFF_Z + al_((size_t)NLAT * D_ * SA);
#ifndef CPU_EMU
static_assert(OFF_G + ROWB <= OFF_Y, "layer-1 view overflows region X");
#endif

constexpr int NT = 512;
#ifdef CPU_EMU
__device__ __forceinline__ unsigned tid_now() { return threadIdx.x; }
#else
constexpr int TID_TAB_OFF = 131072 + 512;
__device__ __forceinline__ unsigned hw_slot() { return (unsigned)__builtin_amdgcn_s_getreg((5 << 11) | 4) & 63u; }
__device__ __forceinline__ unsigned tid_now() {
    extern __shared__ __attribute__((aligned(16))) unsigned char lds_dyn_tid_[];
    const unsigned wv = *(volatile __attribute__((address_space(3))) unsigned*)((__attribute__((address_space(3))) unsigned char*)lds_dyn_tid_ + TID_TAB_OFF + 4 * hw_slot());
    const unsigned lane = __builtin_amdgcn_mbcnt_hi(~0u, __builtin_amdgcn_mbcnt_lo(~0u, 0u));
    return ((unsigned)__builtin_amdgcn_readfirstlane((int)wv) << 6) | lane; }
#endif
#define GSTRIDE(idx, N) for (size_t idx = (size_t)blockIdx.x * NT + tid_now(); idx < (size_t)(N); idx += (size_t)gridDim.x * NT)
#define GSTRIDE_SUB(idx, N, wg0, nwg) for (size_t idx = (size_t)((int)blockIdx.x - (wg0)) * NT + tid_now(); idx < (size_t)(N); idx += (size_t)(nwg) * NT)

#ifndef CPU_EMU
namespace pg8 {
#define PG8_LAS __attribute__((address_space(3)))
typedef unsigned short bf16_t;
typedef short bf16x8 __attribute__((ext_vector_type(8)));
typedef float f32x4 __attribute__((ext_vector_type(4)));
typedef unsigned u32x4 __attribute__((ext_vector_type(4)));
constexpr int BM = 256, BK = 64, HALF = 128, HTB = HALF * BK * 2  , STAGE_BYTES = 8 * HTB, NXCD = 8, WGM = 8;

__host__ __device__ __forceinline__ int lds_byte(int r, int c) { const int st = (r >> 4) * 2 + (c >> 5), rr = r & 15, cc = c & 31, ob = rr * 64 + cc * 2; return st * 1024 + (ob ^ (((ob >> 9) & 1) << 5)); }
__host__ __device__ __forceinline__ void stage_rc(int b, int& R, int& C) { const int st = b / 1024, sb = b % 1024, swz = sb ^ (((sb >> 9) & 1) << 5); R = (st >> 1) * 16 + swz / 64; C = (st & 1) * 32 + (swz % 64) / 2; }
__host__ __device__ __forceinline__ int perm32(int rho) { const int n = rho >> 4, i = rho & 15; return 8 * (i >> 2) + 4 * n + (i & 3); }

struct Unit { int pm, pn; };
struct Gemm { const bf16_t* A; const bf16_t* Bt; int M, N, K; };

struct StaticOrder {
    int nM, nN, nwg, G, c;
    __host__ __device__ void init(int M, int N, int G_, int c_) { nM = M / BM; nN = N / BM; nwg = nM * nN; G = G_; c = c_; }
    __host__ __device__ bool next(int i, Unit& u) const {
        const long L = (long)i * G + c; if (L >= nwg) return false;
        int wgid = (int)L; { const int q = nwg / NXCD, r = nwg % NXCD, xcd = wgid % NXCD, off = wgid / NXCD; wgid = (xcd < r ? xcd * (q + 1) : r * (q + 1) + (xcd - r) * q) + off; }
        const int nig = WGM * nN, gid = wgid / nig, fm = gid * WGM, gsz = (nM - fm) < WGM ? (nM - fm) : WGM;
        u.pm = fm + ((wgid % nig) % gsz); u.pn = (wgid % nig) / gsz; return true;
    }
    __device__ __forceinline__ void a_ready(const Unit&) const {}
    __device__ __forceinline__ void done(const Unit&) const {}
};

__device__ __forceinline__ unsigned cvt_pk_bf16(float lo, float hi) { unsigned r; asm volatile("v_cvt_pk_bf16_f32 %0, %1, %2" : "=v"(r) : "v"(lo), "v"(hi)); return r; }
typedef float f32x2 __attribute__((ext_vector_type(2)));
template <class Epi, class Sched, bool ALIGN_EPI = false, bool SP2 = false>
__device__ __forceinline__ void gemm_phase(PG8_LAS unsigned char* lds, const Gemm g, const Sched& S, const Epi& E) {
    const int tid = (int)tid_now(), wid = __builtin_amdgcn_readfirstlane(tid >> 6), lane = tid & 63, wr = wid >> 2, wc = wid & 3, fr = lane & 15, fq = lane >> 4;
    const int K = g.K, nt = K / BK;
    unsigned voffA[2], voffB[2];
#pragma unroll
    for (int i = 0; i < 2; ++i) { int R, C; stage_rc(tid * 16 + i * 8192, R, C); const int Rb = Epi::PERM ? ((R & ~31) + perm32(R & 31)) : R;
        voffA[i] = (unsigned)(R * K + C) * 2u; voffB[i] = (unsigned)(Rb * K + C) * 2u; }
    const size_t kstep = (size_t)(BK * 2);
    const size_t hstep = (size_t)HALF * K * 2;
    const size_t tstep = 2 * hstep;
    const unsigned ldsw = (unsigned)wid * 1024u;
    const int aoff = lds_byte(wr * 64 + fr, fq * 8), boff = lds_byte(wc * 32 + fr, fq * 8);
#define PG8_SA(b, h) (((b) * 2 + (h)) * HTB)
#define PG8_SB(b, h) ((4 + (b) * 2 + (h)) * HTB)
#define PG8_STAGE(bufoff, gbase, voff) do { _Pragma("unroll") for (int _i = 0; _i < 2; ++_i) \
        __builtin_amdgcn_global_load_lds((const unsigned*)((const char*)(gbase) + (voff)[_i]), (PG8_LAS unsigned*)(lds + (bufoff) + ldsw + _i * 8192), 16, 0, 0); } while (0)
#define PG8_LDA(dst, b, h) do { _Pragma("unroll") for (int m = 0; m < 4; ++m) _Pragma("unroll") for (int k = 0; k < 2; ++k) dst[m][k] = *(const PG8_LAS bf16x8*)(lds + PG8_SA(b, h) + aoff + m * 2048 + k * 1024); } while (0)
#define PG8_LDB(dst, b, h) do { _Pragma("unroll") for (int n = 0; n < 2; ++n) _Pragma("unroll") for (int k = 0; k < 2; ++k) dst[n][k] = *(const PG8_LAS bf16x8*)(lds + PG8_SB(b, h) + boff + n * 2048 + k * 1024); } while (0)
#define PG8_MMA(ai, bj, At, Bt) do { __builtin_amdgcn_s_setprio(1); _Pragma("unroll") for (int m = 0; m < 4; ++m) _Pragma("unroll") for (int n = 0; n < 2; ++n) _Pragma("unroll") for (int k = 0; k < 2; ++k) \
        acc[ai][bj][m][n] = __builtin_amdgcn_mfma_f32_16x16x32_bf16(Bt[n][k], At[m][k], acc[ai][bj][m][n], 0, 0, 0); __builtin_amdgcn_s_setprio(0); } while (0)
#define PG8_WAIT_V(n) asm volatile("s_waitcnt vmcnt(" #n ")" ::: "memory")
#define PG8_WAIT_L(n) asm volatile("s_waitcnt lgkmcnt(" #n ")" ::: "memory")
#define PG8_BAR __builtin_amdgcn_s_barrier()
#define PG8_SCHED __builtin_amdgcn_sched_barrier(0)
    Unit cur, nxt; int ui = 0;
    if (!S.next(0, cur)) return;
    f32x4 acc[2][2][4][2];
#pragma unroll
    for (int a = 0; a < 2; ++a)
#pragma unroll
        for (int b = 0; b < 2; ++b)
#pragma unroll
            for (int m = 0; m < 4; ++m)
#pragma unroll
                for (int n = 0; n < 2; ++n) acc[a][b][m][n] = (f32x4){0.f, 0.f, 0.f, 0.f};
    bf16x8 At[4][2], B0[2][2], B1[2][2];
    const char* cA = (const char*)g.A + (size_t)cur.pm * tstep; const char* cB = (const char*)g.Bt + (size_t)cur.pn * tstep;
    S.a_ready(cur);
    if constexpr (SP2) {
        PG8_STAGE(PG8_SB(0, 0), cB, voffB); PG8_STAGE(PG8_SB(0, 1), cB + hstep, voffB); PG8_STAGE(PG8_SA(0, 0), cA, voffA); PG8_STAGE(PG8_SA(0, 1), cA + hstep, voffA);
        if (wr == 1) PG8_BAR;
        PG8_WAIT_V(2); PG8_BAR;
        PG8_STAGE(PG8_SB(1, 0), cB + kstep, voffB); PG8_STAGE(PG8_SA(1, 0), cA + kstep, voffA); PG8_STAGE(PG8_SB(1, 1), cB + hstep + kstep, voffB);
        PG8_WAIT_V(6); PG8_BAR;
    } else {
        PG8_STAGE(PG8_SB(0, 0), cB, voffB); PG8_STAGE(PG8_SA(0, 0), cA, voffA); PG8_STAGE(PG8_SB(0, 1), cB + hstep, voffB); PG8_STAGE(PG8_SA(0, 1), cA + hstep, voffA);
        if (wr == 1) PG8_BAR;
        PG8_WAIT_V(4); PG8_BAR;
        PG8_STAGE(PG8_SB(1, 0), cB + kstep, voffB); PG8_STAGE(PG8_SA(1, 0), cA + kstep, voffA); PG8_STAGE(PG8_SB(1, 1), cB + hstep + kstep, voffB);
        PG8_WAIT_V(6); PG8_BAR;
    }
    for (;;) {
        const bool has_next = S.next(ui + 1, nxt);
        const char* nA = has_next ? (const char*)g.A + (size_t)nxt.pm * tstep : cA; const char* nB = has_next ? (const char*)g.Bt + (size_t)nxt.pn * tstep : cB;
        for (int t = 0; t < nt; t += 2) {
            const bool last = (t == nt - 2);
            const char* a1 = cA + (size_t)(t + 1) * kstep;
            const char* a2 = last ? nA : cA + (size_t)(t + 2) * kstep; const char* b2 = last ? nB : cB + (size_t)(t + 2) * kstep;
            const char* a3 = a2 + kstep; const char* b3 = b2 + kstep;
            if (last && has_next) S.a_ready(nxt);
            if constexpr (SP2) {
            PG8_LDB(B0, 0, 0); PG8_LDB(B1, 0, 1); PG8_SCHED; PG8_LDA(At, 0, 0); PG8_STAGE(PG8_SA(1, 1), a1 + hstep, voffA);
            PG8_WAIT_V(8); PG8_WAIT_L(0); PG8_BAR; PG8_MMA(0, 0, At, B0); PG8_MMA(0, 1, At, B1); PG8_BAR; PG8_SCHED;
            PG8_LDA(At, 0, 1); PG8_STAGE(PG8_SB(0, 0), b2, voffB); PG8_STAGE(PG8_SB(0, 1), b2 + hstep, voffB); PG8_STAGE(PG8_SA(0, 0), a2, voffA);
            PG8_WAIT_V(8); PG8_WAIT_L(0); PG8_BAR; PG8_MMA(1, 0, At, B0); PG8_MMA(1, 1, At, B1); PG8_BAR; PG8_SCHED;
            PG8_LDB(B0, 1, 0); PG8_LDB(B1, 1, 1); PG8_SCHED; PG8_LDA(At, 1, 0); PG8_STAGE(PG8_SA(0, 1), a2 + hstep, voffA);
            PG8_WAIT_V(8); PG8_WAIT_L(0); PG8_BAR; PG8_MMA(0, 0, At, B0); PG8_MMA(0, 1, At, B1); PG8_BAR; PG8_SCHED;
            PG8_LDA(At, 1, 1); PG8_STAGE(PG8_SB(1, 0), b3, voffB); PG8_STAGE(PG8_SB(1, 1), b3 + hstep, voffB); PG8_STAGE(PG8_SA(1, 0), a3, voffA);
            PG8_WAIT_V(8); PG8_WAIT_L(0); PG8_BAR; PG8_MMA(1, 0, At, B0); PG8_MMA(1, 1, At, B1); PG8_BAR; PG8_SCHED;
            } else {
            PG8_LDB(B0, 0, 0); PG8_SCHED; PG8_LDA(At, 0, 0); PG8_STAGE(PG8_SA(1, 1), a1 + hstep, voffA);
            PG8_WAIT_L(8); PG8_BAR; PG8_WAIT_L(0); PG8_MMA(0, 0, At, B0); PG8_BAR; PG8_SCHED;
            PG8_LDB(B1, 0, 1); PG8_STAGE(PG8_SB(0, 0), b2, voffB);
            PG8_BAR; PG8_WAIT_L(0); PG8_MMA(0, 1, At, B1); PG8_BAR;
            PG8_LDA(At, 0, 1); PG8_STAGE(PG8_SA(0, 0), a2, voffA);
            PG8_BAR; PG8_WAIT_L(0); PG8_MMA(1, 0, At, B0); PG8_BAR; PG8_SCHED;
            PG8_STAGE(PG8_SB(0, 1), b2 + hstep, voffB);
            PG8_WAIT_V(6); PG8_BAR; PG8_MMA(1, 1, At, B1); PG8_BAR;
            PG8_LDB(B0, 1, 0); PG8_SCHED; PG8_LDA(At, 1, 0); PG8_STAGE(PG8_SA(0, 1), a2 + hstep, voffA);
            PG8_WAIT_L(8); PG8_BAR; PG8_WAIT_L(0); PG8_MMA(0, 0, At, B0); PG8_BAR; PG8_SCHED;
            PG8_LDB(B1, 1, 1); PG8_STAGE(PG8_SB(1, 0), b3, voffB);
            PG8_BAR; PG8_WAIT_L(0); PG8_MMA(0, 1, At, B1); PG8_BAR;
            PG8_LDA(At, 1, 1); PG8_STAGE(PG8_SA(1, 0), a3, voffA);
            PG8_BAR; PG8_WAIT_L(0); PG8_MMA(1, 0, At, B0); PG8_BAR; PG8_SCHED;
            PG8_STAGE(PG8_SB(1, 1), b3 + hstep, voffB);
            PG8_WAIT_V(6); PG8_BAR; PG8_MMA(1, 1, At, B1); PG8_BAR;
            }
        }
        if constexpr (ALIGN_EPI) { if (wr == 0) PG8_BAR; }
        if constexpr (!Epi::AFTER_DRAIN) { E(acc, cur, wr, wc, fr, fq); S.done(cur); }
        if (!has_next) break;
#pragma unroll
        for (int a = 0; a < 2; ++a)
#pragma unroll
            for (int b = 0; b < 2; ++b)
#pragma unroll
                for (int m = 0; m < 4; ++m)
#pragma unroll
                    for (int n = 0; n < 2; ++n) acc[a][b][m][n] = (f32x4){0.f, 0.f, 0.f, 0.f};
        cur = nxt; cA = nA; cB = nB; ++ui;
        if constexpr (ALIGN_EPI) { if (wr == 1) PG8_BAR; }
    }
    PG8_WAIT_V(0);
    if constexpr (!ALIGN_EPI) { if (wr == 0) PG8_BAR; }
    PG8_BAR;
    if constexpr (Epi::AFTER_DRAIN) { E.fused(acc, cur, wr, wc, fr, fq, lds, wid, lane); S.done(cur); }
#undef PG8_SA
#undef PG8_SB
#undef PG8_STAGE
#undef PG8_LDA
#undef PG8_LDB
#undef PG8_MMA
#undef PG8_WAIT_V
#undef PG8_WAIT_L
#undef PG8_BAR
#undef PG8_SCHED
}
}

#define PG8_SP2 true
#define PG8_ALIGN true
#endif
struct EpiStore16 {
    static constexpr bool PERM = true, AFTER_DRAIN = false; AT* O; int ldc;
#ifndef CPU_EMU
    __device__ __forceinline__ void operator()(const pg8::f32x4 (&acc)[2][2][4][2], const pg8::Unit& u, int wr, int wc, int fr, int fq) const {
        const int row0 = u.pm * 256 + wr * 64 + fr, col0 = u.pn * 256 + wc * 32 + 8 * fq;
#pragma unroll
        for (int ai = 0; ai < 2; ++ai)
#pragma unroll
            for (int m = 0; m < 4; ++m) { pg8::bf16_t* rowp = (pg8::bf16_t*)O + (size_t)(row0 + ai * 128 + m * 16) * ldc + col0;
#pragma unroll
                for (int bj = 0; bj < 2; ++bj) { const pg8::f32x4 v0 = acc[ai][bj][m][0], v1 = acc[ai][bj][m][1]; pg8::u32x4 w;
                    w.x = pg8::cvt_pk_bf16(v0[0], v0[1]); w.y = pg8::cvt_pk_bf16(v0[2], v0[3]); w.z = pg8::cvt_pk_bf16(v1[0], v1[1]); w.w = pg8::cvt_pk_bf16(v1[2], v1[3]);
                    *(pg8::u32x4*)(rowp + bj * 128) = w; } }
    }
#endif
    __device__ __forceinline__ void elem(int m, int n, float v) const { stf(O + (size_t)m * ldc + n, v); }
};
typedef unsigned eu2_t __attribute__((ext_vector_type(2)));
struct EpiResid {
    static constexpr bool PERM = true, AFTER_DRAIN = false; float* XC; const float* gate; const float* xsrc; const float* csrc;
    __device__ __forceinline__ const float* srow(int r) const { return xsrc ? (r < NLAT ? xsrc + (size_t)r * D_ : csrc + (size_t)(r - NLAT) * D_) : XC + (size_t)r * D_; }
#ifndef CPU_EMU
    __device__ __forceinline__ void operator()(const pg8::f32x4 (&acc)[2][2][4][2], const pg8::Unit& u, int wr, int wc, int fr, int fq) const {
        static_assert(T_ % 256 == 0 && NLAT % 256 == 0, "a 256-row unit must lie within one batch element");
        const int row0 = u.pm * 256 + wr * 64 + fr, col0 = u.pn * 256 + wc * 32 + 8 * fq;
        const float* gr = gate + (size_t)tok_row(u.pm * 256) * D6 + col0;
        pg8::f32x4 gg[2][2];
#pragma unroll
        for (int bj = 0; bj < 2; ++bj) { gg[bj][0] = *(const pg8::f32x4*)(gr + bj * 128); gg[bj][1] = *(const pg8::f32x4*)(gr + bj * 128 + 4); }
        if (xsrc) {
            pg8::f32x4 sc[2][2], sn[2][2];
            { const float* sr = srow(row0) + col0;
#pragma unroll
              for (int bj = 0; bj < 2; ++bj) { sc[bj][0] = *(const pg8::f32x4*)(sr + bj * 128); sc[bj][1] = *(const pg8::f32x4*)(sr + bj * 128 + 4); } }
#pragma unroll
            for (int it = 0; it < 8; ++it) { const int ai = it >> 2, m = it & 3, r = row0 + ai * 128 + m * 16;
                if (it < 7) { const float* sr = srow(row0 + ((it + 1) >> 2) * 128 + ((it + 1) & 3) * 16) + col0;
#pragma unroll
                    for (int bj = 0; bj < 2; ++bj) { sn[bj][0] = *(const pg8::f32x4*)(sr + bj * 128); sn[bj][1] = *(const pg8::f32x4*)(sr + bj * 128 + 4); } }
                unsigned short* xh = (unsigned short*)XC + (size_t)r * D_ + col0;
#pragma unroll
                for (int bj = 0; bj < 2; ++bj) { const pg8::f32x4 r0 = sc[bj][0] + gg[bj][0] * acc[ai][bj][m][0], r1 = sc[bj][1] + gg[bj][1] * acc[ai][bj][m][1]; pg8::u32x4 w;
                    w.x = pg8::cvt_pk_bf16(r0[0], r0[1]); w.y = pg8::cvt_pk_bf16(r0[2], r0[3]); w.z = pg8::cvt_pk_bf16(r1[0], r1[1]); w.w = pg8::cvt_pk_bf16(r1[2], r1[3]); *(pg8::u32x4*)(xh + bj * 128) = w; }
#pragma unroll
                for (int bj = 0; bj < 2; ++bj) { sc[bj][0] = sn[bj][0]; sc[bj][1] = sn[bj][1]; }
                __builtin_amdgcn_sched_barrier(0); }
        } else {
            pg8::u32x4 qc[2], qn[2];
            { const unsigned short* xh = (const unsigned short*)XC + (size_t)row0 * D_ + col0; qc[0] = *(const pg8::u32x4*)xh; qc[1] = *(const pg8::u32x4*)(xh + 128); }
#pragma unroll
            for (int it = 0; it < 8; ++it) { const int ai = it >> 2, m = it & 3, r = row0 + ai * 128 + m * 16;
                if (it < 7) { const unsigned short* xn = (const unsigned short*)XC + (size_t)(row0 + ((it + 1) >> 2) * 128 + ((it + 1) & 3) * 16) * D_ + col0; qn[0] = *(const pg8::u32x4*)xn; qn[1] = *(const pg8::u32x4*)(xn + 128); }
                unsigned short* xh = (unsigned short*)XC + (size_t)r * D_ + col0;
#pragma unroll
                for (int bj = 0; bj < 2; ++bj) { const pg8::u32x4 q = qc[bj]; pg8::f32x4 s0, s1;
                    s0[0] = __uint_as_float(q.x << 16); s0[1] = __uint_as_float(q.x & 0xffff0000u); s0[2] = __uint_as_float(q.y << 16); s0[3] = __uint_as_float(q.y & 0xffff0000u);
                    s1[0] = __uint_as_float(q.z << 16); s1[1] = __uint_as_float(q.z & 0xffff0000u); s1[2] = __uint_as_float(q.w << 16); s1[3] = __uint_as_float(q.w & 0xffff0000u);
                    const pg8::f32x4 r0 = s0 + gg[bj][0] * acc[ai][bj][m][0], r1 = s1 + gg[bj][1] * acc[ai][bj][m][1]; pg8::u32x4 w;
                    w.x = pg8::cvt_pk_bf16(r0[0], r0[1]); w.y = pg8::cvt_pk_bf16(r0[2], r0[3]); w.z = pg8::cvt_pk_bf16(r1[0], r1[1]); w.w = pg8::cvt_pk_bf16(r1[2], r1[3]); *(pg8::u32x4*)(xh + bj * 128) = w; }
                qc[0] = qn[0]; qc[1] = qn[1];
                __builtin_amdgcn_sched_barrier(0); }
        }
    }
#endif
    __device__ __forceinline__ void elem(int m, int n, float v) const { XC[(size_t)m * D_ + n] = srow(m)[n] + gate[(size_t)tok_row(m) * D6 + n] * v; }
};
template <class Epi>
__device__ __forceinline__ void run_gemm(unsigned char* lds, const AT* A, const AT* Bt, int M, int N, int K, const Epi& E, int coff = 0) {
#ifdef CPU_EMU
    GSTRIDE(idx, (size_t)M * N) { int m = (int)(idx / N), n = (int)(idx % N); float acc = 0.f;
        for (int k = 0; k < K; ++k) acc += ldf(A + (size_t)m * K + k) * ldf(Bt + (size_t)n * K + k);
        E.elem(m, n, acc); }
#else
    pg8::Gemm g{(const pg8::bf16_t*)A, (const pg8::bf16_t*)Bt, M, N, K}; pg8::StaticOrder S; S.init(M, N, (int)gridDim.x, (int)((blockIdx.x + (unsigned)coff) % gridDim.x));
    pg8::gemm_phase<Epi, pg8::StaticOrder, PG8_ALIGN, PG8_SP2>((PG8_LAS unsigned char*)lds, g, S, E);
#endif
}

struct EpiStoreF32 {
    static constexpr bool PERM = false, AFTER_DRAIN = false; float* O; int ldc;
#ifndef CPU_EMU
    __device__ __forceinline__ void operator()(const pg8::f32x4 (&acc)[2][2][4][2], const pg8::Unit& u, int wr, int wc, int fr, int fq) const {
        const int row0 = u.pm * 256 + wr * 64 + fr, col0 = u.pn * 256 + wc * 32 + 4 * fq;
#pragma unroll
        for (int ai = 0; ai < 2; ++ai)
#pragma unroll
            for (int m = 0; m < 4; ++m) { float* rp = O + (size_t)(row0 + ai * 128 + m * 16) * ldc + col0;
#pragma unroll
                for (int bj = 0; bj < 2; ++bj)
#pragma unroll
                    for (int n = 0; n < 2; ++n) *(pg8::f32x4*)(rp + bj * 128 + n * 16) = acc[ai][bj][m][n]; }
    }
#endif
    __device__ __forceinline__ void elem(int m, int n, float v) const { O[(size_t)m * ldc + n] = v; }
};
#ifndef CPU_EMU
struct EpiStoreKey {
    static constexpr bool PERM = false, AFTER_DRAIN = false; float* O; int ldc;
    __device__ __forceinline__ void operator()(const pg8::f32x4 (&acc)[2][2][4][2], const pg8::Unit& u, int wr, int wc, int fr, int fq) const {
        const int tile0 = u.pm * 4 + wr, jq0 = wc * 8 + fq;
        const unsigned lb = 127u - (unsigned)(wc * 32 + 4 * fq);
#pragma unroll
        for (int ai = 0; ai < 2; ++ai)
#pragma unroll
            for (int m = 0; m < 4; ++m) { float* rp = O + ((size_t)(((tile0 + 2 * ai) * 8 + u.pn) * 64 + jq0) * 64 + (m * 16 + fr)) * 4;
#pragma unroll
                for (int bj = 0; bj < 2; ++bj)
#pragma unroll
                    for (int n = 0; n < 2; ++n) { const pg8::f32x4 a = acc[ai][bj][m][n]; pg8::u32x4 w; unsigned t;
                        t = __float_as_uint(a[0]); w.x = ((t ^ ((unsigned)((int)t >> 31) | 0x80000000u)) & ~127u) | (lb - (unsigned)(n * 16));
                        t = __float_as_uint(a[1]); w.y = ((t ^ ((unsigned)((int)t >> 31) | 0x80000000u)) & ~127u) | (lb - (unsigned)(n * 16 + 1));
                        t = __float_as_uint(a[2]); w.z = ((t ^ ((unsigned)((int)t >> 31) | 0x80000000u)) & ~127u) | (lb - (unsigned)(n * 16 + 2));
                        t = __float_as_uint(a[3]); w.w = ((t ^ ((unsigned)((int)t >> 31) | 0x80000000u)) & ~127u) | (lb - (unsigned)(n * 16 + 3));
                        *(pg8::u32x4*)(rp + (size_t)(bj * 32 + n * 4) * 256) = w; } }
    }
};
#endif
__device__ __forceinline__ void ph_wc(const float* Wq, const float* k1, const float* k2, AT* WcT) {
    GSTRIDE(idx, (size_t)2048 * D_) { const int gn = (int)(idx / D_), kin = (int)(idx % D_); const int g = gn >> 7, n = gn & 127, h = g >> 1, side = g & 1;
        const float* key = (side ? k2 : k1) + ((size_t)h * 128 + n) * 128; const float* wq = Wq + (size_t)kin * 2048 + g * 128;
        float acc = 0.f; for (int d = 0; d < 128; ++d) acc += key[d] * wq[d];
        stf(WcT + idx, acc); }
}
#ifdef CPU_EMU
typedef float TT;
__device__ __forceinline__ float e4m3_round(float x) { if (x == 0.f) return 0.f; float a = fabsf(x); if (a > 448.f) a = 448.f; int e; frexpf(a, &e); int ex = e - 1; if (ex < -6) ex = -6;
    const float q = ldexpf(1.f, ex - 3); float r = nearbyintf(a / q) * q; return x < 0.f ? -r : r; }
#else
typedef unsigned char TT;
#endif
__device__ __forceinline__ void ph_cvt_tab(const float* src, TT* dst, size_t n, float scale, int wg0 = 0, int nwg = 0) {
#ifdef CPU_EMU
    GSTRIDE(i, n) dst[i] = e4m3_round(src[i] * scale);
#else
    if (nwg == 0) nwg = (int)gridDim.x;
    GSTRIDE_SUB(i, n / 16, wg0, nwg) { const float* sp = src + i * 16; pg8::u32x4 w; unsigned ww[4];
#pragma unroll
        for (int j = 0; j < 4; ++j) { const pg8::f32x4 a = *(const pg8::f32x4*)(sp + 4 * j); int pk = 0;
            pk = __builtin_amdgcn_cvt_pk_fp8_f32(a[0] * scale, a[1] * scale, pk, false); pk = __builtin_amdgcn_cvt_pk_fp8_f32(a[2] * scale, a[3] * scale, pk, true); ww[j] = (unsigned)pk; }
        w.x = ww[0]; w.y = ww[1]; w.z = ww[2]; w.w = ww[3];
        *(pg8::u32x4*)(dst + i * 16) = w; }
#endif
}
struct EpiLora1 {
    static constexpr bool PERM = true, AFTER_DRAIN = false; AT* T1; AT* T2;
    __device__ __forceinline__ static float act(int n, float v) { return n < 128 ? ftanh(v) : (n < 256 ? v : (n < 416 ? fsig(v) : 0.f)); }
#ifndef CPU_EMU
    __device__ __forceinline__ void operator()(const pg8::f32x4 (&acc)[2][2][4][2], const pg8::Unit& u, int wr, int wc, int fr, int fq) const {
        const int row0 = u.pm * 256 + wr * 64 + fr, col0 = wc * 32 + 8 * fq; pg8::bf16_t* O = (pg8::bf16_t*)(u.pn == 0 ? T1 : T2);
#pragma unroll
        for (int ai = 0; ai < 2; ++ai)
#pragma unroll
            for (int m = 0; m < 4; ++m) { pg8::bf16_t* rowp = O + (size_t)(row0 + ai * 128 + m * 16) * 256 + col0;
#pragma unroll
                for (int bj = 0; bj < 2; ++bj) { const int n0 = u.pn * 256 + col0 + bj * 128; const pg8::f32x4 v0 = acc[ai][bj][m][0], v1 = acc[ai][bj][m][1]; pg8::u32x4 w;
                    w.x = pg8::cvt_pk_bf16(act(n0, v0[0]), act(n0 + 1, v0[1])); w.y = pg8::cvt_pk_bf16(act(n0 + 2, v0[2]), act(n0 + 3, v0[3]));
                    w.z = pg8::cvt_pk_bf16(act(n0 + 4, v1[0]), act(n0 + 5, v1[1])); w.w = pg8::cvt_pk_bf16(act(n0 + 6, v1[2]), act(n0 + 7, v1[3]));
                    *(pg8::u32x4*)(rowp + bj * 128) = w; } }
    }
#endif
    __device__ __forceinline__ void elem(int m, int n, float v) const { if (n < 256) stf(T1 + (size_t)m * 256 + n, act(n, v)); else stf(T2 + (size_t)m * 256 + n - 256, act(n, v)); }
};
__device__ __forceinline__ float decay_of(float lw) { return expf(-0.6065306597f * sigmoidf_(lw)); }
__device__ __forceinline__ void ph_wlora(const float* mu, const float* w1, const float* a1, const float* g1, const float* w2, const float* a2, const float* g2, AT* WL1, AT* WL2A, AT* WL2B, int wg0, int nwg) {
    GSTRIDE_SUB(idx, (size_t)512 * 2048, wg0, nwg) { const int j = (int)(idx >> 11), kk = (int)(idx & 2047), kin = kk & 1023; float w = 0.f, m_ = 0.f;
        if (j < 128) { const int z = j >> 6, c = j & 63; w = w1[((size_t)z * 1024 + kin) * 64 + c]; m_ = mu[1 * D_ + kin]; }
        else if (j < 256) { const int z = (j - 128) >> 6, c = (j - 128) & 63; w = a1[((size_t)z * 1024 + kin) * 64 + c]; m_ = mu[4 * D_ + kin]; }
        else if (j < 416) { w = g1[(size_t)kin * 160 + (j - 256)]; m_ = mu[5 * D_ + kin]; }
        stf(WL1 + idx, kk >= 1024 ? w * m_ : w); }
    GSTRIDE_SUB(idx, (size_t)4096 * 256, wg0, nwg) { const int n4 = (int)(idx >> 8), k = (int)(idx & 255); const int which = n4 >> 10, c = n4 & 1023, z = which & 1; float w = 0.f;
        const int kb = (which < 2 ? 0 : 128) + z * 64;
        if (k >= kb && k < kb + 64) w = (which < 2 ? w2 : a2)[((size_t)z * 64 + (k - kb)) * 1024 + c];
        stf(WL2A + idx, w); }
    GSTRIDE_SUB(idx, (size_t)1024 * 256, wg0, nwg) { const int c = (int)(idx >> 8), k = (int)(idx & 255); stf(WL2B + idx, k < 160 ? g2[(size_t)k * 1024 + c] : 0.f); }
}

__device__ __forceinline__ void cvt_tab16(const float* src, TT* dst, size_t i, float scale) {
#ifndef CPU_EMU
    const float* sp = src + i * 16; pg8::u32x4 w; unsigned ww[4];
#pragma unroll
    for (int j = 0; j < 4; ++j) { const pg8::f32x4 a = *(const pg8::f32x4*)(sp + 4 * j); int pk = 0;
        pk = __builtin_amdgcn_cvt_pk_fp8_f32(a[0] * scale, a[1] * scale, pk, false); pk = __builtin_amdgcn_cvt_pk_fp8_f32(a[2] * scale, a[3] * scale, pk, true); ww[j] = (unsigned)pk; }
    w.x = ww[0]; w.y = ww[1]; w.z = ww[2]; w.w = ww[3];
    *(pg8::u32x4*)(dst + i * 16) = w;
#endif
}

#ifndef CPU_EMU
__device__ __forceinline__ float wave_maxf(float v) {
#pragma unroll
    for (int o = 32; o > 0; o >>= 1) v = fmaxf(v, __shfl_xor(v, o));
    return v; }
__device__ __forceinline__ unsigned q8pack(float a, float b, float c, float d, float inv) {
    const unsigned ia = __float_as_uint(a * inv + 12582912.f), ib = __float_as_uint(b * inv + 12582912.f), ic = __float_as_uint(c * inv + 12582912.f), id = __float_as_uint(d * inv + 12582912.f);
    return (ia & 255u) | ((ib & 255u) << 8) | ((ic & 255u) << 16) | (id << 24); }
__device__ __forceinline__ void cvt_row_i8(const float* src, unsigned char* dst, float* usc, size_t row, int lane) {
    const float* sp = src + row * D_ + 16 * lane; pg8::f32x4 a[4]; float mx = 0.f;
#pragma unroll
    for (int j = 0; j < 4; ++j) { a[j] = *(const pg8::f32x4*)(sp + 4 * j); mx = fmaxf(mx, fmaxf(fmaxf(fabsf(a[j][0]), fabsf(a[j][1])), fmaxf(fabsf(a[j][2]), fabsf(a[j][3])))); }
    mx = wave_maxf(mx); const float inv = mx > 0.f ? 127.f / mx : 0.f; pg8::u32x4 w;
    w.x = q8pack(a[0][0], a[0][1], a[0][2], a[0][3], inv); w.y = q8pack(a[1][0], a[1][1], a[1][2], a[1][3], inv); w.z = q8pack(a[2][0], a[2][1], a[2][2], a[2][3], inv); w.w = q8pack(a[3][0], a[3][1], a[3][2], a[3][3], inv);
    *(pg8::u32x4*)(dst + row * D_ + 16 * lane) = w; if (lane == 0) usc[row] = mx * (1.f / 127.f); }
__device__ __forceinline__ void ph_cvt_tab_i8(const float* src, unsigned char* dst, float* usc, int wg0 = 0, int nwg = 0) {
    if (nwg == 0) nwg = (int)gridDim.x;
    const int tn_ = (int)tid_now(), lane = tn_ & 63, gw = ((int)blockIdx.x - wg0) * 8 + (tn_ >> 6), nw = nwg * 8;
    for (int row = gw; row < 16384; row += nw) cvt_row_i8(src, dst, usc, (size_t)row, lane); }
#endif
__device__ __forceinline__ void ph_wprep(const float* W, int K, int N, int Npad, AT* WT) {
    GSTRIDE(idx, (size_t)Npad * K) { int n = (int)(idx / K), k = (int)(idx % K); stf(WT + idx, n < N ? W[(size_t)k * N + n] : 0.f); }
}
__device__ __forceinline__ void ph_xs(const AT* H, const float* mu, AT* XS, AT* HX) {
    GSTRIDE(idx, (size_t)NTOK * D_) { int m = (int)(idx / D_), k = (int)(idx % D_);
        TokInfo ti = tokinfo(m); float cur = ldf(H + idx);
        float prev = ti.pos > 0 ? ldf(H + idx - D_) : 0.f, nxt = ti.pos < ti.len - 1 ? ldf(H + idx + D_) : 0.f;
        float xx = 0.5f * (prev + nxt) - cur;
        stf(HX + (size_t)m * 2048 + k, cur); stf(HX + (size_t)m * 2048 + 1024 + k, xx);
        stf(XS + idx, cur + xx * mu[0 * D_ + k]); stf(XS + (ROWB / SA) + idx, cur + xx * mu[2 * D_ + k]); stf(XS + 2 * (ROWB / SA) + idx, cur + xx * mu[3 * D_ + k]); }
}

__device__ __forceinline__ void ph_adaln(const float* c, const float* c_ctx, const float* ada_w, const float* ada_b, float* MOD) {
    GSTRIDE(i_, 2 * (B_ + 1) * D6) { int idx = (int)i_;
        int col = idx % D6, row = (idx / D6) % (B_ + 1), layer = idx / (D6 * (B_ + 1));
        const float* cv = row < B_ ? c + row * D_ : c_ctx;
        const float* w = ada_w + (size_t)layer * D_ * D6;
        float acc = ada_b[layer * D6 + col];
        for (int k = 0; k < D_; ++k) { float x = cv[k]; acc += x * sigmoidf_(x) * w[(size_t)k * D6 + col]; }
        MOD[idx] = acc; }
}
__device__ __forceinline__ void ph_init_xc(const float* x, const float* ctx, float* XC) {
    GSTRIDE(idx, (size_t)NTOK * D_) XC[idx] = idx < (size_t)NLAT * D_ ? x[idx] : ctx[idx - (size_t)NLAT * D_];
}
__device__ __forceinline__ void ph_modnorm(float* lds, int ntok, const float* XC, const float* g, const float* MODL, int ishift, int iscale, AT* out, float* fout, const float* xsrc = nullptr, const float* csrc = nullptr) {
    const int half = threadIdx.x >> 8, tid = threadIdx.x & 255; float* red = lds + half * 256;
    const int stride = gridDim.x * 2, iters = (ntok + stride - 1) / stride;
    for (int it = 0; it < iters; ++it) {
        const int m = it * stride + blockIdx.x * 2 + half; const bool act = m < ntok;
        float v[4] = {0.f, 0.f, 0.f, 0.f}, ss = 0.f;
        if (act) { const float* xr = xsrc ? (m < NLAT ? xsrc + (size_t)m * D_ : csrc + (size_t)(m - NLAT) * D_) : XC + (size_t)m * D_;
#pragma unroll
            for (int i = 0; i < 4; ++i) { v[i] = xr[tid + 256 * i]; ss += v[i] * v[i]; } }
        __syncthreads();
        red[tid] = ss; __syncthreads();
        float tot = 0.f; for (int i = 0; i < 256; ++i) tot += red[i];
        float rs = rsqrtf(tot / D_ + 1e-6f);
        if (act) {
            if (fout) {
#pragma unroll
                for (int i = 0; i < 4; ++i) { int d = tid + 256 * i; fout[(size_t)m * D_ + d] = v[i] * rs * g[d]; }
            } else { const float* mr = MODL + (size_t)tok_row(m) * D6;
#pragma unroll
                for (int i = 0; i < 4; ++i) { int d = tid + 256 * i; float y = v[i] * rs * g[d] * (1.f + mr[iscale * D_ + d]) + mr[ishift * D_ + d]; stf(out + (size_t)m * D_ + d, y); } }
        }
    }
}

struct ALPlain { const AT* p; int lda; __device__ __forceinline__ float operator()(int m, int k) const { return ldf(p + (size_t)m * lda + k); } };
struct ALMix { const AT* h; const float* mu;
    __device__ __forceinline__ float operator()(int m, int k) const {
        TokInfo ti = tokinfo(m); float cur = ldf(h + (size_t)m * D_ + k);
        float prev = ti.pos > 0 ? ldf(h + (size_t)(m - 1) * D_ + k) : 0.f;
        float nxt = ti.pos < ti.len - 1 ? ldf(h + (size_t)(m + 1) * D_ + k) : 0.f;
        return cur + (0.5f * (prev + nxt) - cur) * mu[k]; } };
struct EPStore { AT* o; int ldo; int act;
    __device__ __forceinline__ void operator()(int m, int n, float a) const { if (act == 1) a = tanhf(a); if (act == 2) a = sigmoidf_(a); stf(o + (size_t)m * ldo + n, a); } };
struct EPResid { float* XC; const float* MODL; int igate;
    __device__ __forceinline__ void operator()(int m, int n, float a) const { XC[(size_t)m * D_ + n] += MODL[(size_t)tok_row(m) * D6 + igate * D_ + n] * a; } };
struct EPDecay { DT* o; const float* w0z; int z;
    __device__ __forceinline__ void operator()(int m, int n, float a) const { float lw = w0z[n] + a; o[((size_t)m * 2 + z) * D_ + n] = (DT)expf(-0.6065306597f * sigmoidf_(lw)); } };
struct EPAgate { AT* o; const float* a0z; int z;
    __device__ __forceinline__ void operator()(int m, int n, float a) const { stf(o + ((size_t)m * 2 + z) * D_ + n, sigmoidf_(a0z[n] + a)); } };

template <class AL, class EP>
__device__ __forceinline__ void ph_gemm(int M, int N, int K, AL al, const float* Bm, int ldb, EP ep) {
    const int n4 = N / 4;
    GSTRIDE(idx, (size_t)(M / 4) * n4) {
        int m0 = (int)(idx / n4) * 4, n0 = (int)(idx % n4) * 4;
        float acc[4][4];
#pragma unroll
        for (int i = 0; i < 4; ++i)
#pragma unroll
            for (int j = 0; j < 4; ++j) acc[i][j] = 0.f;
        for (int k = 0; k < K; ++k) {
            float a[4], b[4];
#pragma unroll
            for (int i = 0; i < 4; ++i) a[i] = al(m0 + i, k);
#pragma unroll
            for (int j = 0; j < 4; ++j) b[j] = Bm[(size_t)k * ldb + n0 + j];
#pragma unroll
            for (int i = 0; i < 4; ++i)
#pragma unroll
                for (int j = 0; j < 4; ++j) acc[i][j] += a[i] * b[j];
        }
#pragma unroll
        for (int i = 0; i < 4; ++i)
#pragma unroll
            for (int j = 0; j < 4; ++j) ep(m0 + i, n0 + j, acc[i][j]);
    }
}

__device__ __forceinline__ void ph_rope(AT* PROJ) {
    GSTRIDE(idx, (size_t)NLAT * 320) {
        int f = idx % 32, hd = (idx / 32) % 10; int m = (int)(idx / 320);
        int t = m % T_; int axis = f / 16, fr = f % 16;
        float pos = axis == 0 ? (float)(t / 64) : (float)(t % 64);
        float inv = expf(-(float)fr * (9.210340371976184f / 16.f));
        float ang = pos * inv, cs = cosf(ang), sn = sinf(ang);
        AT* p = PROJ + (size_t)m * PROJW + (hd < 8 ? C_SQ + hd * 64 : C_SK + (hd - 8) * 64) + axis * 32 + fr;
        float a = ldf(p), b = ldf(p + 16);
        stf(p, a * cs - b * sn); stf(p + 16, b * cs + a * sn); }
}
__device__ __forceinline__ void ph_gla_loga(const AT* PROJ, const float* dec_w2, const float* dec_b, float* LOGA) {
    GSTRIDE(idx, (size_t)NTOK * 512) {
        int e = idx % 256, z = (idx / 256) % 2; int m = (int)(idx / 512);
        float acc = dec_b[z * 256 + e];
        for (int r = 0; r < 16; ++r) acc += ldf(PROJ + (size_t)m * PROJW + C_LR + z * 16 + r) * dec_w2[(z * 16 + r) * 256 + e];
        float ls = fminf(acc, 0.f) - log1pf(expf(-fabsf(acc)));
        LOGA[idx] = ls * (1.f / 16.f); }
}
__device__ __forceinline__ int scan_token(int b, int z, int step) {
    if (step < L_) { int p = z == 0 ? step : L_ - 1 - step; return NLAT + b * L_ + p; }
    int s2 = step - L_; int p = z == 0 ? s2 : T_ - 1 - s2; return b * T_ + p;
}
constexpr int GLA_THREADS = B_ * 4 * 2 * 128;
__device__ __forceinline__ void ph_gla_scan(const AT* PROJ, const float* LOGA, float* GLAO) {
    GSTRIDE(i_, GLA_THREADS) { int idx = (int)i_;
        int vv = idx % 128, z = (idx / 128) % 2, h = (idx / 256) % 4, b = idx / 1024;
        float S[64];
#pragma unroll
        for (int d = 0; d < 64; ++d) S[d] = 0.f;
        for (int step = 0; step < L_ + T_; ++step) {
            int m = scan_token(b, z, step);
            const AT* pr = PROJ + (size_t)m * PROJW; const float* la = LOGA + ((size_t)m * 2 + z) * 256 + h * 64;
            float vval = ldf(pr + C_GV + h * 128 + vv), o = 0.f;
#pragma unroll
            for (int d = 0; d < 64; ++d) {
                float a = expf(la[d]); float q = ldf(pr + C_GQ + h * 64 + d) * 0.125f, k = ldf(pr + C_GK + h * 64 + d);
                float s = S[d] * a; if (z == 1) o += q * s; s += k * vval; if (z == 0) o += q * s; S[d] = s;
            }
            GLAO[((size_t)z * NTOK + m) * 512 + h * 128 + vv] = o;
        } }
}
__device__ __forceinline__ void ph_gla_out(const AT* PROJ, const float* GLAO, const float* gn, AT* MIX) {
    GSTRIDE(i_, NTOK * 4) { int idx = (int)i_;
        int h = idx % 4, m = idx / 4;
        const float* o0 = GLAO + (size_t)m * 512 + h * 128; const float* o1 = GLAO + ((size_t)NTOK + m) * 512 + h * 128;
        float ss = 0.f; for (int v = 0; v < 128; ++v) { float o = o0[v] + o1[v]; ss += o * o; }
        float rs = rsqrtf(ss / 128.f + 1e-6f);
        for (int v = 0; v < 128; ++v) { float o = o0[v] + o1[v]; float gt = ldf(PROJ + (size_t)m * PROJW + C_GG + h * 128 + v);
            stf(MIX + (size_t)m * D_ + h * 128 + v, o * rs * gn[h * 128 + v] * gt * sigmoidf_(gt)); } }
}
__device__ __forceinline__ void ph_swa(const AT* PROJ, const float* sink, AT* MIX, int skip) {
    const size_t gt = (size_t)blockIdx.x * NT + threadIdx.x, gs = (size_t)gridDim.x * NT;
    if (gt < (size_t)skip) return;
    for (size_t i_ = gt - skip; i_ < (size_t)NTOK * 8; i_ += gs - skip) { int idx = (int)i_;
        int hq = idx % 8, m = idx / 8, g = hq / 4;
        TokInfo ti = tokinfo(m);
        float q[64], acc[64];
#pragma unroll
        for (int d = 0; d < 64; ++d) { q[d] = ldf(PROJ + (size_t)m * PROJW + C_SQ + hq * 64 + d) * 0.125f; acc[d] = 0.f; }
        float mx = sink[hq], l = 1.f;
        int nloc = 0, j0 = 0;
        if (m < NLAT) { j0 = ti.pos - 128 < 0 ? 0 : ti.pos - 128; int j1 = ti.pos + 128 > T_ - 1 ? T_ - 1 : ti.pos + 128; nloc = j1 - j0 + 1; }
        for (int jj = 0; jj < nloc + L_; ++jj) {
            int row = jj < nloc ? ti.b * T_ + j0 + jj : NLAT + ti.b * L_ + (jj - nloc);
            const AT* kp = PROJ + (size_t)row * PROJW + C_SK + g * 64; const AT* vp = PROJ + (size_t)row * PROJW + C_SV + g * 64;
            float s = 0.f;
#pragma unroll
            for (int d = 0; d < 64; ++d) s += q[d] * ldf(kp + d);
            if (s > mx) { float sc = expf(mx - s); l *= sc;
#pragma unroll
                for (int d = 0; d < 64; ++d) acc[d] *= sc;
                mx = s; }
            float p = expf(s - mx); l += p;
#pragma unroll
            for (int d = 0; d < 64; ++d) acc[d] += p * ldf(vp + d);
        }
        float il = 1.f / l;
#pragma unroll
        for (int d = 0; d < 64; ++d) stf(MIX + (size_t)m * D_ + 512 + hq * 64 + d, acc[d] * il); }
}

constexpr int PT_WORDS = 4864;
__device__ __forceinline__ void ph_peer_topk(float* lds, int ntok, const float* SC, int* PIDX, float* PGATE) {
    const int half = threadIdx.x >> 8, tid = threadIdx.x & 255; float* base = lds + half * PT_WORDS;
    float (*sc)[128] = (float (*)[128])base; float (*tv)[16] = (float (*)[16])(base + 2048); int (*ti)[16] = (int (*)[16])(base + 2304);
    float (*cv)[256] = (float (*)[256])(base + 2560); float (*ss)[16] = (float (*)[16])(base + 4608); int (*si)[16] = (int (*)[16])(base + 4736);
    const int stride = gridDim.x * 2, iters = (ntok + stride - 1) / stride;
    for (int it = 0; it < iters; ++it) {
        const int m = it * stride + blockIdx.x * 2 + half; const bool act = m < ntok;
        __syncthreads();
        if (act) for (int i = 0; i < 8; ++i) { int e = tid + 256 * i; sc[e / 128][e % 128] = SC[(size_t)m * 2048 + e]; }
        __syncthreads();
        if (act) for (int i = 0; i < 8; ++i) { int e = tid + 256 * i; int list = e / 128, n = e % 128; float s = sc[list][n]; int r = 0;
            for (int j = 0; j < 128; ++j) { float o = sc[list][j]; r += (o > s || (o == s && j < n)) ? 1 : 0; }
            if (r < 16) { tv[list][r] = s; ti[list][r] = n; } }
        __syncthreads();
        if (act) for (int i = 0; i < 8; ++i) { int e = tid + 256 * i; int h = e / 256, c = e % 256; cv[h][c] = tv[2 * h][c / 16] + tv[2 * h + 1][c % 16]; }
        __syncthreads();
        if (act) for (int i = 0; i < 8; ++i) { int e = tid + 256 * i; int h = e / 256, c = e % 256; float s = cv[h][c]; int r = 0;
            for (int j = 0; j < 256; ++j) { float o = cv[h][j]; r += (o > s || (o == s && j < c)) ? 1 : 0; }
            if (r < 16) { ss[h][r] = s; si[h][r] = ti[2 * h][c / 16] * 128 + ti[2 * h + 1][c % 16]; } }
        __syncthreads();
        if (act && tid < 128) { int h = tid / 16, r = tid % 16; float mx = ss[h][0], sum = 0.f;
            for (int j = 0; j < 16; ++j) sum += expf(ss[h][j] - mx);
            PIDX[(size_t)m * 128 + tid] = si[h][r]; PGATE[(size_t)m * 128 + tid] = expf(ss[h][r] - mx) / sum; }
    }
}
constexpr int PA_WORDS = 1536;
__device__ __forceinline__ void ph_peer_apply(float* lds, int ntok, const AT* F, const int* PIDX, const float* PGATE, const float* U, const float* V, const float* MODL, float* XC) {
    const int half = threadIdx.x >> 8, tid = threadIdx.x & 255; float* base = lds + half * PA_WORDS;
    float* tvec = base; float* part = base + 1024; float* coef = base + 1280; int* eid = (int*)(base + 1408);
    const int stride = gridDim.x * 2, iters = (ntok + stride - 1) / stride;
    for (int it = 0; it < iters; ++it) {
        const int m = it * stride + blockIdx.x * 2 + half; const bool act = m < ntok;
        __syncthreads();
        if (act) { for (int i = 0; i < 4; ++i) tvec[tid + 256 * i] = ldf(F + (size_t)m * D_ + tid + 256 * i);
            if (tid < 128) eid[tid] = PIDX[(size_t)m * 128 + tid]; }
        __syncthreads();
        if (act) { int e = tid / 2, hf = tid % 2; const float* ur = U + (size_t)eid[e] * D_ + hf * 512; float s = 0.f;
            for (int d = 0; d < 512; ++d) s += ur[d] * (1.f / 32.f) * tvec[hf * 512 + d];
            part[tid] = s; }
        __syncthreads();
        if (act && tid < 128) { float a = part[2 * tid] + part[2 * tid + 1]; coef[tid] = PGATE[(size_t)m * 128 + tid] * 0.5f * a * (1.f + erff(a * 0.70710678118f)); }
        __syncthreads();
        if (act) { const float* mr = MODL + (size_t)tok_row(m) * D6 + 5 * D_;
            for (int i = 0; i < 4; ++i) { int col = tid + 256 * i; float acc = 0.f;
                for (int e = 0; e < 128; ++e) acc += coef[e] * V[(size_t)eid[e] * D_ + col];
                XC[(size_t)m * D_ + col] += mr[col] * acc; } }
    }
}

__device__ __forceinline__ void ph_rw_kk(const AT* K, const float* k_k, AT* KK) {
    GSTRIDE(i_, NTOK * 16) { int idx = (int)i_;
        int h = idx % 16, m = idx / 16; float ss = 0.f;
        for (int n = 0; n < 64; ++n) { float x = ldf(K + (size_t)m * D_ + h * 64 + n) * k_k[h * 64 + n]; ss += x * x; }
        float rs = rsqrtf(fmaxf(ss, 1e-24f));
        for (int n = 0; n < 64; ++n) stf(KK + (size_t)m * D_ + h * 64 + n, ldf(K + (size_t)m * D_ + h * 64 + n) * k_k[h * 64 + n] * rs); }
}
__device__ __forceinline__ void ph_rw_scan(const AT* R, const AT* K, const AT* V, const AT* KK, const AT* A, const AT* DEC, const float* w0, const float* a0, const float* k_a, AT* Y0, AT* Y1) {
    GSTRIDE(i_, B_ * 16 * 2 * 64) { int idx = (int)i_;
        int vv = idx % 64, z = (idx / 64) % 2, h = (idx / 128) % 16, b = idx / 2048;
        float S[64];
#pragma unroll
        for (int d = 0; d < 64; ++d) S[d] = 0.f;
        AT* Y = z == 0 ? Y0 : Y1;
        for (int step = 0; step < L_ + T_; ++step) {
            int m = scan_token(b, z, step);
            size_t o1 = (size_t)m * D_ + h * 64, o2 = ((size_t)m * 2 + z) * D_ + h * 64;
            float sa = 0.f;
#pragma unroll
            for (int d = 0; d < 64; ++d) sa += S[d] * ldf(KK + o1 + d);
            float vval = ldf(V + o1 + vv), y = 0.f;
            bool lat = m < NLAT;
#pragma unroll
            for (int d = 0; d < 64; ++d) {
                float w = decay_of(ldf(DEC + o2 + d) + w0[z * D_ + h * 64 + d]), a = sigmoidf_(ldf(A + o2 + d) + a0[z * D_ + h * 64 + d]), k = ldf(K + o1 + d), kk = ldf(KK + o1 + d);
                float kd = k * (1.f + (a - 1.f) * k_a[h * 64 + d]);
                float s = S[d] * w - sa * (kk * a) + vval * kd; S[d] = s;
                if (lat) y += s * ldf(R + o1 + d);
            }
            if (lat) stf(Y + o1 + vv, y);
        } }
}

#ifndef CPU_EMU
typedef float f4_t __attribute__((ext_vector_type(4)));
typedef float f2_t __attribute__((ext_vector_type(2)));
typedef unsigned u2_t __attribute__((ext_vector_type(2)));
typedef _Float16 h4_t __attribute__((ext_vector_type(4)));
#define DPP_ADD(v, ctrl) v += __int_as_float(__builtin_amdgcn_update_dpp(0, __float_as_int(v), ctrl, 0xF, 0xF, true))
__device__ __forceinline__ float allsum16(float v) {
    DPP_ADD(v, 0xB1); DPP_ADD(v, 0x4E); DPP_ADD(v, 0x141); DPP_ADD(v, 0x140); return v; }
__device__ __forceinline__ f4_t bf4(u2_t u) { f4_t r; r.x = __uint_as_float(u.x << 16); r.y = __uint_as_float(u.x & 0xffff0000u); r.z = __uint_as_float(u.y << 16); r.w = __uint_as_float(u.y & 0xffff0000u); return r; }
__device__ __forceinline__ unsigned short f2bf_bits(float f) { unsigned u = __float_as_uint(f); return (unsigned short)((u + 0x7fffu + ((u >> 16) & 1u)) >> 16); }

constexpr int RTS = 32;
__device__ __forceinline__ void ph_rw_scan2(unsigned char* lds, const AT* R, const AT* K, const AT* V, const float* k_k, const AT* A, const AT* DEC, const float* w0, const float* a0, const float* k_a, AT* Y0, AT* Y1) {
    float* buf = (float*)lds;
    float* yb = buf + 2 * 6 * RTS * 64;
    const int tid = (int)tid_now(), w = tid >> 6, l = tid & 63, rp = l >> 4, kc = l & 15;
    const int v0 = w * 8 + rp * 2, k0 = kc * 4;
    const int ss = tid >> 4, kq = tid & 15;
    constexpr int NCH = (L_ + T_) / RTS;
    for (int sc = blockIdx.x; sc < B_ * 32; sc += gridDim.x) {
        const int z = sc & 1, h = (sc >> 1) & 15, b = sc >> 5;
        AT* Y = z == 0 ? Y0 : Y1;
        const f4_t ka4 = *(const f4_t*)(k_a + h * 64 + kq * 4), w04 = *(const f4_t*)(w0 + z * D_ + h * 64 + kq * 4), a04 = *(const f4_t*)(a0 + z * D_ + h * 64 + kq * 4), kk4c = *(const f4_t*)(k_k + h * 64 + kq * 4);
        f4_t S0 = {0.f, 0.f, 0.f, 0.f}, S1 = {0.f, 0.f, 0.f, 0.f};
        u2_t gk, gv, gr, gd, ga;
#define RW_LOAD(c) do { const int m_ = scan_token(b, z, (c) * RTS + ss); const size_t o1_ = (size_t)m_ * D_ + h * 64 + kq * 4, o2_ = ((size_t)m_ * 2 + z) * D_ + h * 64 + kq * 4; \
        gk = *(const u2_t*)(K + o1_); gv = *(const u2_t*)(V + o1_); ga = *(const u2_t*)(A + o2_); gd = *(const u2_t*)(DEC + o2_); \
        if (m_ < NLAT) gr = *(const u2_t*)(R + o1_); else { gr.x = 0u; gr.y = 0u; } } while (0)
#define RW_STORE(bi) do { float* q_ = buf + (bi) * 6 * RTS * 64 + ss * 64 + kq * 4; const f4_t k_ = bf4(gk), ar_ = bf4(ga) + a04, wr_ = bf4(gd) + w04; f4_t a_, w_, kk_ = k_ * kk4c; \
        kk_ = kk_ * rsqrtf(fmaxf(allsum16(kk_.x * kk_.x + kk_.y * kk_.y + kk_.z * kk_.z + kk_.w * kk_.w), 1e-24f)); \
        a_.x = fsig(ar_.x); a_.y = fsig(ar_.y); a_.z = fsig(ar_.z); a_.w = fsig(ar_.w); \
        w_.x = __expf(-0.6065306597f * fsig(wr_.x)); w_.y = __expf(-0.6065306597f * fsig(wr_.y)); w_.z = __expf(-0.6065306597f * fsig(wr_.z)); w_.w = __expf(-0.6065306597f * fsig(wr_.w)); \
        *(f4_t*)(q_) = w_; *(f4_t*)(q_ + RTS * 64) = kk_ * a_; *(f4_t*)(q_ + 2 * RTS * 64) = k_ * (1.f + (a_ - 1.f) * ka4); *(f4_t*)(q_ + 3 * RTS * 64) = kk_; \
        *(f4_t*)(q_ + 4 * RTS * 64) = bf4(gr); *(f4_t*)(q_ + 5 * RTS * 64) = bf4(gv); } while (0)
        RW_LOAD(0); RW_STORE(0); __syncthreads();
        for (int c = 0; c < NCH; ++c) {
            if (c + 1 < NCH) RW_LOAD(c + 1);
            const float* bb = buf + (c & 1) * 6 * RTS * 64; float* yo = yb + (c & 1) * RTS * 64;
            f4_t w4 = *(const f4_t*)(bb + k0), kka4 = *(const f4_t*)(bb + RTS * 64 + k0), kd4 = *(const f4_t*)(bb + 2 * RTS * 64 + k0);
            f4_t kk4 = *(const f4_t*)(bb + 3 * RTS * 64 + k0), r4 = *(const f4_t*)(bb + 4 * RTS * 64 + k0);
            f2_t vv = *(const f2_t*)(bb + 5 * RTS * 64 + v0);
            f4_t rp = r4;
#pragma unroll 4
            for (int s = 0; s < RTS; ++s) {
                const int sn = (s + 1 < RTS ? s + 1 : s) * 64;
                const f4_t nw4 = *(const f4_t*)(bb + sn + k0), nkka4 = *(const f4_t*)(bb + RTS * 64 + sn + k0), nkd4 = *(const f4_t*)(bb + 2 * RTS * 64 + sn + k0);
                const f4_t nkk4 = *(const f4_t*)(bb + 3 * RTS * 64 + sn + k0), nr4 = *(const f4_t*)(bb + 4 * RTS * 64 + sn + k0);
                const f2_t nvv = *(const f2_t*)(bb + 5 * RTS * 64 + sn + v0);
                float sa0 = S0.x * kk4.x + S0.y * kk4.y + S0.z * kk4.z + S0.w * kk4.w;
                float sa1 = S1.x * kk4.x + S1.y * kk4.y + S1.z * kk4.z + S1.w * kk4.w;
                float y0 = S0.x * rp.x + S0.y * rp.y + S0.z * rp.z + S0.w * rp.w;
                float y1 = S1.x * rp.x + S1.y * rp.y + S1.z * rp.z + S1.w * rp.w;
                sa0 = allsum16(sa0); sa1 = allsum16(sa1); y0 = allsum16(y0); y1 = allsum16(y1);
                if (kc == 0 && s > 0) { f2_t yy; yy.x = y0; yy.y = y1; *(f2_t*)(yo + (s - 1) * 64 + v0) = yy; }
                S0 = S0 * w4 - sa0 * kka4 + vv.x * kd4;
                S1 = S1 * w4 - sa1 * kka4 + vv.y * kd4;
                rp = r4;
                w4 = nw4; kka4 = nkka4; kd4 = nkd4; kk4 = nkk4; r4 = nr4; vv = nvv;
            }
            { float y0 = S0.x * rp.x + S0.y * rp.y + S0.z * rp.z + S0.w * rp.w, y1 = S1.x * rp.x + S1.y * rp.y + S1.z * rp.z + S1.w * rp.w;
              y0 = allsum16(y0); y1 = allsum16(y1);
              if (kc == 0) { f2_t yy; yy.x = y0; yy.y = y1; *(f2_t*)(yo + (RTS - 1) * 64 + v0) = yy; } }
            if (c + 1 < NCH) RW_STORE((c + 1) & 1);
            __syncthreads();
            if (c * RTS >= L_) {
#pragma unroll
                for (int i = 0; i < 4; ++i) { const int e = tid + 512 * i, s = e >> 6, vx = e & 63; const int m = scan_token(b, z, c * RTS + s);
                    stf(Y + (size_t)m * D_ + h * 64 + vx, yo[s * 64 + vx]); }
            }
        }
        __syncthreads();
#undef RW_LOAD
#undef RW_STORE
    }
}

constexpr int GTS = 32;
__device__ __forceinline__ void ph_gla_scan2(unsigned char* lds, const AT* PROJ, const float* dec_w2, const float* dec_b, float* GLAO) {
    float* buf = (float*)lds;
    constexpr int BSZ = 3 * GTS * 64 + GTS * 32;
    float* ob = buf + 2 * BSZ;
    float* w2s = ob + 2 * GTS * 32;
    const int tid = (int)tid_now(), col = tid >> 4, dc = tid & 15, d0 = dc * 4;
    const int ss = tid >> 4, dq = tid & 15;
    constexpr int NCH = (L_ + T_) / GTS;
    for (int it = blockIdx.x; it < B_ * 32; it += gridDim.x) {
        const int vq = it & 3, z = (it >> 2) & 1, h = (it >> 3) & 3, b = it >> 5;
        __syncthreads();
        for (int i = tid; i < 16 * 64; i += NT) w2s[i] = dec_w2[(z * 16 + (i >> 6)) * 256 + h * 64 + (i & 63)];
        const f4_t db4 = *(const f4_t*)(dec_b + z * 256 + h * 64 + dq * 4);
        __syncthreads();
        f4_t S = {0.f, 0.f, 0.f, 0.f};
        u2_t gq, gk, gv; pg8::u32x4 glr0, glr1;
#define GL_LOAD(c) do { const int m_ = scan_token(b, z, (c) * GTS + ss); const AT* pr_ = PROJ + (size_t)m_ * PROJW; \
        gq = *(const u2_t*)(pr_ + C_GQ + h * 64 + dq * 4); gk = *(const u2_t*)(pr_ + C_GK + h * 64 + dq * 4); \
        glr0 = *(const pg8::u32x4*)(pr_ + C_LR + z * 16); glr1 = *(const pg8::u32x4*)(pr_ + C_LR + z * 16 + 8); \
        if (dq < 8) gv = *(const u2_t*)(pr_ + C_GV + h * 128 + vq * 32 + dq * 4); } while (0)
#define GL_STORE(bi) do { float* q_ = buf + (bi) * BSZ + ss * 64 + dq * 4; f4_t x_ = db4; \
        const unsigned lr_[8] = {glr0.x, glr0.y, glr0.z, glr0.w, glr1.x, glr1.y, glr1.z, glr1.w}; \
        _Pragma("unroll") for (int r_ = 0; r_ < 8; ++r_) { const float l0_ = __uint_as_float(lr_[r_] << 16), l1_ = __uint_as_float(lr_[r_] & 0xffff0000u); \
            x_ += l0_ * *(const f4_t*)(w2s + (2 * r_) * 64 + dq * 4); x_ += l1_ * *(const f4_t*)(w2s + (2 * r_ + 1) * 64 + dq * 4); } \
        f4_t a_; a_.x = expf((fminf(x_.x, 0.f) - log1pf(expf(-fabsf(x_.x)))) * 0.0625f); a_.y = expf((fminf(x_.y, 0.f) - log1pf(expf(-fabsf(x_.y)))) * 0.0625f); \
        a_.z = expf((fminf(x_.z, 0.f) - log1pf(expf(-fabsf(x_.z)))) * 0.0625f); a_.w = expf((fminf(x_.w, 0.f) - log1pf(expf(-fabsf(x_.w)))) * 0.0625f); \
        *(f4_t*)(q_) = a_; *(f4_t*)(q_ + GTS * 64) = bf4(gq) * 0.125f; *(f4_t*)(q_ + 2 * GTS * 64) = bf4(gk); \
        if (dq < 8) *(f4_t*)(buf + (bi) * BSZ + 3 * GTS * 64 + ss * 32 + dq * 4) = bf4(gv); } while (0)
        GL_LOAD(0); GL_STORE(0); __syncthreads();
        for (int c = 0; c < NCH; ++c) {
            if (c + 1 < NCH) GL_LOAD(c + 1);
            const float* bb = buf + (c & 1) * BSZ; float* oo = ob + (c & 1) * GTS * 32;
            f4_t a4 = *(const f4_t*)(bb + d0), q4 = *(const f4_t*)(bb + GTS * 64 + d0), k4 = *(const f4_t*)(bb + 2 * GTS * 64 + d0); float vv = bb[3 * GTS * 64 + col];
#define GL_STEPS(INCL) _Pragma("unroll 8") for (int s = 0; s < GTS; ++s) { const int sn = s + 1 < GTS ? s + 1 : s; \
                const f4_t na4 = *(const f4_t*)(bb + sn * 64 + d0), nq4 = *(const f4_t*)(bb + GTS * 64 + sn * 64 + d0), nk4 = *(const f4_t*)(bb + 2 * GTS * 64 + sn * 64 + d0); \
                const float nvv = bb[3 * GTS * 64 + sn * 32 + col]; float o; \
                if (INCL) { S = S * a4 + k4 * vv; o = S.x * q4.x + S.y * q4.y + S.z * q4.z + S.w * q4.w; } \
                else { S = S * a4; o = S.x * q4.x + S.y * q4.y + S.z * q4.z + S.w * q4.w; S = S + k4 * vv; } \
                o = allsum16(o); if (dc == 0) oo[s * 32 + col] = o; \
                a4 = na4; q4 = nq4; k4 = nk4; vv = nvv; }
            if (z == 0) { GL_STEPS(true) } else { GL_STEPS(false) }
#undef GL_STEPS
            if (c + 1 < NCH) GL_STORE((c + 1) & 1);
            __syncthreads();
#pragma unroll
            for (int i = 0; i < 2; ++i) { const int e = tid + 512 * i, s = e >> 5, vx = e & 31; const int m = scan_token(b, z, c * GTS + s);
                GLAO[((size_t)z * NTOK + m) * 512 + h * 128 + vq * 32 + vx] = oo[s * 32 + vx]; }
        }
        __syncthreads();
#undef GL_LOAD
#undef GL_STORE
    }
}

typedef __bf16 bf16x2_t __attribute__((ext_vector_type(2)));
__device__ __forceinline__ float dot2bf(unsigned a, unsigned b, float acc) { return __builtin_amdgcn_fdot2_f32_bf16(__builtin_bit_cast(bf16x2_t, a), __builtin_bit_cast(bf16x2_t, b), acc, false); }
__device__ __forceinline__ float wave_total(float v) {
    v = allsum16(v);
    v += __int_as_float(__builtin_amdgcn_update_dpp(0, __float_as_int(v), 0x142, 0xA, 0xF, false));
    v += __int_as_float(__builtin_amdgcn_update_dpp(0, __float_as_int(v), 0x143, 0xC, 0xF, false));
    return __int_as_float(__builtin_amdgcn_readlane(__float_as_int(v), 63));
}
__device__ __forceinline__ unsigned f2key(float f) { const unsigned u = __float_as_uint(f); return u ^ ((unsigned)((int)u >> 31) | 0x80000000u); }
__device__ __forceinline__ float key2f(unsigned k) { return __uint_as_float((k & 0x80000000u) ? (k ^ 0x80000000u) : ~k); }
#define INS16(r, x_) do { unsigned x__ = (x_); _Pragma("unroll") for (int i_ = 0; i_ < 16; ++i_) { const unsigned hi_ = r[i_] > x__ ? r[i_] : x__; x__ = r[i_] > x__ ? x__ : r[i_]; r[i_] = hi_; } } while (0)
__device__ __forceinline__ void ph_topk2(int ntok, const float* SC, int* PIDX, float* PGATE) {
    const int tn_ = (int)tid_now(), lane = tn_ & 63, gw = blockIdx.x * 8 + (tn_ >> 6), nw = gridDim.x * 8;
    const int ntask = (ntok / 64) * 8;
    for (int it = 0;; ++it) { const int task = it == 0 ? gw : (((tn_ >> 6) == 0) ? nw + (int)blockIdx.x + (it - 1) * (int)gridDim.x : ntask); if (task >= ntask) { if (it == 0) continue; break; }
        const int tile = task >> 3, h = task & 7, m = tile * 64 + lane;
        const float* row = SC + ((size_t)(tile * 8 + h) * 64) * 256 + lane * 4;
        unsigned r1[16], r2[16];
#define TK_CE(a_, b_) do { const unsigned hi_ = a_ > b_ ? a_ : b_, lo_ = a_ > b_ ? b_ : a_; a_ = hi_; b_ = lo_; } while (0)
#define TK_SORT16(x_) do {   TK_CE(x_[0], x_[13]); TK_CE(x_[1], x_[12]); TK_CE(x_[2], x_[15]); TK_CE(x_[3], x_[14]); TK_CE(x_[4], x_[8]); TK_CE(x_[5], x_[6]); TK_CE(x_[7], x_[11]); TK_CE(x_[9], x_[10]); TK_CE(x_[0], x_[5]); TK_CE(x_[1], x_[7]); TK_CE(x_[2], x_[9]); TK_CE(x_[3], x_[4]); TK_CE(x_[6], x_[13]); TK_CE(x_[8], x_[14]); TK_CE(x_[10], x_[15]); TK_CE(x_[11], x_[12]); TK_CE(x_[0], x_[1]); TK_CE(x_[2], x_[3]); TK_CE(x_[4], x_[5]); TK_CE(x_[6], x_[8]); TK_CE(x_[7], x_[9]); TK_CE(x_[10], x_[11]); TK_CE(x_[12], x_[13]); TK_CE(x_[14], x_[15]); TK_CE(x_[0], x_[2]); TK_CE(x_[1], x_[3]); TK_CE(x_[4], x_[10]); TK_CE(x_[5], x_[11]); TK_CE(x_[6], x_[7]); TK_CE(x_[8], x_[9]); TK_CE(x_[12], x_[14]); TK_CE(x_[13], x_[15]); TK_CE(x_[1], x_[2]); TK_CE(x_[3], x_[12]); TK_CE(x_[4], x_[6]); TK_CE(x_[5], x_[7]); TK_CE(x_[8], x_[10]); TK_CE(x_[9], x_[11]); TK_CE(x_[13], x_[14]); TK_CE(x_[1], x_[4]); TK_CE(x_[2], x_[6]); TK_CE(x_[5], x_[8]); TK_CE(x_[7], x_[10]); TK_CE(x_[9], x_[13]); TK_CE(x_[11], x_[14]); TK_CE(x_[2], x_[4]); TK_CE(x_[3], x_[6]); TK_CE(x_[9], x_[12]); TK_CE(x_[11], x_[13]); TK_CE(x_[3], x_[5]); TK_CE(x_[6], x_[8]); TK_CE(x_[7], x_[9]); TK_CE(x_[10], x_[12]); TK_CE(x_[3], x_[4]); TK_CE(x_[5], x_[6]); TK_CE(x_[7], x_[8]); TK_CE(x_[9], x_[10]); TK_CE(x_[11], x_[12]); TK_CE(x_[6], x_[7]); TK_CE(x_[8], x_[9]); } while (0)
#define TK_MERGE16(x_) do { _Pragma("unroll") for (int j_ = 8; j_ > 0; j_ >>= 1) { _Pragma("unroll") for (int i_ = 0; i_ < 16; ++i_) { const int l_ = i_ ^ j_; if (l_ > i_) TK_CE(x_[i_], x_[l_]); } } } while (0)
#define TK_LOAD16(xg_, gq_) do { _Pragma("unroll") for (int q_ = 0; q_ < 4; ++q_) { const pg8::u32x4 v_ = *(const pg8::u32x4*)(row + ((gq_) * 4 + q_) * 256);     \
                xg_[4 * q_] = v_.x; xg_[4 * q_ + 1] = v_.y; xg_[4 * q_ + 2] = v_.z; xg_[4 * q_ + 3] = v_.w; } } while (0)
#define TK_STEP(rr_, cur_, nxt_, gnext_) do { TK_LOAD16(nxt_, gnext_); __builtin_amdgcn_sched_barrier(0); TK_SORT16(cur_); \
            _Pragma("unroll") for (int i_ = 0; i_ < 16; ++i_) rr_[i_] = rr_[i_] > cur_[15 - i_] ? rr_[i_] : cur_[15 - i_]; TK_MERGE16(rr_); __builtin_amdgcn_sched_barrier(0); } while (0)
        { unsigned xa_[16], xb_[16];
          TK_LOAD16(r1, 0); TK_LOAD16(xa_, 1); __builtin_amdgcn_sched_barrier(0); TK_SORT16(r1);
          for (int g_ = 1; g_ < 7; g_ += 2) { TK_STEP(r1, xa_, xb_, g_ + 1); TK_STEP(r1, xb_, xa_, g_ + 2); }
          TK_STEP(r1, xa_, xb_, 8);
          TK_LOAD16(xa_, 9); __builtin_amdgcn_sched_barrier(0); TK_SORT16(xb_);
#pragma unroll
          for (int i_ = 0; i_ < 16; ++i_) r2[i_] = xb_[i_];
          __builtin_amdgcn_sched_barrier(0);
          for (int g_ = 9; g_ < 15; g_ += 2) { TK_STEP(r2, xa_, xb_, g_ + 1); TK_STEP(r2, xb_, xa_, g_ + 2); }
          TK_SORT16(xa_);
#pragma unroll
          for (int i_ = 0; i_ < 16; ++i_) r2[i_] = r2[i_] > xa_[15 - i_] ? r2[i_] : xa_[15 - i_];
          TK_MERGE16(r2); }
#undef TK_STEP
#undef TK_LOAD16
#define TK_CAND(a_, b_) ((f2key(key2f(r1[a_] & ~127u) + key2f(r2[b_] & ~127u)) & ~255u) | (unsigned)((a_) * 16 + (b_)))
        unsigned ck[16]; int cp[16];
        { ck[0] = TK_CAND(0, 0); ck[1] = TK_CAND(0, 1); ck[2] = TK_CAND(0, 2); ck[3] = TK_CAND(0, 3); ck[4] = TK_CAND(0, 4); ck[5] = TK_CAND(0, 5); ck[6] = TK_CAND(0, 6); ck[7] = TK_CAND(0, 7); ck[8] = TK_CAND(0, 8); ck[9] = TK_CAND(0, 9); ck[10] = TK_CAND(0, 10); ck[11] = TK_CAND(0, 11); ck[12] = TK_CAND(0, 12); ck[13] = TK_CAND(0, 13); ck[14] = TK_CAND(0, 14); ck[15] = TK_CAND(0, 15); }
        TK_SORT16(ck); __builtin_amdgcn_sched_barrier(0);
        { unsigned xg_[16]; xg_[0] = TK_CAND(1, 0); xg_[1] = TK_CAND(1, 1); xg_[2] = TK_CAND(1, 2); xg_[3] = TK_CAND(1, 3); xg_[4] = TK_CAND(1, 4); xg_[5] = TK_CAND(1, 5); xg_[6] = TK_CAND(1, 6); xg_[7] = TK_CAND(1, 7); xg_[8] = TK_CAND(2, 0); xg_[9] = TK_CAND(2, 1); xg_[10] = TK_CAND(2, 2); xg_[11] = TK_CAND(2, 3); xg_[12] = TK_CAND(2, 4); xg_[13] = TK_CAND(3, 0); xg_[14] = TK_CAND(3, 1); xg_[15] = TK_CAND(3, 2);
          TK_SORT16(xg_);
          _Pragma("unroll") for (int i_ = 0; i_ < 16; ++i_) ck[i_] = ck[i_] > xg_[15 - i_] ? ck[i_] : xg_[15 - i_]; TK_MERGE16(ck); __builtin_amdgcn_sched_barrier(0); }
        { unsigned xg_[16]; xg_[0] = TK_CAND(3, 3); xg_[1] = TK_CAND(4, 0); xg_[2] = TK_CAND(4, 1); xg_[3] = TK_CAND(4, 2); xg_[4] = TK_CAND(5, 0); xg_[5] = TK_CAND(5, 1); xg_[6] = TK_CAND(6, 0); xg_[7] = TK_CAND(6, 1); xg_[8] = TK_CAND(7, 0); xg_[9] = TK_CAND(7, 1); xg_[10] = TK_CAND(8, 0); xg_[11] = TK_CAND(9, 0); xg_[12] = TK_CAND(10, 0); xg_[13] = TK_CAND(11, 0); xg_[14] = TK_CAND(12, 0); xg_[15] = TK_CAND(13, 0);
          TK_SORT16(xg_);
          _Pragma("unroll") for (int i_ = 0; i_ < 16; ++i_) ck[i_] = ck[i_] > xg_[15 - i_] ? ck[i_] : xg_[15 - i_]; TK_MERGE16(ck); __builtin_amdgcn_sched_barrier(0); }
        { unsigned xg_[16]; xg_[0] = TK_CAND(14, 0); xg_[1] = TK_CAND(15, 0); xg_[2] = 0u; xg_[3] = 0u; xg_[4] = 0u; xg_[5] = 0u; xg_[6] = 0u; xg_[7] = 0u; xg_[8] = 0u; xg_[9] = 0u; xg_[10] = 0u; xg_[11] = 0u; xg_[12] = 0u; xg_[13] = 0u; xg_[14] = 0u; xg_[15] = 0u;
          TK_SORT16(xg_);
          _Pragma("unroll") for (int i_ = 0; i_ < 16; ++i_) ck[i_] = ck[i_] > xg_[15 - i_] ? ck[i_] : xg_[15 - i_]; TK_MERGE16(ck); __builtin_amdgcn_sched_barrier(0); }
#undef TK_CAND
#undef TK_MERGE16
        { unsigned p1[4], p2[4];
#pragma unroll
          for (int d = 0; d < 4; ++d) { p1[d] = (r1[4 * d] & 127u) | ((r1[4 * d + 1] & 127u) << 8) | ((r1[4 * d + 2] & 127u) << 16) | ((r1[4 * d + 3] & 127u) << 24);
              p2[d] = (r2[4 * d] & 127u) | ((r2[4 * d + 1] & 127u) << 8) | ((r2[4 * d + 2] & 127u) << 16) | ((r2[4 * d + 3] & 127u) << 24); }
#pragma unroll
          for (int i = 0; i < 16; ++i) { const unsigned ab = ck[i] & 255u, a = ab >> 4, b = ab & 15u;
              const unsigned s1 = (a & 8u) ? ((a & 4u) ? p1[3] : p1[2]) : ((a & 4u) ? p1[1] : p1[0]), s2 = (b & 8u) ? ((b & 4u) ? p2[3] : p2[2]) : ((b & 4u) ? p2[1] : p2[0]);
              const unsigned f1 = (s1 >> ((a & 3u) * 8u)) & 127u, f2 = (s2 >> ((b & 3u) * 8u)) & 127u;
              cp[i] = (int)((127u - f1) * 128u + (127u - f2)); ck[i] &= ~255u; } }
        const float mx = key2f(ck[0]); float e[16], sum = 0.f;
#pragma unroll
        for (int i = 0; i < 16; ++i) { e[i] = __expf(key2f(ck[i]) - mx); sum += e[i]; }
        const float inv = 1.f / sum;
        int* pi = PIDX + (size_t)m * 128 + h * 16; float* pg = PGATE + (size_t)m * 128 + h * 16;
#pragma unroll
        for (int i = 0; i < 16; i += 4) { f4_t g; g.x = e[i] * inv; g.y = e[i + 1] * inv; g.z = e[i + 2] * inv; g.w = e[i + 3] * inv; *(f4_t*)(pg + i) = g; }
        unsigned sk[16];
#pragma unroll
        for (int i = 0; i < 16; ++i) sk[i] = ((unsigned)cp[i] << 7) | (unsigned)(h * 16 + i);
        TK_SORT16(sk);
        const bool asc = (h & 1) == 0;
#pragma unroll
        for (int i = 0; i < 16; i += 4) { pg8::u32x4 w; w.x = asc ? sk[15 - i] : sk[i]; w.y = asc ? sk[14 - i] : sk[i + 1]; w.z = asc ? sk[13 - i] : sk[i + 2]; w.w = asc ? sk[12 - i] : sk[i + 3]; *(pg8::u32x4*)(pi + i) = w; }
#undef TK_SORT16
#undef TK_CE
    }
}
__device__ __forceinline__ void unpk8(pg8::u32x4 u, float (&o)[8]) {
    o[0] = __uint_as_float(u.x << 16); o[1] = __uint_as_float(u.x & 0xffff0000u); o[2] = __uint_as_float(u.y << 16); o[3] = __uint_as_float(u.y & 0xffff0000u);
    o[4] = __uint_as_float(u.z << 16); o[5] = __uint_as_float(u.z & 0xffff0000u); o[6] = __uint_as_float(u.w << 16); o[7] = __uint_as_float(u.w & 0xffff0000u); }
__device__ __forceinline__ void cvt16(pg8::u32x4 w, float (&o)[16]) {
    const unsigned ww[4] = {w.x, w.y, w.z, w.w};
#pragma unroll
    for (int j = 0; j < 4; ++j) { const f2_t lo = __builtin_amdgcn_cvt_pk_f32_fp8((int)ww[j], false), hi = __builtin_amdgcn_cvt_pk_f32_fp8((int)ww[j], true); o[4 * j] = lo.x; o[4 * j + 1] = lo.y; o[4 * j + 2] = hi.x; o[4 * j + 3] = hi.y; }
}
template <int NTK, int BS>
__device__ __forceinline__ void ph_peer_apply2(int ntok, const AT* F, const int* PIDX, const float* PGATE, const TT* TU, const TT* TV, const float* MODL, float* XC, float gscale, const float* fin_g = nullptr, float* fin_out = nullptr) {
    const int tn_ = (int)tid_now(), lane = tn_ & 63, gw = blockIdx.x * 8 + (tn_ >> 6), nw = gridDim.x * 8;
    for (int m0 = gw; m0 < ntok; m0 += nw * NTK) {
        f2_t t2[NTK][8]; int eh[NTK][2]; float gh[NTK][2], dh[NTK][2]; bool ok[NTK];
#pragma unroll
        for (int q = 0; q < NTK; ++q) { const int m = m0 + q * nw; ok[q] = m < ntok; const int mm = ok[q] ? m : m0; dh[q][0] = 0.f; dh[q][1] = 0.f;
            { const pg8::u32x4 ta = *(const pg8::u32x4*)(F + (size_t)mm * D_ + 16 * lane), tb = *(const pg8::u32x4*)(F + (size_t)mm * D_ + 16 * lane + 8); float x0[8], x1[8]; unpk8(ta, x0); unpk8(tb, x1);
#pragma unroll
              for (int j = 0; j < 4; ++j) { t2[q][j].x = x0[2 * j]; t2[q][j].y = x0[2 * j + 1]; t2[q][4 + j].x = x1[2 * j]; t2[q][4 + j].y = x1[2 * j + 1]; } }
            unsigned k0 = ((unsigned)PIDX[(size_t)mm * 128 + lane] << 7) | (unsigned)lane, k1 = ((unsigned)PIDX[(size_t)mm * 128 + 64 + lane] << 7) | (unsigned)(64 + lane);
#pragma unroll
            for (int k = 2; k <= 128; k <<= 1)
#pragma unroll
                for (int j = k >> 1; j > 0; j >>= 1) {
                    if (j == 64) { const unsigned lo = k0 < k1 ? k0 : k1, hi = k0 < k1 ? k1 : k0; k0 = lo; k1 = hi; }
                    else { const unsigned p0 = (unsigned)__shfl_xor((int)k0, j), p1 = (unsigned)__shfl_xor((int)k1, j);
                        const bool low = (lane & j) == 0; const bool asc0 = (lane & k) == 0, asc1 = ((64 + lane) & k) == 0; const bool min0 = low == asc0, min1 = low == asc1;
                        k0 = min0 ? (k0 < p0 ? k0 : p0) : (k0 > p0 ? k0 : p0); k1 = min1 ? (k1 < p1 ? k1 : p1) : (k1 > p1 ? k1 : p1); } }
            eh[q][0] = (int)(k0 >> 7); eh[q][1] = (int)(k1 >> 7); gh[q][0] = PGATE[(size_t)mm * 128 + (k0 & 127u)]; gh[q][1] = PGATE[(size_t)mm * 128 + (k1 & 127u)]; }
        __syncthreads();
        static_assert(BS == 4, "the batched reduction below sums four experts at a time");
        const __amdgpu_buffer_rsrc_t ru = __builtin_amdgcn_make_buffer_rsrc((void*)TU, 0, 16384 * D_, 0x00020000), rv = __builtin_amdgcn_make_buffer_rsrc((void*)TV, 0, 16384 * D_, 0x00020000);
        const int voff = 16 * lane;
        pg8::u32x4 rw[NTK][BS];
#define PA_LOADQ(rs, q, hf, jb_) do { _Pragma("unroll") for (int j = 0; j < BS; ++j) { \
            const int e = __builtin_amdgcn_readlane(eh[q][hf], (jb_) + j); rw[q][j] = __builtin_amdgcn_raw_buffer_load_b128(rs, voff, e << 10, 0); } } while (0)
#define PA_UCOMPQ(q, hf, jb) do { float p[4]; \
            _Pragma("unroll") for (int j = 0; j < 4; ++j) { const unsigned ww[4] = {rw[q][j].x, rw[q][j].y, rw[q][j].z, rw[q][j].w}; f2_t ac = {0.f, 0.f}; \
                _Pragma("unroll") for (int k = 0; k < 4; ++k) { ac += __builtin_amdgcn_cvt_pk_f32_fp8((int)ww[k], false) * t2[q][2 * k]; ac += __builtin_amdgcn_cvt_pk_f32_fp8((int)ww[k], true) * t2[q][2 * k + 1]; } \
                p[j] = ac.x + ac.y; } \
            const bool b0 = (lane & 1) != 0, b1 = (lane & 2) != 0; \
            float ra = b0 ? p[1] : p[0], sa = b0 ? p[0] : p[1], rc = b0 ? p[3] : p[2], sc = b0 ? p[2] : p[3]; \
            ra += __int_as_float(__builtin_amdgcn_update_dpp(0, __float_as_int(sa), 0xB1, 0xF, 0xF, true)); rc += __int_as_float(__builtin_amdgcn_update_dpp(0, __float_as_int(sc), 0xB1, 0xF, 0xF, true)); \
            float rd = b1 ? rc : ra, sd = b1 ? ra : rc; \
            rd += __int_as_float(__builtin_amdgcn_update_dpp(0, __float_as_int(sd), 0x4E, 0xF, 0xF, true)); \
            rd += __int_as_float(__builtin_amdgcn_update_dpp(0, __float_as_int(rd), 0x124, 0xF, 0xF, true)); \
            rd += __int_as_float(__builtin_amdgcn_update_dpp(0, __float_as_int(rd), 0x128, 0xF, 0xF, true)); \
            rd += __shfl_xor(rd, 16); rd += __shfl_xor(rd, 32); \
            dh[q][hf] = ((lane >> 2) == ((jb) >> 2)) ? rd : dh[q][hf]; } while (0)
#define PA_VCOMPQ(q, hf, jb) do { _Pragma("unroll") for (int j = 0; j < BS; ++j) { \
            const float c = __int_as_float(__builtin_amdgcn_readlane(__float_as_int(cf[q][hf]), (jb) + j)); float x[16]; cvt16(rw[q][j], x); \
            _Pragma("unroll") for (int i = 0; i < 16; ++i) acc[q][i] += c * x[i]; } } while (0)
#define PA_SWEEP(rs, COMPQ, rs_next) do { \
            for (int jb = 0; jb < 60; jb += 4) { _Pragma("unroll") for (int q = 0; q < NTK; ++q) { COMPQ(q, 0, jb); __builtin_amdgcn_sched_barrier(0); PA_LOADQ(rs, q, 0, jb + 4); __builtin_amdgcn_sched_barrier(0); } } \
            _Pragma("unroll") for (int q = 0; q < NTK; ++q) { COMPQ(q, 0, 60); __builtin_amdgcn_sched_barrier(0); PA_LOADQ(rs, q, 1, 0); __builtin_amdgcn_sched_barrier(0); } \
            for (int jb = 0; jb < 60; jb += 4) { _Pragma("unroll") for (int q = 0; q < NTK; ++q) { COMPQ(q, 1, jb); __builtin_amdgcn_sched_barrier(0); PA_LOADQ(rs, q, 1, jb + 4); __builtin_amdgcn_sched_barrier(0); } } \
            _Pragma("unroll") for (int q = 0; q < NTK; ++q) { COMPQ(q, 1, 60); __builtin_amdgcn_sched_barrier(0); if (rs_next) { PA_LOADQ(rv, q, 0, 0); __builtin_amdgcn_sched_barrier(0); } } } while (0)
#pragma unroll
        for (int q = 0; q < NTK; ++q) PA_LOADQ(ru, q, 0, 0);
        __builtin_amdgcn_sched_barrier(0);
        PA_SWEEP(ru, PA_UCOMPQ, true);
        float cf[NTK][2];
#pragma unroll
        for (int q = 0; q < NTK; ++q)
#pragma unroll
            for (int hf = 0; hf < 2; ++hf) { const float a = dh[q][hf] * (1.f / 32.f); cf[q][hf] = gscale * gh[q][hf] * 0.5f * a * (1.f + erff(a * 0.70710678118f)); }
        float acc[NTK][16];
#pragma unroll
        for (int q = 0; q < NTK; ++q)
#pragma unroll
            for (int i = 0; i < 16; ++i) acc[q][i] = 0.f;
        PA_SWEEP(rv, PA_VCOMPQ, false);
#undef PA_LOADQ
#undef PA_UCOMPQ
#undef PA_VCOMPQ
#undef PA_SWEEP
#pragma unroll
        for (int q = 0; q < NTK; ++q) if (ok[q]) { const int m = m0 + q * nw;
            const float* gr = MODL + (size_t)tok_row(m) * D6 + 5 * D_ + 16 * lane; float* xr = XC + (size_t)m * D_ + 16 * lane;
            f4_t xo[4]; float ssq = 0.f;
#pragma unroll
            for (int j = 0; j < 4; ++j) { f4_t a; a.x = acc[q][4 * j]; a.y = acc[q][4 * j + 1]; a.z = acc[q][4 * j + 2]; a.w = acc[q][4 * j + 3]; xo[j] = *(const f4_t*)(xr + 4 * j) + *(const f4_t*)(gr + 4 * j) * a;
                ssq += xo[j].x * xo[j].x + xo[j].y * xo[j].y + xo[j].z * xo[j].z + xo[j].w * xo[j].w; }
            if (fin_out) { const float rsn = rsqrtf(wave_total(ssq) * (1.f / D_) + 1e-6f);
#pragma unroll
                for (int j = 0; j < 4; ++j) *(f4_t*)(fin_out + (size_t)m * D_ + 16 * lane + 4 * j) = xo[j] * rsn * *(const f4_t*)(fin_g + 16 * lane + 4 * j);
            } else {
#pragma unroll
                for (int j = 0; j < 4; ++j) *(f4_t*)(xr + 4 * j) = xo[j]; } }
    }
}
#define L3 __attribute__((address_space(3)))
template <int NTK>
__device__ __forceinline__ void ph_peer_apply4(unsigned char* lds, int ntok, const AT* F, const int* PIDX, const float* PGATE, const TT* TU, const float* USCL, const TT* TV, const float* MODL, float* XC, float gscale, const float* fin_g = nullptr, float* fin_out = nullptr) {
    const int tn_ = (int)tid_now(), lane = tn_ & 63, wv = tn_ >> 6, gw = blockIdx.x * 8 + wv, nw = gridDim.x * 8;
    L3 unsigned char* TQ = (L3 unsigned char*)lds + wv * (NTK * 1024);
    for (int m0 = gw; m0 < ntok; m0 += nw * NTK) {
        int eh[NTK][2]; float gh[NTK][2], tsc[NTK]; bool ok[NTK];
#pragma unroll
        for (int q = 0; q < NTK; ++q) { const int m = m0 + q * nw; ok[q] = m < ntok; const int mm = ok[q] ? m : m0;
            { const pg8::u32x4 ta = *(const pg8::u32x4*)(F + (size_t)mm * D_ + 16 * lane), tb = *(const pg8::u32x4*)(F + (size_t)mm * D_ + 16 * lane + 8); float x0[8], x1[8]; unpk8(ta, x0); unpk8(tb, x1);
              float mx = 0.f;
#pragma unroll
              for (int i = 0; i < 8; ++i) mx = fmaxf(mx, fmaxf(fabsf(x0[i]), fabsf(x1[i])));
              mx = wave_maxf(mx); const float inv = mx > 0.f ? 127.f / mx : 0.f; tsc[q] = mx * (1.f / 127.f); pg8::u32x4 w;
              w.x = q8pack(x0[0], x0[1], x0[2], x0[3], inv); w.y = q8pack(x0[4], x0[5], x0[6], x0[7], inv); w.z = q8pack(x1[0], x1[1], x1[2], x1[3], inv); w.w = q8pack(x1[4], x1[5], x1[6], x1[7], inv);
              *(L3 pg8::u32x4*)(TQ + q * 1024 + 16 * lane) = w; }
            unsigned k0 = (unsigned)PIDX[(size_t)mm * 128 + lane], k1 = (unsigned)PIDX[(size_t)mm * 128 + 64 + lane];
#pragma unroll
            for (int k = 32; k <= 128; k <<= 1)
#pragma unroll
                for (int j = k >> 1; j > 0; j >>= 1) {
                    if (j == 64) { const unsigned lo = k0 < k1 ? k0 : k1, hi = k0 < k1 ? k1 : k0; k0 = lo; k1 = hi; }
                    else { const unsigned p0 = (unsigned)__shfl_xor((int)k0, j), p1 = (unsigned)__shfl_xor((int)k1, j);
                        const bool low = (lane & j) == 0; const bool asc0 = (lane & k) == 0, asc1 = ((64 + lane) & k) == 0; const bool min0 = low == asc0, min1 = low == asc1;
                        k0 = min0 ? (k0 < p0 ? k0 : p0) : (k0 > p0 ? k0 : p0); k1 = min1 ? (k1 < p1 ? k1 : p1) : (k1 > p1 ? k1 : p1); } }
            eh[q][0] = (int)(k0 >> 7); eh[q][1] = (int)(k1 >> 7); gh[q][0] = PGATE[(size_t)mm * 128 + (k0 & 127u)]; gh[q][1] = PGATE[(size_t)mm * 128 + (k1 & 127u)]; }
        __syncthreads();
        const __amdgpu_buffer_rsrc_t ru = __builtin_amdgcn_make_buffer_rsrc((void*)TU, 0, 16384 * D_, 0x00020000), rv = __builtin_amdgcn_make_buffer_rsrc((void*)TV, 0, 16384 * D_, 0x00020000);
        const int voff = 16 * lane;
        constexpr int RU = 4, RV = 8;
        pg8::u32x4 rw[NTK][RV > RU ? RV : RU]; int idh[NTK][2];
        {
            pg8::u32x4 tq[NTK];
#pragma unroll
            for (int q = 0; q < NTK; ++q) { idh[q][0] = 0; idh[q][1] = 0; tq[q] = *(L3 const pg8::u32x4*)(TQ + q * 1024 + 16 * lane); }
#define P4_ULOAD1(q, j, hf, jb_) do { const int e = __builtin_amdgcn_readlane(eh[q][hf], (jb_) + (j)); rw[q][j] = __builtin_amdgcn_raw_buffer_load_b128(ru, voff, e << 10, 0); } while (0)
#define P4_USTEP(q, hf, jb, NEXT) do { int p[4]; \
            _Pragma("unroll") for (int j = 0; j < 4; ++j) { int s_ = __builtin_amdgcn_sdot4((int)rw[q][j].x, (int)tq[q].x, 0, false); s_ = __builtin_amdgcn_sdot4((int)rw[q][j].y, (int)tq[q].y, s_, false); \
                s_ = __builtin_amdgcn_sdot4((int)rw[q][j].z, (int)tq[q].z, s_, false); p[j] = __builtin_amdgcn_sdot4((int)rw[q][j].w, (int)tq[q].w, s_, false); __builtin_amdgcn_sched_barrier(0); NEXT(q, j); __builtin_amdgcn_sched_barrier(0); } \
            const bool b0 = (lane & 1) != 0, b1 = (lane & 2) != 0; \
            int ra = b0 ? p[1] : p[0], sa = b0 ? p[0] : p[1], rc = b0 ? p[3] : p[2], sc = b0 ? p[2] : p[3]; \
            ra += __builtin_amdgcn_update_dpp(0, sa, 0xB1, 0xF, 0xF, true); rc += __builtin_amdgcn_update_dpp(0, sc, 0xB1, 0xF, 0xF, true); \
            int rd = b1 ? rc : ra, sd = b1 ? ra : rc; \
            rd += __builtin_amdgcn_update_dpp(0, sd, 0x4E, 0xF, 0xF, true); \
            rd += __builtin_amdgcn_update_dpp(0, rd, 0x124, 0xF, 0xF, true); \
            rd += __builtin_amdgcn_update_dpp(0, rd, 0x128, 0xF, 0xF, true); \
            rd += __shfl_xor(rd, 16); rd += __shfl_xor(rd, 32); \
            idh[q][hf] = ((lane >> 2) == ((jb) >> 2)) ? rd : idh[q][hf]; } while (0)
#define P4_UN0(q, j) P4_ULOAD1(q, j, 0, jb + 4)
#define P4_UN01(q, j) P4_ULOAD1(q, j, 1, 0)
#define P4_UN1(q, j) P4_ULOAD1(q, j, 1, jb + 4)
#define P4_UNV(q, j) P4_VLOAD1(q, j, 0, 0)
#define P4_VLOAD1(q, j, hf, jb_) do { const int e = __builtin_amdgcn_readlane(eh[q][hf], (jb_) + (j)); rw[q][j] = __builtin_amdgcn_raw_buffer_load_b128(rv, voff, e << 10, 0); } while (0)
#pragma unroll
            for (int q = 0; q < NTK; ++q)
#pragma unroll
                for (int j = 0; j < 4; ++j) P4_ULOAD1(q, j, 0, 0);
            __builtin_amdgcn_sched_barrier(0);
            for (int jb = 0; jb < 60; jb += 4) {
#pragma unroll
                for (int q = 0; q < NTK; ++q) P4_USTEP(q, 0, jb, P4_UN0); }
#pragma unroll
            for (int q = 0; q < NTK; ++q) P4_USTEP(q, 0, 60, P4_UN01);
            for (int jb = 0; jb < 60; jb += 4) {
#pragma unroll
                for (int q = 0; q < NTK; ++q) P4_USTEP(q, 1, jb, P4_UN1); }
#pragma unroll
            for (int q = 0; q < NTK; ++q) P4_USTEP(q, 1, 60, P4_UNV);
#pragma unroll
            for (int q = 0; q < NTK; ++q)
#pragma unroll
                for (int j = 4; j < RV; ++j) P4_VLOAD1(q, j, 0, 0);
#undef P4_USTEP
#undef P4_UN0
#undef P4_UN01
#undef P4_UN1
#undef P4_UNV
#undef P4_ULOAD1
        }
        float cf[NTK][2];
#pragma unroll
        for (int q = 0; q < NTK; ++q)
#pragma unroll
            for (int hf = 0; hf < 2; ++hf) { const float a = (float)idh[q][hf] * (tsc[q] * USCL[eh[q][hf]]); cf[q][hf] = gscale * gh[q][hf] * 0.5f * a * (1.f + erff(a * 0.70710678118f)); }
        f2_t acc[NTK][8];
#pragma unroll
        for (int q = 0; q < NTK; ++q)
#pragma unroll
            for (int i = 0; i < 8; ++i) acc[q][i] = f2_t{0.f, 0.f};
#define P4_VSTEP(q, hf, jb, NEXT) do { _Pragma("unroll") for (int j = 0; j < RV; ++j) { \
            const float c = __int_as_float(__builtin_amdgcn_readlane(__float_as_int(cf[q][hf]), (jb) + j)); const unsigned ww_[4] = {rw[q][j].x, rw[q][j].y, rw[q][j].z, rw[q][j].w}; \
            _Pragma("unroll") for (int k = 0; k < 4; ++k) { acc[q][2 * k] += __builtin_amdgcn_cvt_pk_f32_fp8((int)ww_[k], false) * c; acc[q][2 * k + 1] += __builtin_amdgcn_cvt_pk_f32_fp8((int)ww_[k], true) * c; } \
            asm volatile("" : "+v"(acc[q][0]), "+v"(acc[q][1]), "+v"(acc[q][2]), "+v"(acc[q][3]), "+v"(acc[q][4]), "+v"(acc[q][5]), "+v"(acc[q][6]), "+v"(acc[q][7]));   \
            __builtin_amdgcn_sched_barrier(0); NEXT(q, j); __builtin_amdgcn_sched_barrier(0); } } while (0)
#define P4_VN0(q, j) P4_VLOAD1(q, j, 0, jb + RV)
#define P4_VN01(q, j) P4_VLOAD1(q, j, 1, 0)
#define P4_VN1(q, j) P4_VLOAD1(q, j, 1, jb + RV)
#define P4_VNONE(q, j) do { } while (0)
        for (int jb = 0; jb < 64 - RV; jb += RV) {
#pragma unroll
            for (int q = 0; q < NTK; ++q) P4_VSTEP(q, 0, jb, P4_VN0); }
#pragma unroll
        for (int q = 0; q < NTK; ++q) P4_VSTEP(q, 0, 64 - RV, P4_VN01);
        for (int jb = 0; jb < 64 - RV; jb += RV) {
#pragma unroll
            for (int q = 0; q < NTK; ++q) P4_VSTEP(q, 1, jb, P4_VN1); }
#pragma unroll
        for (int q = 0; q < NTK; ++q) P4_VSTEP(q, 1, 64 - RV, P4_VNONE);
#undef P4_VSTEP
#undef P4_VN0
#undef P4_VN01
#undef P4_VN1
#undef P4_VNONE
#undef P4_VLOAD1
#pragma unroll
        for (int q = 0; q < NTK; ++q) if (ok[q]) { const int m = m0 + q * nw; int ln_ = lane; asm volatile("" : "+v"(ln_));
            const float* gr = MODL + (size_t)tok_row(m) * D6 + 5 * D_ + 16 * ln_; unsigned short* xr = (unsigned short*)XC + (size_t)m * D_ + 16 * ln_;
            f4_t xo[4]; float ssq = 0.f; float xin[16];
            { const pg8::u32x4 xa = *(const pg8::u32x4*)xr, xb = *(const pg8::u32x4*)(xr + 8); float x0[8], x1[8]; unpk8(xa, x0); unpk8(xb, x1);
#pragma unroll
              for (int i = 0; i < 8; ++i) { xin[i] = x0[i]; xin[8 + i] = x1[i]; } }
#pragma unroll
            for (int j = 0; j < 4; ++j) { f4_t a; a.x = acc[q][2 * j].x; a.y = acc[q][2 * j].y; a.z = acc[q][2 * j + 1].x; a.w = acc[q][2 * j + 1].y; f4_t xi; xi.x = xin[4 * j]; xi.y = xin[4 * j + 1]; xi.z = xin[4 * j + 2]; xi.w = xin[4 * j + 3];
                xo[j] = xi + *(const f4_t*)(gr + 4 * j) * a;
                ssq += xo[j].x * xo[j].x + xo[j].y * xo[j].y + xo[j].z * xo[j].z + xo[j].w * xo[j].w; }
            if (fin_out) { const float rsn = rsqrtf(wave_total(ssq) * (1.f / D_) + 1e-6f);
#pragma unroll
                for (int j = 0; j < 4; ++j) *(f4_t*)(fin_out + (size_t)m * D_ + 16 * ln_ + 4 * j) = xo[j] * rsn * *(const f4_t*)(fin_g + 16 * ln_ + 4 * j);
            } else { pg8::u32x4 w0, w1;
                w0.x = pg8::cvt_pk_bf16(xo[0].x, xo[0].y); w0.y = pg8::cvt_pk_bf16(xo[0].z, xo[0].w); w0.z = pg8::cvt_pk_bf16(xo[1].x, xo[1].y); w0.w = pg8::cvt_pk_bf16(xo[1].z, xo[1].w);
                w1.x = pg8::cvt_pk_bf16(xo[2].x, xo[2].y); w1.y = pg8::cvt_pk_bf16(xo[2].z, xo[2].w); w1.z = pg8::cvt_pk_bf16(xo[3].x, xo[3].y); w1.w = pg8::cvt_pk_bf16(xo[3].z, xo[3].w);
                *(pg8::u32x4*)xr = w0; *(pg8::u32x4*)(xr + 8) = w1; } }
    }
}
#undef L3
typedef short bf16x8_t __attribute__((ext_vector_type(8)));
typedef short s16x4_t __attribute__((ext_vector_type(4)));
typedef float f32x16_t __attribute__((ext_vector_type(16)));
#define MFMA32(a, b, c) __builtin_amdgcn_mfma_f32_32x32x16_bf16((a), (b), (c), 0, 0, 0)
__device__ __forceinline__ unsigned pkbf(float a, float b) { f2_t v; v.x = a; v.y = b; return __builtin_bit_cast(unsigned, __builtin_convertvector(v, bf16x2_t)); }
constexpr int SW_KST = 72, SW_VST = 68;
__device__ __forceinline__ void ph_swa2(unsigned char* lds, const AT* PROJ, const float* sink, AT* MIX) {
    unsigned short* KS = (unsigned short*)lds;
    unsigned short* VT = KS + 2 * 64 * SW_KST;
    float* cosT = (float*)(VT + 2 * 64 * SW_VST);
    float* sinT = cosT + 96 * 16;
    const int tid = (int)tid_now(), w = tid >> 6, lane = tid & 63, r = lane & 31, h = lane >> 5;
    const int skey = tid >> 3, spart = tid & 7;
    __syncthreads();
    for (int i = tid; i < 96 * 16; i += NT) { const int p = i >> 4, f = i & 15; const float pos = p < 32 ? (float)p : (float)(p - 32);
        const float ang = pos * __expf(-(float)f * (9.210340371976184f / 16.f)); cosT[i] = __cosf(ang); sinT[i] = __sinf(ang); }
    __syncthreads();
    constexpr int NBLK = T_ / 64, NLU = B_ * 2 * NBLK, NCB = L_ / 64, NCU = B_ * 2 * NCB, CEND = 5 + NCB;
    f32x16_t zero;
#pragma unroll
    for (int i = 0; i < 16; ++i) zero[i] = 0.f;
    for (int u = blockIdx.x; u < NLU + NCU; u += gridDim.x) {
        const bool isl = u < NLU; int b, g, blk;
        if (isl) { blk = u % NBLK; g = (u / NBLK) & 1; b = u / (2 * NBLK); } else { const int v = u - NLU; blk = v % NCB; g = (v / NCB) & 1; b = v / (2 * NCB); }
        const int Q0 = blk * 64, qrow0 = isl ? b * T_ + Q0 : NLAT + b * L_ + Q0;
        const int hq = g * 4 + (w >> 1), ql = (w & 1) * 32 + r;
        bf16x8_t qf[4];
        { const AT* qp = PROJ + (size_t)(qrow0 + ql) * PROJW + C_SQ + hq * 64 + 8 * h; float x[4][8];
#pragma unroll
          for (int s2 = 0; s2 < 4; ++s2) unpk8(*(const pg8::u32x4*)(qp + 16 * s2), x[s2]);
          if (isl) { const int t = Q0 + ql;
#pragma unroll
              for (int ax = 0; ax < 2; ++ax) { const int p = ax == 0 ? (t >> 6) : 32 + (t & 63);
#pragma unroll
                  for (int j = 0; j < 8; ++j) { const float cs = cosT[p * 16 + 8 * h + j], sn = sinT[p * 16 + 8 * h + j]; const float a = x[2 * ax][j], bb = x[2 * ax + 1][j];
                      x[2 * ax][j] = a * cs - bb * sn; x[2 * ax + 1][j] = bb * cs + a * sn; } } }
#pragma unroll
          for (int s2 = 0; s2 < 4; ++s2) { pg8::u32x4 pk; pk.x = pkbf(x[s2][0] * 0.125f, x[s2][1] * 0.125f); pk.y = pkbf(x[s2][2] * 0.125f, x[s2][3] * 0.125f);
              pk.z = pkbf(x[s2][4] * 0.125f, x[s2][5] * 0.125f); pk.w = pkbf(x[s2][6] * 0.125f, x[s2][7] * 0.125f); qf[s2] = __builtin_bit_cast(bf16x8_t, pk); } }
        f32x16_t O0 = zero, O1 = zero; float mrun = sink[hq], lrun = (h == 0) ? 1.f : 0.f;
        pg8::u32x4 gA, gB;
#define SW_OK(ci) ((ci) >= 5 || (isl && Q0 - 128 + 64 * (ci) >= 0 && Q0 - 128 + 64 * (ci) + 64 <= T_))
#define SW_ROW0(ci) ((ci) < 5 ? b * T_ + Q0 - 128 + 64 * (ci) : NLAT + b * L_ + 64 * ((ci) - 5))
#define SW_LOAD(ci) do { const AT* pr_ = PROJ + (size_t)(SW_ROW0(ci) + skey) * PROJW; \
        if (spart < 4) { const int d0_ = (spart & 1) * 8 + (spart >> 1) * 32; gA = *(const pg8::u32x4*)(pr_ + C_SK + g * 64 + d0_); gB = *(const pg8::u32x4*)(pr_ + C_SK + g * 64 + d0_ + 16); } \
        else { gA = *(const pg8::u32x4*)(pr_ + C_SV + g * 64 + (spart - 4) * 16); gB = *(const pg8::u32x4*)(pr_ + C_SV + g * 64 + (spart - 4) * 16 + 8); } } while (0)
#define SW_STORE(ci, bi) do { \
        if (spart < 4) { const int d0_ = (spart & 1) * 8 + (spart >> 1) * 32; unsigned short* kd_ = KS + (bi) * 64 * SW_KST + skey * SW_KST + d0_; pg8::u32x4 oa_ = gA, ob_ = gB; \
            if ((ci) < 5) { float a_[8], b_[8]; unpk8(gA, a_); unpk8(gB, b_); const int t_ = Q0 - 128 + 64 * (ci) + skey; const int p_ = (spart >> 1) == 0 ? (t_ >> 6) : 32 + (t_ & 63); const int f0_ = (spart & 1) * 8; \
                float ra_[8], rb_[8]; _Pragma("unroll") for (int j_ = 0; j_ < 8; ++j_) { const float cs_ = cosT[p_ * 16 + f0_ + j_], sn_ = sinT[p_ * 16 + f0_ + j_]; ra_[j_] = a_[j_] * cs_ - b_[j_] * sn_; rb_[j_] = b_[j_] * cs_ + a_[j_] * sn_; } \
                oa_.x = pkbf(ra_[0], ra_[1]); oa_.y = pkbf(ra_[2], ra_[3]); oa_.z = pkbf(ra_[4], ra_[5]); oa_.w = pkbf(ra_[6], ra_[7]); ob_.x = pkbf(rb_[0], rb_[1]); ob_.y = pkbf(rb_[2], rb_[3]); ob_.z = pkbf(rb_[4], rb_[5]); ob_.w = pkbf(rb_[6], rb_[7]); } \
            *(pg8::u32x4*)kd_ = oa_; *(pg8::u32x4*)(kd_ + 16) = ob_; } \
        else { unsigned short* vd_ = VT + (bi) * 64 * SW_VST + ((spart - 4) * 16) * SW_VST + skey; const unsigned va_[4] = {gA.x, gA.y, gA.z, gA.w}, vb_[4] = {gB.x, gB.y, gB.z, gB.w}; \
            _Pragma("unroll") for (int j_ = 0; j_ < 4; ++j_) { vd_[(2 * j_) * SW_VST] = (unsigned short)(va_[j_] & 0xffffu); vd_[(2 * j_ + 1) * SW_VST] = (unsigned short)(va_[j_] >> 16); \
                vd_[(8 + 2 * j_) * SW_VST] = (unsigned short)(vb_[j_] & 0xffffu); vd_[(9 + 2 * j_) * SW_VST] = (unsigned short)(vb_[j_] >> 16); } } } while (0)
        int ci = isl ? 0 : 5; while (!SW_OK(ci)) ++ci;
        int bi = 0;
        __syncthreads();
        SW_LOAD(ci); SW_STORE(ci, 0); __syncthreads();
        while (ci < CEND) {
            int cn = ci + 1; while (cn < CEND && !SW_OK(cn)) ++cn;
            if (cn < CEND) SW_LOAD(cn);
            const unsigned short* KSb = KS + bi * 64 * SW_KST; const unsigned short* VTb = VT + bi * 64 * SW_VST;
            const int mt = ci == 0 ? 1 : (ci == 4 ? 2 : 0);
            f32x16_t S[2];
#pragma unroll
            for (int kb = 0; kb < 2; ++kb) { f32x16_t acc = zero;
#pragma unroll
                for (int s2 = 0; s2 < 4; ++s2) { const bf16x8_t kf = *(const bf16x8_t*)(KSb + (kb * 32 + r) * SW_KST + 16 * s2 + 8 * h); acc = MFMA32(kf, qf[s2], acc); }
                S[kb] = acc; }
            if (mt) {
#pragma unroll
                for (int kb = 0; kb < 2; ++kb)
#pragma unroll
                    for (int i = 0; i < 16; ++i) { const int kk = 32 * kb + (i & 3) + 8 * (i >> 2) + 4 * h; const bool ok = mt == 1 ? kk >= ql : kk <= ql; S[kb][i] = ok ? S[kb][i] : -INFINITY; } }
            float cm = -INFINITY;
#pragma unroll
            for (int kb = 0; kb < 2; ++kb)
#pragma unroll
                for (int i = 0; i < 16; ++i) cm = fmaxf(cm, S[kb][i]);
            cm = fmaxf(cm, __shfl_xor(cm, 32));
            const float mn = fmaxf(mrun, cm), alpha = __expf(mrun - mn); mrun = mn; lrun *= alpha; O0 *= alpha; O1 *= alpha;
            float ls = 0.f;
#pragma unroll
            for (int kb = 0; kb < 2; ++kb)
#pragma unroll
                for (int i = 0; i < 16; ++i) { const float pv = __expf(S[kb][i] - mn); S[kb][i] = pv; ls += pv; }
            lrun += ls;
#pragma unroll
            for (int kb = 0; kb < 2; ++kb)
#pragma unroll
                for (int s2 = 0; s2 < 2; ++s2) { pg8::u32x4 pk; pk.x = pkbf(S[kb][8 * s2], S[kb][8 * s2 + 1]); pk.y = pkbf(S[kb][8 * s2 + 2], S[kb][8 * s2 + 3]);
                    pk.z = pkbf(S[kb][8 * s2 + 4], S[kb][8 * s2 + 5]); pk.w = pkbf(S[kb][8 * s2 + 6], S[kb][8 * s2 + 7]); const bf16x8_t pf = __builtin_bit_cast(bf16x8_t, pk);
                    const unsigned short* vp = VTb + r * SW_VST + kb * 32 + 16 * s2 + 4 * h;
                    { const s16x4_t lo = *(const s16x4_t*)vp, hi = *(const s16x4_t*)(vp + 8); O0 = MFMA32(__builtin_shufflevector(lo, hi, 0, 1, 2, 3, 4, 5, 6, 7), pf, O0); }
                    { const s16x4_t lo = *(const s16x4_t*)(vp + 32 * SW_VST), hi = *(const s16x4_t*)(vp + 32 * SW_VST + 8); O1 = MFMA32(__builtin_shufflevector(lo, hi, 0, 1, 2, 3, 4, 5, 6, 7), pf, O1); } }
            if (cn < CEND) SW_STORE(cn, bi ^ 1);
            __syncthreads();
            ci = cn; bi ^= 1;
        }
        { const float lt = lrun + __shfl_xor(lrun, 32), inv = 1.f / lt;
          pg8::bf16_t* op = (pg8::bf16_t*)MIX + (size_t)(qrow0 + ql) * D_ + 512 + hq * 64 + 4 * h;
#pragma unroll
          for (int g4 = 0; g4 < 4; ++g4) { u2_t wv; wv.x = pkbf(O0[4 * g4] * inv, O0[4 * g4 + 1] * inv); wv.y = pkbf(O0[4 * g4 + 2] * inv, O0[4 * g4 + 3] * inv); *(u2_t*)(op + 8 * g4) = wv;
              wv.x = pkbf(O1[4 * g4] * inv, O1[4 * g4 + 1] * inv); wv.y = pkbf(O1[4 * g4 + 2] * inv, O1[4 * g4 + 3] * inv); *(u2_t*)(op + 32 + 8 * g4) = wv; } }
#undef SW_OK
#undef SW_ROW0
#undef SW_LOAD
#undef SW_STORE
    }
    __syncthreads();
}

constexpr int GC_QST = 72, GC_VST = 68;
constexpr int GI_NCH = (L_ + T_) / 64, GI_NTASK = B_ * 4 * 2 * GI_NCH;
constexpr size_t GI_IMG = (size_t)GI_NTASK * 4096;
__device__ __forceinline__ void ph_gla_pre(float* ldsf, const AT* PROJ, const float* dec_w2, const float* dec_b, unsigned short* IMG) {
    float* TOT = ldsf;
    unsigned short* LRS = (unsigned short*)(ldsf + 8 * 64);
    unsigned short* QIg = IMG; unsigned short* KIg = IMG + GI_IMG; unsigned short* KOTg = IMG + 2 * GI_IMG; float* ETg = (float*)(IMG + 3 * GI_IMG);
    const int tid = (int)tid_now(), w = tid >> 6, d = tid & 63;
    for (int task = blockIdx.x; task < GI_NTASK; task += gridDim.x) {
        const int u3 = task / GI_NCH, c = task % GI_NCH, z = u3 & 1, hh = (u3 >> 1) & 3, b = u3 >> 3;
        float w2c[16];
#pragma unroll
        for (int rr = 0; rr < 16; ++rr) w2c[rr] = dec_w2[(z * 16 + rr) * 256 + hh * 64 + d];
        const float dbc = dec_b[z * 256 + hh * 64 + d];
        float gq[8], gk[8], gla[8]; pg8::u32x4 glr;
        if (tid < 128) { const int m_ = scan_token(b, z, c * 64 + (tid >> 1)); glr = *(const pg8::u32x4*)(PROJ + (size_t)m_ * PROJW + C_LR + z * 16 + (tid & 1) * 8); }
#pragma unroll
        for (int t_ = 0; t_ < 8; ++t_) { const int m_ = scan_token(b, z, c * 64 + w * 8 + t_); const AT* pr_ = PROJ + (size_t)m_ * PROJW; gq[t_] = ldf(pr_ + C_GQ + hh * 64 + d) * 0.125f; gk[t_] = ldf(pr_ + C_GK + hh * 64 + d); }
        __syncthreads();
        if (tid < 128) *(pg8::u32x4*)(LRS + (tid >> 1) * 16 + (tid & 1) * 8) = glr;
        __syncthreads();
#pragma unroll
        for (int t_ = 0; t_ < 8; ++t_) { const unsigned short* lp_ = LRS + (w * 8 + t_) * 16; const pg8::u32x4 l0_ = *(const pg8::u32x4*)lp_, l1_ = *(const pg8::u32x4*)(lp_ + 8);
            float a8_[8], b8_[8]; unpk8(l0_, a8_); unpk8(l1_, b8_); float x_ = dbc;
#pragma unroll
            for (int q_ = 0; q_ < 8; ++q_) { x_ += a8_[q_] * w2c[q_]; x_ += b8_[q_] * w2c[8 + q_]; }
            gla[t_] = (fminf(x_, 0.f) - __logf(1.f + __expf(-fabsf(x_)))) * 0.0625f; }
        { float run_ = 0.f;
#pragma unroll
          for (int t_ = 0; t_ < 8; ++t_) { run_ += gla[t_]; gla[t_] = run_; }
          TOT[w * 64 + d] = run_; }
        __syncthreads();
        float off_ = 0.f, tot_ = 0.f;
#pragma unroll
        for (int q_ = 0; q_ < 8; ++q_) { const float x_ = TOT[q_ * 64 + d]; tot_ += x_; off_ += q_ < w ? x_ : 0.f; }
        if (w == 0) ETg[(size_t)task * 64 + d] = __expf(tot_);
        pg8::u32x4 ko; unsigned kw[4];
#pragma unroll
        for (int t_ = 0; t_ < 8; ++t_) { const float bc_ = gla[t_] + off_; const int tt_ = w * 8 + t_;
            QIg[(size_t)task * 4096 + tt_ * 64 + d] = f2bf_bits(gq[t_] * __expf(bc_)); KIg[(size_t)task * 4096 + tt_ * 64 + d] = f2bf_bits(gk[t_] * __expf(-bc_));
            const unsigned kb_ = f2bf_bits(gk[t_] * __expf(tot_ - bc_)); if (t_ & 1) kw[t_ >> 1] |= kb_ << 16; else kw[t_ >> 1] = kb_; }
        ko.x = kw[0]; ko.y = kw[1]; ko.z = kw[2]; ko.w = kw[3];
        *(pg8::u32x4*)(KOTg + (size_t)task * 4096 + d * 64 + w * 8) = ko;
    }
    __syncthreads();
}
__device__ __forceinline__ void ph_gla_chunk(unsigned char* lds, const AT* PROJ, const unsigned short* IMG, float* GLAO) {
    unsigned short* QI = (unsigned short*)lds;
    unsigned short* KI = QI + 2 * 64 * GC_QST;
    unsigned short* KOT = KI + 2 * 64 * GC_QST;
    unsigned short* VT = KOT + 2 * 64 * GC_QST;
    unsigned short* ST = VT + 2 * 32 * GC_VST;
    float* TOT = (float*)(ST + 2 * 32 * GC_QST);
    float* ETOT = TOT + 8 * 64;
    unsigned short* LRS = (unsigned short*)(ETOT + 2 * 64);
    const int tid = (int)tid_now(), w = tid >> 6, lane = tid & 63, r = lane & 31, h = lane >> 5;
    const int d = lane;
    constexpr int NCH = (L_ + T_) / 64;
    f32x16_t zero;
#pragma unroll
    for (int i = 0; i < 16; ++i) zero[i] = 0.f;
    for (int it = blockIdx.x; it < B_ * 32; it += gridDim.x) {
        const int vq = it & 3, z = (it >> 2) & 1, hh = (it >> 3) & 3, b = it >> 5;
        const int u3 = ((b * 4 + hh) * 2 + z); const int irow = tid >> 3, icol = (tid & 7) * 8;
        f32x16_t Sst0 = zero, Sst1 = zero;
        __syncthreads();
        if (w == 2) {
#pragma unroll
            for (int i = 0; i < 18; ++i) ((unsigned*)(ST))[lane + 64 * i] = 0u; }
        pg8::u32x4 iq, ik, io, iq2, ik2, io2; float ie = 0.f, ie2 = 0.f; unsigned short gv[4], gv2[4];
        const unsigned short* QIg = IMG; const unsigned short* KIg = IMG + GI_IMG; const unsigned short* KOTg = IMG + 2 * GI_IMG; const float* ETg = (const float*)(IMG + 3 * GI_IMG);
#define GC_LOADIMG(c) do { const size_t tb_ = ((size_t)u3 * NCH + (c)) * 4096 + irow * 64 + icol; iq2 = *(const pg8::u32x4*)(QIg + tb_); ik2 = *(const pg8::u32x4*)(KIg + tb_); io2 = *(const pg8::u32x4*)(KOTg + tb_); \
        if (tid < 64) ie2 = ETg[((size_t)u3 * NCH + (c)) * 64 + tid]; \
        _Pragma("unroll") for (int q_ = 0; q_ < 4; ++q_) { const int e_ = tid + 512 * q_, j_ = e_ >> 5, v_ = e_ & 31; const int m_ = scan_token(b, z, (c) * 64 + j_); \
            gv2[q_] = ((const unsigned short*)(PROJ + (size_t)m_ * PROJW + C_GV + hh * 128 + vq * 32))[v_]; } } while (0)
#define GC_TAKE() do { iq = iq2; ik = ik2; io = io2; ie = ie2; _Pragma("unroll") for (int q_ = 0; q_ < 4; ++q_) gv[q_] = gv2[q_]; } while (0)
#define GC_STOREIMG(bi) do { *(pg8::u32x4*)(QI + (bi) * 64 * GC_QST + irow * GC_QST + icol) = iq; *(pg8::u32x4*)(KI + (bi) * 64 * GC_QST + irow * GC_QST + icol) = ik; *(pg8::u32x4*)(KOT + (bi) * 64 * GC_QST + irow * GC_QST + icol) = io; \
        if (tid < 64) ETOT[(bi) * 64 + tid] = ie; \
        _Pragma("unroll") for (int q_ = 0; q_ < 4; ++q_) { const int e_ = tid + 512 * q_, j_ = e_ >> 5, v_ = e_ & 31; VT[(bi) * 32 * GC_VST + v_ * GC_VST + j_] = gv[q_]; } } while (0)
        GC_LOADIMG(0); GC_TAKE(); if (NCH > 1) GC_LOADIMG(1); GC_STOREIMG(0); __syncthreads();
        for (int c = 0; c < NCH; ++c) {
            const int bi = c & 1;
            if (c + 1 < NCH) { GC_TAKE(); GC_STOREIMG(bi ^ 1); }
            if (c + 2 < NCH) GC_LOADIMG(c + 2);
            const unsigned short* QIb = QI + bi * 64 * GC_QST; const unsigned short* KIb = KI + bi * 64 * GC_QST; const unsigned short* KOTb = KOT + bi * 64 * GC_QST;
            const unsigned short* VTb = VT + bi * 32 * GC_VST; const unsigned short* STb = ST + bi * 32 * GC_QST;
            if (w < 2) {
                bf16x8_t qf[4];
#pragma unroll
                for (int s2 = 0; s2 < 4; ++s2) qf[s2] = *(const bf16x8_t*)(QIb + (w * 32 + r) * GC_QST + 16 * s2 + 8 * h);
                f32x16_t O = zero;
#pragma unroll
                for (int s2 = 0; s2 < 4; ++s2) { const bf16x8_t sf = *(const bf16x8_t*)(STb + r * GC_QST + 16 * s2 + 8 * h); O = MFMA32(sf, qf[s2], O); }
#pragma unroll
                for (int jb = 0; jb < 2; ++jb) if (jb <= w) {
                    f32x16_t A = zero;
#pragma unroll
                    for (int s2 = 0; s2 < 4; ++s2) { const bf16x8_t kf = *(const bf16x8_t*)(KIb + (jb * 32 + r) * GC_QST + 16 * s2 + 8 * h); A = MFMA32(kf, qf[s2], A); }
                    if (jb == w) {
#pragma unroll
                        for (int i = 0; i < 16; ++i) { const int jj = (i & 3) + 8 * (i >> 2) + 4 * h; const bool ok = z == 0 ? jj <= r : jj < r; A[i] = ok ? A[i] : 0.f; } }
#pragma unroll
                    for (int s2 = 0; s2 < 2; ++s2) { pg8::u32x4 pk; pk.x = pkbf(A[8 * s2], A[8 * s2 + 1]); pk.y = pkbf(A[8 * s2 + 2], A[8 * s2 + 3]); pk.z = pkbf(A[8 * s2 + 4], A[8 * s2 + 5]); pk.w = pkbf(A[8 * s2 + 6], A[8 * s2 + 7]);
                        const unsigned short* vp = VTb + r * GC_VST + jb * 32 + 16 * s2 + 4 * h; const s16x4_t lo = *(const s16x4_t*)vp, hi = *(const s16x4_t*)(vp + 8);
                        O = MFMA32(__builtin_shufflevector(lo, hi, 0, 1, 2, 3, 4, 5, 6, 7), __builtin_bit_cast(bf16x8_t, pk), O); } }
                const int m = scan_token(b, z, c * 64 + w * 32 + r);
                unsigned short* op = (unsigned short*)GLAO + ((size_t)z * NTOK + m) * 512 + hh * 128 + vq * 32 + 4 * h;
#pragma unroll
                for (int g4 = 0; g4 < 4; ++g4) { u2_t o4; o4.x = pkbf(O[4 * g4], O[4 * g4 + 1]); o4.y = pkbf(O[4 * g4 + 2], O[4 * g4 + 3]); *(u2_t*)(op + 8 * g4) = o4; }
            } else if (w == 2) {
                f32x16_t D0 = zero, D1 = zero;
#pragma unroll
                for (int s2 = 0; s2 < 4; ++s2) { const unsigned short* vq_ = VTb + r * GC_VST + 16 * s2 + 8 * h; const s16x4_t vlo = *(const s16x4_t*)vq_, vhi = *(const s16x4_t*)(vq_ + 4); const bf16x8_t vf = __builtin_shufflevector(vlo, vhi, 0, 1, 2, 3, 4, 5, 6, 7);
                    const bf16x8_t k0 = *(const bf16x8_t*)(KOTb + r * GC_QST + 16 * s2 + 8 * h), k1 = *(const bf16x8_t*)(KOTb + (32 + r) * GC_QST + 16 * s2 + 8 * h);
                    D0 = MFMA32(k0, vf, D0); D1 = MFMA32(k1, vf, D1); }
                unsigned short* sn = ST + (bi ^ 1) * 32 * GC_QST + r * GC_QST;
#pragma unroll
                for (int g4 = 0; g4 < 4; ++g4) { const int d0 = 8 * g4 + 4 * h; const f4_t e0 = *(const f4_t*)(ETOT + bi * 64 + d0), e1 = *(const f4_t*)(ETOT + bi * 64 + 32 + d0);
                    Sst0[4 * g4] = Sst0[4 * g4] * e0.x + D0[4 * g4]; Sst0[4 * g4 + 1] = Sst0[4 * g4 + 1] * e0.y + D0[4 * g4 + 1]; Sst0[4 * g4 + 2] = Sst0[4 * g4 + 2] * e0.z + D0[4 * g4 + 2]; Sst0[4 * g4 + 3] = Sst0[4 * g4 + 3] * e0.w + D0[4 * g4 + 3];
                    Sst1[4 * g4] = Sst1[4 * g4] * e1.x + D1[4 * g4]; Sst1[4 * g4 + 1] = Sst1[4 * g4 + 1] * e1.y + D1[4 * g4 + 1]; Sst1[4 * g4 + 2] = Sst1[4 * g4 + 2] * e1.z + D1[4 * g4 + 2]; Sst1[4 * g4 + 3] = Sst1[4 * g4 + 3] * e1.w + D1[4 * g4 + 3];
                    u2_t w0; w0.x = pkbf(Sst0[4 * g4], Sst0[4 * g4 + 1]); w0.y = pkbf(Sst0[4 * g4 + 2], Sst0[4 * g4 + 3]); *(u2_t*)(sn + d0) = w0;
                    u2_t w1; w1.x = pkbf(Sst1[4 * g4], Sst1[4 * g4 + 1]); w1.y = pkbf(Sst1[4 * g4 + 2], Sst1[4 * g4 + 3]); *(u2_t*)(sn + 32 + d0) = w1; }
            }
            __syncthreads();
        }
#undef GC_TAKE
#undef GC_LOADIMG
#undef GC_STOREIMG
    }
    __syncthreads();
}

typedef float f32x4m_t __attribute__((ext_vector_type(4)));
__device__ __forceinline__ bf16x8_t cvt8bf(f4_t a, f4_t b) { pg8::u32x4 pk; pk.x = pkbf(a.x, a.y); pk.y = pkbf(a.z, a.w); pk.z = pkbf(b.x, b.y); pk.w = pkbf(b.z, b.w); return __builtin_bit_cast(bf16x8_t, pk); }
__device__ __forceinline__ void ph_rw_scan3(unsigned char* lds, const AT* R, const AT* K, const AT* V, const float* k_k, const AT* A, const AT* DEC, const float* w0, const float* a0, const float* k_a, AT* Y0, AT* Y1,
                                            const float* tsrc_u, const float* tsrc_v, TT* tdst, float* tusc, const float* r_kp, float* bonp) {
    constexpr int TS = 48, NST = L_ + T_, NCH = NST / TS, RING = 128;
    static_assert(NST % TS == 0 && (TS * 16) % 256 == 0 && RING >= 2 * TS, "scan chunking");
    float* VEC = (float*)lds;
    unsigned short* KKR = (unsigned short*)(VEC + 2 * 2 * TS * 64);
    unsigned short* VV = KKR + 2 * TS * 128;
    float* YB = (float*)(VV + 2 * TS * 64);
    unsigned short* ZR = (unsigned short*)(YB + RING * 64);
    const int tid = (int)tid_now(), w = tid >> 6, lane = tid & 63, Rl = lane & 15, g = lane >> 4, row = 16 * (w & 3) + Rl, msel = Rl & 3;
    const int tt = tid - 256;
    bf16x8_t zf;
#pragma unroll
    for (int i = 0; i < 8; ++i) zf[i] = 0;
    for (int sc = blockIdx.x; sc < B_ * 32; sc += gridDim.x) {
        const int z = sc & 1, h = (sc >> 1) & 15, b = sc >> 5;
        AT* Y = z == 0 ? Y0 : Y1;
        __syncthreads();
        if (tid < 32) ((unsigned*)ZR)[tid] = 0u;
        f4_t SaL = {0.f, 0.f, 0.f, 0.f}, SaH = SaL, SbL = SaL, SbH = SaL;
        bf16x8_t ra0 = zf, ra1 = zf;
#define RW3_STAGE(c, bi) do { _Pragma("unroll") for (int q_ = 0; q_ < TS * 16 / 256; ++q_) { const int i_ = tt + 256 * q_, ss_ = i_ >> 4, kq_ = i_ & 15; \
            const int m_ = scan_token(b, z, (c) * TS + ss_); const size_t o1_ = (size_t)m_ * D_ + h * 64 + kq_ * 4, o2_ = ((size_t)m_ * 2 + z) * D_ + h * 64 + kq_ * 4; \
            const u2_t gk_ = *(const u2_t*)(K + o1_), gv_ = *(const u2_t*)(V + o1_), ga_ = *(const u2_t*)(A + o2_), gd_ = *(const u2_t*)(DEC + o2_); u2_t gr_; \
            if (m_ < NLAT) gr_ = *(const u2_t*)(R + o1_); else { gr_.x = 0u; gr_.y = 0u; } \
            const f4_t ka4_ = *(const f4_t*)(k_a + h * 64 + kq_ * 4), w04_ = *(const f4_t*)(w0 + z * D_ + h * 64 + kq_ * 4), a04_ = *(const f4_t*)(a0 + z * D_ + h * 64 + kq_ * 4), kk4c_ = *(const f4_t*)(k_k + h * 64 + kq_ * 4); \
            const f4_t k_ = bf4(gk_), ar_ = bf4(ga_) + a04_, wr_ = bf4(gd_) + w04_; f4_t a_, w_, kk_ = k_ * kk4c_; \
            kk_ = kk_ * rsqrtf(fmaxf(allsum16(kk_.x * kk_.x + kk_.y * kk_.y + kk_.z * kk_.z + kk_.w * kk_.w), 1e-24f)); \
            a_.x = fsig(ar_.x); a_.y = fsig(ar_.y); a_.z = fsig(ar_.z); a_.w = fsig(ar_.w); \
            w_.x = __expf(-0.6065306597f * fsig(wr_.x)); w_.y = __expf(-0.6065306597f * fsig(wr_.y)); w_.z = __expf(-0.6065306597f * fsig(wr_.z)); w_.w = __expf(-0.6065306597f * fsig(wr_.w)); \
            { const f4_t rk4_ = *(const f4_t*)(r_kp + h * 64 + kq_ * 4), tb_ = bf4(gr_) * k_ * (1.f + (a_ - 1.f) * ka4_) * rk4_; const float pb_ = allsum16(tb_.x + tb_.y + tb_.z + tb_.w); \
              if (kq_ == 0 && m_ < NLAT) bonp[((size_t)z * NLAT + m_) * 16 + h] = pb_; }     \
            float* vq_ = VEC + (bi) * 2 * TS * 64 + ss_ * 64 + kq_ * 4; *(f4_t*)vq_ = w_; \
            { const f4_t qk_ = kk_ * a_, dk_ = k_ * (1.f + (a_ - 1.f) * ka4_); unsigned* qd_ = (unsigned*)(VEC + (bi) * 2 * TS * 64 + TS * 64) + ss_ * 64 + (4 * (kq_ & 3)) * 4 + (kq_ >> 2); \
              qd_[0] = pkbf(qk_.x, dk_.x); qd_[4] = pkbf(qk_.y, dk_.y); qd_[8] = pkbf(qk_.z, dk_.z); qd_[12] = pkbf(qk_.w, dk_.w); }     \
            u2_t kb_; kb_.x = pkbf(kk_.x, kk_.y); kb_.y = pkbf(kk_.z, kk_.w); unsigned short* kr_ = KKR + (bi) * TS * 128 + ss_ * 128 + 32 * (kq_ >> 3) + 8 * (kq_ & 3) + 4 * ((kq_ >> 2) & 1); *(u2_t*)kr_ = kb_; *(u2_t*)(kr_ + 64) = gr_;     \
            *(u2_t*)(VV + (bi) * TS * 64 + ss_ * 64 + kq_ * 4) = gv_; } } while (0)
        if (w >= 4) RW3_STAGE(0, 0);
        __syncthreads();
        for (int c = 0; c < NCH; ++c) {
            const int bi = c & 1;
            if (w >= 4) { if (c + 1 < NCH) RW3_STAGE(c + 1, bi ^ 1);
                { constexpr size_t NG = (size_t)16384 * D_ / 16; const size_t per = (size_t)gridDim.x * NCH * 256; const size_t base = ((size_t)blockIdx.x * NCH + c) * 256 + tt;
                  for (size_t gi = base; gi < 2 * NG; gi += per) { if (gi < NG) cvt_row_i8(tsrc_u, tdst, tusc, gi >> 6, (int)(gi & 63)); else cvt_tab16(tsrc_v, tdst + (size_t)16384 * D_, gi - NG, 1.f); } } }
            else {
                __builtin_amdgcn_s_setprio(3);
                const float* vb = VEC + bi * 2 * TS * 64 + 4 * g; const unsigned short* vvb = VV + bi * TS * 64 + row;
                const unsigned* qp = g == 0 ? (const unsigned*)(VEC + bi * 2 * TS * 64 + TS * 64) + Rl * 4 : (const unsigned*)ZR; const int q_str = g == 0 ? 64 : 0;
                const unsigned short* pa = msel == 0 ? KKR + bi * TS * 128 + 8 * g : (msel == 1 ? KKR + bi * TS * 128 - 128 + 64 + 8 * g : ZR + 8 * g); const int sa_str = msel < 2 ? 128 : 0;
                bf16x8_t a0f = msel == 1 ? ra0 : *(const bf16x8_t*)(pa), a1f = msel == 1 ? ra1 : *(const bf16x8_t*)(pa + 32);
                f4_t wA = *(const f4_t*)(vb), wB = *(const f4_t*)(vb + 16), wC = *(const f4_t*)(vb + 32), wD = *(const f4_t*)(vb + 48);
                pg8::u32x4 qd = *(const pg8::u32x4*)qp;
                float vr = __uint_as_float((unsigned)vvb[0] << 16);
#pragma unroll 8
                for (int s = 0; s < TS; ++s) {
                    const int sn = s + 1 < TS ? s + 1 : s;
                    const bf16x8_t na0 = *(const bf16x8_t*)(pa + sn * sa_str), na1 = *(const bf16x8_t*)(pa + sn * sa_str + 32);
                    const f4_t nwA = *(const f4_t*)(vb + sn * 64), nwB = *(const f4_t*)(vb + sn * 64 + 16), nwC = *(const f4_t*)(vb + sn * 64 + 32), nwD = *(const f4_t*)(vb + sn * 64 + 48);
                    const pg8::u32x4 nqd = *(const pg8::u32x4*)(qp + sn * q_str);
                    const float nvr = __uint_as_float((unsigned)vvb[sn * 64] << 16);
                    const f32x4m_t Dz = {0.f, 0.f, 0.f, 0.f};
                    const f32x4m_t D1 = __builtin_amdgcn_mfma_f32_16x16x32_bf16(a0f, cvt8bf(SaL, SaH), Dz, 0, 0, 0);
                    const f32x4m_t D2 = __builtin_amdgcn_mfma_f32_16x16x32_bf16(a1f, cvt8bf(SbL, SbH), Dz, 0, 0, 0);
                    SaL = SaL * wA; SaH = SaH * wB; SbL = SbL * wC; SbH = SbH * wD;
                    const float sa = D1[0] + D2[0];
                    if (g == 0) YB[((c * TS + s - 1) & (RING - 1)) * 64 + row] = D1[1] + D2[1];
                    { u2_t bq; bq.x = g == 0 ? pkbf(-sa, vr) : 0u; bq.y = 0u; const s16x4_t bsv = __builtin_bit_cast(s16x4_t, bq);
                      u2_t aq; aq.y = 0u;
                      aq.x = qd.x; SaL = __builtin_amdgcn_mfma_f32_16x16x16bf16_1k(__builtin_bit_cast(s16x4_t, aq), bsv, SaL, 0, 0, 0);
                      aq.x = qd.y; SaH = __builtin_amdgcn_mfma_f32_16x16x16bf16_1k(__builtin_bit_cast(s16x4_t, aq), bsv, SaH, 0, 0, 0);
                      aq.x = qd.z; SbL = __builtin_amdgcn_mfma_f32_16x16x16bf16_1k(__builtin_bit_cast(s16x4_t, aq), bsv, SbL, 0, 0, 0);
                      aq.x = qd.w; SbH = __builtin_amdgcn_mfma_f32_16x16x16bf16_1k(__builtin_bit_cast(s16x4_t, aq), bsv, SbH, 0, 0, 0); }
                    a0f = na0; a1f = na1; wA = nwA; wB = nwB; wC = nwC; wD = nwD; qd = nqd; vr = nvr;
                }
                __builtin_amdgcn_s_setprio(0);
                if (msel == 1) { ra0 = *(const bf16x8_t*)(KKR + bi * TS * 128 + (TS - 1) * 128 + 64 + 8 * g); ra1 = *(const bf16x8_t*)(KKR + bi * TS * 128 + (TS - 1) * 128 + 64 + 8 * g + 32); }
                if (c == NCH - 1) {
                    f32x4m_t Dm = {0.f, 0.f, 0.f, 0.f};
                    Dm = __builtin_amdgcn_mfma_f32_16x16x32_bf16(msel == 1 ? ra0 : zf, cvt8bf(SaL, SaH), Dm, 0, 0, 0);
                    Dm = __builtin_amdgcn_mfma_f32_16x16x32_bf16(msel == 1 ? ra1 : zf, cvt8bf(SbL, SbH), Dm, 0, 0, 0);
                    if (g == 0) YB[((NST - 1) & (RING - 1)) * 64 + row] = Dm[1];
                }
            }
            __syncthreads();
            if (w >= 4) {
#pragma unroll
                for (int i = 0; i < TS * 64 / 256; ++i) { const int e = tt + 256 * i, sl = e >> 6, vx = e & 63; const int G = c * TS - 1 + sl;
                    if (G >= L_) { const int m = scan_token(b, z, G); stf(Y + (size_t)m * D_ + h * 64 + vx, YB[(G & (RING - 1)) * 64 + vx]); } } }
            if (c == NCH - 1 && tid < 64) { const int G = NST - 1; const int m = scan_token(b, z, G); stf(Y + (size_t)m * D_ + h * 64 + tid, YB[(G & (RING - 1)) * 64 + tid]); }
        }
#undef RW3_STAGE
    }
    __syncthreads();
}

__device__ __forceinline__ void ph_wc2(float* ldsf, const float* peer_wq, const float* peer_k1, const float* peer_k2, AT* WQ0) {
    unsigned short* KA = (unsigned short*)ldsf;
    unsigned short* WB = KA + 128 * 136;
    const int tid = (int)tid_now(), w = tid >> 6, lane = tid & 63, r = lane & 31, h = lane >> 5;
    f32x16_t zero;
#pragma unroll
    for (int i = 0; i < 16; ++i) zero[i] = 0.f;
    for (int tile = blockIdx.x; tile < 256; tile += gridDim.x) {
        const int layer = tile >> 7, g = (tile >> 3) & 15, kt = tile & 7;
        const float* key = ((g & 1) ? peer_k2 : peer_k1) + (size_t)layer * 8 * 128 * 128 + (size_t)(g >> 1) * 128 * 128;
        const float* wq = peer_wq + (size_t)layer * D_ * 2048 + (size_t)(kt * 128) * 2048 + g * 128;
        __syncthreads();
#pragma unroll
        for (int i = 0; i < 8; ++i) { const int e = tid * 4 + i * 2048, row = e >> 7, col = e & 127; const f4_t v = *(const f4_t*)(key + e), u = *(const f4_t*)(wq + (size_t)row * 2048 + col);
            u2_t a; a.x = pkbf(v.x, v.y); a.y = pkbf(v.z, v.w); *(u2_t*)(KA + row * 136 + col) = a; u2_t bq; bq.x = pkbf(u.x, u.y); bq.y = pkbf(u.z, u.w); *(u2_t*)(WB + row * 136 + col) = bq; }
        __syncthreads();
        const int nb = w & 3, kh = w >> 2;
        f32x16_t acc0 = zero, acc1 = zero;
#pragma unroll
        for (int s2 = 0; s2 < 8; ++s2) { const bf16x8_t af = *(const bf16x8_t*)(KA + (nb * 32 + r) * 136 + 16 * s2 + 8 * h);
            const bf16x8_t b0 = *(const bf16x8_t*)(WB + (kh * 64 + r) * 136 + 16 * s2 + 8 * h), b1 = *(const bf16x8_t*)(WB + (kh * 64 + 32 + r) * 136 + 16 * s2 + 8 * h);
            acc0 = MFMA32(af, b0, acc0); acc1 = MFMA32(af, b1, acc1); }
        pg8::bf16_t* out = (pg8::bf16_t*)WQ0 + (size_t)layer * 2048 * D_ + (size_t)(g * 128 + nb * 32) * D_ + kt * 128 + kh * 64 + r;
#pragma unroll
        for (int i = 0; i < 16; ++i) { const int n = (i & 3) + 8 * (i >> 2) + 4 * h; out[(size_t)n * D_] = f2bf_bits(acc0[i]); out[(size_t)n * D_ + 32] = f2bf_bits(acc1[i]); }
    }
    __syncthreads();
}
__device__ __forceinline__ float wave_allsum(float v) { return wave_total(v); }
__device__ __forceinline__ unsigned pk_bf16(float a, float b) { return pg8::cvt_pk_bf16(a, b); }
__device__ __forceinline__ void ph_wc2(float* ldsf, const float* peer_wq, const float* peer_k1, const float* peer_k2, AT* WQ0);
__device__ __forceinline__ void wprep_items(float* scr, int lane, int gw, int nw, const float* W, int K, int N, int Npad, AT* WT) {
    const int nblk = Npad / 32, nitems = (K / 64) * nblk;
    for (int it = gw; it < nitems; it += nw) { const int kb = it / nblk, nb = it % nblk, k0 = 64 * kb, n0 = 32 * nb; const int nn = n0 + (lane & 31);
        { const int c4 = lane & 7; pg8::f32x4 v[8];
#pragma unroll
          for (int i = 0; i < 8; ++i) { const int kk = 8 * i + (lane >> 3); v[i] = n0 < N ? *(const pg8::f32x4*)(W + (size_t)(k0 + kk) * N + n0 + 4 * c4) : pg8::f32x4{0.f, 0.f, 0.f, 0.f}; }
#pragma unroll
          for (int i = 0; i < 8; ++i) { const int kk = 8 * i + (lane >> 3); float* d = scr + kk * 33 + 4 * c4; d[0] = v[i][0]; d[1] = v[i][1]; d[2] = v[i][2]; d[3] = v[i][3]; } }
        asm volatile("s_waitcnt lgkmcnt(0)" ::: "memory");
        const int c = lane & 7;
#pragma unroll
        for (int j = 0; j < 4; ++j) { const int n = (lane >> 3) + 8 * j; const float* q = scr + (8 * c) * 33 + n; pg8::u32x4 o;
            o.x = pk_bf16(q[0], q[33]); o.y = pk_bf16(q[2 * 33], q[3 * 33]); o.z = pk_bf16(q[4 * 33], q[5 * 33]); o.w = pk_bf16(q[6 * 33], q[7 * 33]);
            *(pg8::u32x4*)((pg8::bf16_t*)WT + (size_t)(n0 + n) * K + k0 + 8 * c) = o; }
        asm volatile("s_waitcnt lgkmcnt(0)" ::: "memory"); }
}
__device__ __forceinline__ void ph_adaln2(float* ldsf, const float* c, const float* c_ctx, const float* ada_w, const float* ada_b, float* MOD) {
    static_assert(B_ + 1 <= 12, "adaln row padding");
    float* sv = ldsf;
    float* part = ldsf + D_ * 12;
    const int tid = (int)tid_now(), w = tid >> 6, lane = tid & 63;
    __syncthreads();
    for (int i = tid; i < D_ * 12; i += NT) { const int k = i / 12, rr = i % 12; float x = 0.f; if (rr < B_) x = c[rr * D_ + k]; else if (rr == B_) x = c_ctx[k]; sv[i] = rr <= B_ ? x * fsig(x) : 0.f; }
    __syncthreads();
    const int nitem = 2 * (D6 / 64);
    for (int it = blockIdx.x; it < nitem; it += gridDim.x) { const int layer = it / (D6 / 64), col = (it % (D6 / 64)) * 64 + lane;
        const float* wp = ada_w + (size_t)layer * D_ * D6 + (size_t)(w * 128) * D6 + col; const float* sp = sv + (w * 128) * 12;
        float acc[12];
#pragma unroll
        for (int rr = 0; rr < 12; ++rr) acc[rr] = 0.f;
#pragma unroll 32
        for (int k = 0; k < 128; ++k) { const float wv = wp[(size_t)k * D6]; const f4_t s0 = *(const f4_t*)(sp + k * 12), s1 = *(const f4_t*)(sp + k * 12 + 4), s2 = *(const f4_t*)(sp + k * 12 + 8);
            acc[0] += s0.x * wv; acc[1] += s0.y * wv; acc[2] += s0.z * wv; acc[3] += s0.w * wv; acc[4] += s1.x * wv; acc[5] += s1.y * wv; acc[6] += s1.z * wv; acc[7] += s1.w * wv;
            acc[8] += s2.x * wv; acc[9] += s2.y * wv; acc[10] += s2.z * wv; acc[11] += s2.w * wv; }
        __syncthreads();
#pragma unroll
        for (int rr = 0; rr < 12; ++rr) part[(w * 12 + rr) * 64 + lane] = acc[rr];
        __syncthreads();
        for (int o = tid; o < (B_ + 1) * 64; o += NT) { const int rr = o >> 6, cl = o & 63; float t = ada_b[layer * D6 + (it % (D6 / 64)) * 64 + cl];
#pragma unroll
            for (int q = 0; q < 8; ++q) t += part[(q * 12 + rr) * 64 + cl];
            MOD[((size_t)layer * (B_ + 1) + rr) * D6 + (it % (D6 / 64)) * 64 + cl] = t; }
    }
    __syncthreads();
}
__device__ __forceinline__ float row_rs(const float* xr, int lane, f4_t (&v)[4]) {
    float ss = 0.f;
#pragma unroll
    for (int j = 0; j < 4; ++j) { v[j] = *(const f4_t*)(xr + lane * 4 + 256 * j); ss += v[j].x * v[j].x + v[j].y * v[j].y + v[j].z * v[j].z + v[j].w * v[j].w; }
    return rsqrtf(wave_allsum(ss) * (1.f / D_) + 1e-6f);
}
__device__ __forceinline__ float row_rs16(const unsigned short* xr, int lane, f4_t (&v)[4]) {
    float ss = 0.f;
#pragma unroll
    for (int j = 0; j < 4; ++j) { const u2_t q = *(const u2_t*)(xr + lane * 4 + 256 * j); v[j] = bf4(q); ss += v[j].x * v[j].x + v[j].y * v[j].y + v[j].z * v[j].z + v[j].w * v[j].w; }
    return rsqrtf(wave_allsum(ss) * (1.f / D_) + 1e-6f);
}
__device__ __forceinline__ void mod_row(const f4_t (&v)[4], float rs, const float* g, const float* mr, int ishift, int iscale, int lane, f4_t (&y)[4]) {
#pragma unroll
    for (int j = 0; j < 4; ++j) { const int cI = lane * 4 + 256 * j; const f4_t gg = *(const f4_t*)(g + cI), sc = *(const f4_t*)(mr + iscale * D_ + cI), sh = *(const f4_t*)(mr + ishift * D_ + cI);
        y[j] = v[j] * rs * gg * (1.f + sc) + sh; }
}
__device__ __forceinline__ void st_row_bf16(AT* o, int lane, const f4_t (&y)[4]) {
#pragma unroll
    for (int j = 0; j < 4; ++j) { u2_t w; w.x = pk_bf16(y[j].x, y[j].y); w.y = pk_bf16(y[j].z, y[j].w); *(u2_t*)((pg8::bf16_t*)o + lane * 4 + 256 * j) = w; }
}
__device__ __forceinline__ void ph_modnorm2(int ntok, const float* XC, const float* g, const float* MODL, int ishift, int iscale, AT* out, float* fout, const float* xsrc = nullptr, const float* csrc = nullptr) {
    const int tn_ = (int)tid_now(), lane = tn_ & 63, gw = blockIdx.x * 8 + (tn_ >> 6), nw = gridDim.x * 8;
    constexpr int UN = 3;
    for (int m0 = gw; m0 < ntok; m0 += nw * UN) { f4_t v[UN][4]; float rs[UN]; u2_t raw[UN][4];
        if (xsrc) {
#pragma unroll
            for (int u = 0; u < UN; ++u) { const int m = m0 + u * nw; if (m < ntok) { const float* xr = m < NLAT ? xsrc + (size_t)m * D_ : csrc + (size_t)(m - NLAT) * D_;
#pragma unroll
                for (int j = 0; j < 4; ++j) v[u][j] = *(const f4_t*)(xr + lane * 4 + 256 * j); } }
        } else {
#pragma unroll
            for (int u = 0; u < UN; ++u) { const int m = m0 + u * nw; if (m < ntok) {
#pragma unroll
                for (int j = 0; j < 4; ++j) raw[u][j] = *(const u2_t*)((const unsigned short*)XC + (size_t)m * D_ + lane * 4 + 256 * j); } }
#pragma unroll
            for (int u = 0; u < UN; ++u) { const int m = m0 + u * nw; if (m < ntok) {
#pragma unroll
                for (int j = 0; j < 4; ++j) v[u][j] = bf4(raw[u][j]); } }
        }
#pragma unroll
        for (int u = 0; u < UN; ++u) { const int m = m0 + u * nw; if (m < ntok) { float ss = 0.f;
#pragma unroll
            for (int j = 0; j < 4; ++j) ss += v[u][j].x * v[u][j].x + v[u][j].y * v[u][j].y + v[u][j].z * v[u][j].z + v[u][j].w * v[u][j].w;
            rs[u] = rsqrtf(wave_allsum(ss) * (1.f / D_) + 1e-6f); } }
#pragma unroll
        for (int u = 0; u < UN; ++u) { const int m = m0 + u * nw; if (m < ntok) { f4_t y[4];
            if (fout) {
#pragma unroll
                for (int j = 0; j < 4; ++j) { const int cI = lane * 4 + 256 * j; *(f4_t*)(fout + (size_t)m * D_ + cI) = v[u][j] * rs[u] * *(const f4_t*)(g + cI); }
            } else { mod_row(v[u], rs[u], g, MODL + (size_t)tok_row(m) * D6, ishift, iscale, lane, y); st_row_bf16(out + (size_t)m * D_, lane, y); } } }
    }
}
__device__ __forceinline__ void ph_norm_mix(const float* XC, const float* g, const float* MODL, const float* mu, AT* XS, AT* HX) {
    const int tn_ = (int)tid_now(), lane = tn_ & 63, gw = blockIdx.x * 8 + (tn_ >> 6), nw = gridDim.x * 8;
    for (int m = gw; m < NTOK; m += nw) { const TokInfo ti = tokinfo(m); const float* mr = MODL + (size_t)tok_row(m) * D6;
        f4_t v[4], h[4], hp[4], hn[4];
        { const float rs = row_rs16((const unsigned short*)XC + (size_t)m * D_, lane, v); mod_row(v, rs, g, mr, 0, 1, lane, h); }
        if (ti.pos > 0) { const float rs = row_rs16((const unsigned short*)XC + (size_t)(m - 1) * D_, lane, v); mod_row(v, rs, g, mr, 0, 1, lane, hp); }
        else {
#pragma unroll
            for (int j = 0; j < 4; ++j) hp[j] = (f4_t){0.f, 0.f, 0.f, 0.f}; }
        if (ti.pos < ti.len - 1) { const float rs = row_rs16((const unsigned short*)XC + (size_t)(m + 1) * D_, lane, v); mod_row(v, rs, g, mr, 0, 1, lane, hn); }
        else {
#pragma unroll
            for (int j = 0; j < 4; ++j) hn[j] = (f4_t){0.f, 0.f, 0.f, 0.f}; }
        f4_t xx[4], y[4];
#pragma unroll
        for (int j = 0; j < 4; ++j) xx[j] = 0.5f * (hp[j] + hn[j]) - h[j];
        st_row_bf16(HX + (size_t)m * 2048, lane, h); st_row_bf16(HX + (size_t)m * 2048 + 1024, lane, xx);
#pragma unroll
        for (int q = 0; q < 3; ++q) { const float* muq = mu + (q == 0 ? 0 : (q == 1 ? 2 : 3)) * D_;
#pragma unroll
            for (int j = 0; j < 4; ++j) y[j] = h[j] + xx[j] * *(const f4_t*)(muq + lane * 4 + 256 * j);
            st_row_bf16(XS + (size_t)q * (ROWB / SA) + (size_t)m * D_, lane, y); }
    }
}
__device__ __forceinline__ void ph_gla_out2(const AT* PROJ, const float* GLAO, const float* gn, AT* MIX) {
    const int tn_ = (int)tid_now(), lane = tn_ & 63, gw = blockIdx.x * 8 + (tn_ >> 6), nw = gridDim.x * 8;
    for (int m = gw; m < NTOK; m += nw) {
        const unsigned short* o0 = (const unsigned short*)GLAO + (size_t)m * 512 + lane * 8; const unsigned short* o1 = (const unsigned short*)GLAO + ((size_t)NTOK + m) * 512 + lane * 8;
        float x0_[8], x1_[8]; unpk8(*(const pg8::u32x4*)o0, x0_); unpk8(*(const pg8::u32x4*)o1, x1_);
        f4_t a0, a1; a0.x = x0_[0] + x1_[0]; a0.y = x0_[1] + x1_[1]; a0.z = x0_[2] + x1_[2]; a0.w = x0_[3] + x1_[3]; a1.x = x0_[4] + x1_[4]; a1.y = x0_[5] + x1_[5]; a1.z = x0_[6] + x1_[6]; a1.w = x0_[7] + x1_[7];
        float ss = a0.x * a0.x + a0.y * a0.y + a0.z * a0.z + a0.w * a0.w + a1.x * a1.x + a1.y * a1.y + a1.z * a1.z + a1.w * a1.w;
        const float rs = rsqrtf(allsum16(ss) * (1.f / 128.f) + 1e-6f);
        const pg8::u32x4 gt = *(const pg8::u32x4*)(PROJ + (size_t)m * PROJW + C_GG + lane * 8);
        u2_t q; q.x = gt.x; q.y = gt.y; const f4_t g0 = bf4(q); q.x = gt.z; q.y = gt.w; const f4_t g1 = bf4(q);
        const f4_t n0 = *(const f4_t*)(gn + lane * 8), n1 = *(const f4_t*)(gn + lane * 8 + 4);
        f4_t s0, s1; s0.x = g0.x * fsig(g0.x); s0.y = g0.y * fsig(g0.y); s0.z = g0.z * fsig(g0.z); s0.w = g0.w * fsig(g0.w);
        s1.x = g1.x * fsig(g1.x); s1.y = g1.y * fsig(g1.y); s1.z = g1.z * fsig(g1.z); s1.w = g1.w * fsig(g1.w);
        const f4_t r0 = a0 * rs * n0 * s0, r1 = a1 * rs * n1 * s1; pg8::u32x4 w;
        w.x = pk_bf16(r0.x, r0.y); w.y = pk_bf16(r0.z, r0.w); w.z = pk_bf16(r1.x, r1.y); w.w = pk_bf16(r1.z, r1.w);
        *(pg8::u32x4*)((pg8::bf16_t*)MIX + (size_t)m * D_ + lane * 8) = w; }
}
__device__ __forceinline__ void ld16(const AT* p, f4_t (&o)[4]) { const pg8::u32x4 a = *(const pg8::u32x4*)p, b = *(const pg8::u32x4*)(p + 8); u2_t q;
    q.x = a.x; q.y = a.y; o[0] = bf4(q); q.x = a.z; q.y = a.w; o[1] = bf4(q); q.x = b.x; q.y = b.y; o[2] = bf4(q); q.x = b.z; q.y = b.w; o[3] = bf4(q); }
__device__ __forceinline__ float hsum4(f4_t a) { return a.x + a.y + a.z + a.w; }
__device__ __forceinline__ float quadsum(float v) { DPP_ADD(v, 0xB1); DPP_ADD(v, 0x4E); return v; }
__device__ __forceinline__ void ph_rw_out2(const AT* Y0, const AT* Y1, const AT* V, const AT* G, const float* bonp, const float* ln_g, const float* ln_b, AT* OUT) {
    const int tn_ = (int)tid_now(), lane = tn_ & 63, gw = blockIdx.x * 8 + (tn_ >> 6), nw = gridDim.x * 8;
    for (int m = gw; m < NLAT; m += nw) { int ln_ = lane; asm volatile("" : "+v"(ln_)); const size_t o1 = (size_t)m * D_ + ln_ * 16; const int cI = ln_ * 16;
        f4_t y[4], t[4], r[4], k[4];
        ld16(Y0 + o1, y); ld16(Y1 + o1, t); ld16(V + o1, r); ld16(G + o1, k);
        const float bonus = bonp[(size_t)m * 16 + (ln_ >> 2)] + bonp[((size_t)NLAT + m) * 16 + (ln_ >> 2)];
        float s = 0.f;
#pragma unroll
        for (int j = 0; j < 4; ++j) { y[j] += t[j]; s += hsum4(y[j]); }
        const float mean = quadsum(s) * (1.f / 64.f); float q = 0.f;
#pragma unroll
        for (int j = 0; j < 4; ++j) { y[j] -= mean; q += hsum4(y[j] * y[j]); }
        const float rs = rsqrtf(quadsum(q) * (1.f / 64.f) + 64e-5f);
        pg8::u32x4 w0, w1; f4_t o[4];
#pragma unroll
        for (int j = 0; j < 4; ++j) o[j] = (y[j] * rs * *(const f4_t*)(ln_g + cI + 4 * j) + *(const f4_t*)(ln_b + cI + 4 * j) + bonus * r[j]) * k[j];
        w0.x = pk_bf16(o[0].x, o[0].y); w0.y = pk_bf16(o[0].z, o[0].w); w0.z = pk_bf16(o[1].x, o[1].y); w0.w = pk_bf16(o[1].z, o[1].w);
        w1.x = pk_bf16(o[2].x, o[2].y); w1.y = pk_bf16(o[2].z, o[2].w); w1.z = pk_bf16(o[3].x, o[3].y); w1.w = pk_bf16(o[3].z, o[3].w);
        *(pg8::u32x4*)((pg8::bf16_t*)OUT + o1) = w0; *(pg8::u32x4*)((pg8::bf16_t*)OUT + o1 + 8) = w1; }
}
#endif
__device__ __forceinline__ void ph_rw_out(const AT* Y0, const AT* Y1, const AT* R, const AT* K, const AT* V, const AT* A, const float* a0, const AT* G, const float* k_a, const float* r_k,
                                          const float* ln_g, const float* ln_b, AT* OUT) {
    GSTRIDE(i_, NLAT * 16) { int idx = (int)i_;
        int h = idx % 16, m = idx / 16; size_t o1 = (size_t)m * D_ + h * 64;
        float mean = 0.f; for (int n = 0; n < 64; ++n) mean += ldf(Y0 + o1 + n) + ldf(Y1 + o1 + n); mean *= (1.f / 64.f);
        float var = 0.f; for (int n = 0; n < 64; ++n) { float d = ldf(Y0 + o1 + n) + ldf(Y1 + o1 + n) - mean; var += d * d; } var *= (1.f / 64.f);
        float rs = rsqrtf(var + 64e-5f);
        float bonus = 0.f;
        for (int z = 0; z < 2; ++z) for (int n = 0; n < 64; ++n) { float a = sigmoidf_(ldf(A + ((size_t)m * 2 + z) * D_ + h * 64 + n) + a0[z * D_ + h * 64 + n]); float k = ldf(K + o1 + n);
            bonus += ldf(R + o1 + n) * k * (1.f + (a - 1.f) * k_a[h * 64 + n]) * r_k[h * 64 + n]; }
        for (int n = 0; n < 64; ++n) { float y = ldf(Y0 + o1 + n) + ldf(Y1 + o1 + n);
            float o = ((y - mean) * rs * ln_g[h * 64 + n] + ln_b[h * 64 + n] + bonus * ldf(V + o1 + n)) * ldf(G + o1 + n);
            stf(OUT + o1 + n, o); } }
}

struct Params { const float* in[36]; float* out; char* ws; int ph_lo, ph_hi; };
#ifdef CPU_EMU
#define KP (&p)
#else
typedef const Params __attribute__((address_space(4))) CParams;
__device__ __forceinline__ CParams* kp_now() { CParams* q = (CParams*)__builtin_amdgcn_kernarg_segment_ptr(); asm volatile("" : "+s"(q)); return q; }
#define KP (kp_now())
#endif
constexpr int N_PHASES = 23;
constexpr int LDS_BYTES = 131072 + 1024;
constexpr size_t OFF_CTL = WS_END;
constexpr size_t CTL_BYTES = 16384;
constexpr size_t OFF_USC = OFF_CTL + CTL_BYTES;
constexpr size_t OFF_BON = OFF_USC + (size_t)2 * 16384 * 4;
constexpr size_t WS_TOTAL = OFF_BON + (size_t)2 * NLAT * 16 * 4;

#ifndef CPU_EMU
#define LAS __attribute__((address_space(3)))
#define XB_TMO      128
#define XB_XCNT(j)  (256  + 64 * (j))
#define XB_XSUB(j)  (1280 + 64 * (j))
#define XB_XGEN(j)  (2304 + 64 * (j))
#define XB_TOP      3328
#define XB_TOPGEN   3392
#define XCD_BAR_WORDS 3456
#define XB_SPIN_CAP (1u << 26)
__device__ __forceinline__ unsigned xb_ld(unsigned* p)              { return __hip_atomic_load(p, __ATOMIC_RELAXED, __HIP_MEMORY_SCOPE_AGENT); }
__device__ __forceinline__ unsigned xb_add(unsigned* p, unsigned v) { return __hip_atomic_fetch_add(p, v, __ATOMIC_RELAXED, __HIP_MEMORY_SCOPE_AGENT); }
__device__ __forceinline__ unsigned xb_xcc_id() { return (unsigned)__builtin_amdgcn_s_getreg((3 << 11) | 20) & 0xFu; }
#define XB_SPIN(cond, bar) do { unsigned _sp = 0; while (cond) { __builtin_amdgcn_s_sleep(1); \
    if ((++_sp & 255u) == 0u) { if (xb_ld(&(bar)[XB_TMO])) break; if (_sp > XB_SPIN_CAP) { atomicAdd(&(bar)[XB_TMO], 1u); break; } } } } while (0)
struct XcdBarrier { unsigned* bar; unsigned x; volatile LAS unsigned* st; };
__device__ __forceinline__ XcdBarrier xcd_barrier_post(unsigned* bar, volatile LAS unsigned* st) {
    XcdBarrier b; b.bar = bar; b.x = xb_xcc_id(); b.st = st;
    if (tid_now() == 0u) (void)xb_add(&bar[XB_XCNT(b.x)], 1u);
    return b;
}
__device__ __forceinline__ void xcd_barrier_complete(unsigned* bar, unsigned x, unsigned& nloc, unsigned& nx) {
    const unsigned G = gridDim.x * gridDim.y * gridDim.z;
    unsigned sum, cnt, mine, sp = 0u;
    for (;;) {
        sum = 0u; cnt = 0u; mine = 0u;
#pragma unroll
        for (unsigned j = 0; j < 16; ++j) { const unsigned c = xb_ld(&bar[XB_XCNT(j)]); sum += c; cnt += (c > 0u) ? 1u : 0u; mine = (j == x) ? c : mine; }
        if (sum == G) break;
        __builtin_amdgcn_s_sleep(1);
        if ((++sp & 255u) == 0u) { if (xb_ld(&bar[XB_TMO])) break; if (sp > XB_SPIN_CAP) { atomicAdd(&bar[XB_TMO], 1u); break; } }
    }
    nloc = mine > 0u ? mine : 1u; nx = cnt > 0u ? cnt : 1u;
}
__device__ __forceinline__ void xcd_barrier(const XcdBarrier& b) {
    asm volatile("s_waitcnt vmcnt(0)" ::: "memory");
    __syncthreads();
    if (tid_now() == 0u) {
        unsigned* bar = b.bar;
        __builtin_amdgcn_s_waitcnt(0);
        unsigned nloc = b.st[0], nx = b.st[1];
        if (nloc == 0u) { xcd_barrier_complete(bar, b.x, nloc, nx); b.st[0] = nloc; b.st[1] = nx; }
        const unsigned old = xb_add(&bar[XB_XSUB(b.x)], 1u);
        const unsigned gen = old / nloc;
        if (old + 1u == (gen + 1u) * nloc) {
            __builtin_amdgcn_fence(__ATOMIC_RELEASE, "agent");
            asm volatile("s_waitcnt vmcnt(0)" ::: "memory");
            const unsigned og = xb_add(&bar[XB_TOP], 1u);
            const unsigned tg = og / nx;
            if (og + 1u == (tg + 1u) * nx) xb_add(&bar[XB_TOPGEN], 1u);
            else XB_SPIN(xb_ld(&bar[XB_TOPGEN]) == tg, bar);
            __builtin_amdgcn_fence(__ATOMIC_ACQUIRE, "agent");
            xb_add(&bar[XB_XGEN(b.x)], 1u);
            asm volatile("s_waitcnt vmcnt(0)" ::: "memory");
        } else {
            XB_SPIN(xb_ld(&bar[XB_XGEN(b.x)]) == gen, bar);
            __builtin_amdgcn_fence(__ATOMIC_ACQUIRE, "agent");
            asm volatile("s_waitcnt vmcnt(0)" ::: "memory");
        }
    }
    __syncthreads();
}
#endif

#define x_in (KP->in[0])
#define c_in (KP->in[1])
#define ctx (KP->in[2])
#define c_ctx (KP->in[3])
#define ada_w (KP->in[4])
#define ada_b (KP->in[5])
#define norm1_g (KP->in[6])
#define norm2_g (KP->in[7])
#define w_in (KP->in[8])
#define dec_w2 (KP->in[9])
#define dec_b (KP->in[10])
#define gla_g (KP->in[11])
#define sink (KP->in[12])
#define w_out (KP->in[13])
#define rw_mu (KP->in[14])
#define w_rkv (KP->in[15])
#define w_o (KP->in[16])
#define rw_w0 (KP->in[17])
#define rw_w1 (KP->in[18])
#define rw_w2 (KP->in[19])
#define rw_a0 (KP->in[20])
#define rw_a1 (KP->in[21])
#define rw_a2 (KP->in[22])
#define rw_g1 (KP->in[23])
#define rw_g2 (KP->in[24])
#define k_k (KP->in[25])
#define k_a (KP->in[26])
#define r_k (KP->in[27])
#define ln_g (KP->in[28])
#define ln_b (KP->in[29])
#define peer_wq (KP->in[30])
#define peer_k1 (KP->in[31])
#define peer_k2 (KP->in[32])
#define peer_u (KP->in[33])
#define peer_v (KP->in[34])
#define final_g (KP->in[35])
#define MOD ((float*)(KP->ws + OFF_MOD))
#define XC ((float*)(KP->ws + OFF_XC))
#define U ((AT*)(KP->ws + OFF_U))
#define MIX ((AT*)(KP->ws + OFF_MIX))
#define WIN ((AT*)(KP->ws + OFF_WIN))
#define WOUT ((AT*)(KP->ws + OFF_WOUT))
#define WQ0 ((AT*)(KP->ws + OFF_WQ0))
#define WQ1 ((AT*)(KP->ws + OFF_WQ1))
#define WRKV ((AT*)(KP->ws + OFF_WRKV))
#define WO ((AT*)(KP->ws + OFF_WO))
#define H ((AT*)(KP->ws + OFF_H))
#define XS ((AT*)(KP->ws + OFF_XS))
#define Y0 ((AT*)(KP->ws + OFF_Y0))
#define Y1 ((AT*)(KP->ws + OFF_Y1))
#define PROJ ((AT*)(KP->ws + OFF_PROJ))
#define LOGA ((float*)(KP->ws + OFF_LOGA))
#define GLAO ((float*)(KP->ws + OFF_GLAO))
#define SC ((float*)(KP->ws + OFF_SC))
#define TAB0 ((TT*)(KP->ws + OFF_TAB0))
#define TAB1 ((TT*)(KP->ws + OFF_TAB1))
#define USC ((float*)(KP->ws + OFF_USC))
#define PIDX ((int*)(KP->ws + OFF_PIDX))
#define PGATE ((float*)(KP->ws + OFF_PGATE))
#define R ((AT*)(KP->ws + OFF_R))
#define K ((AT*)(KP->ws + OFF_K))
#define V ((AT*)(KP->ws + OFF_V))
#define KK ((AT*)(KP->ws + OFF_KK))
#define U1 ((AT*)(KP->ws + OFF_U1))
#define SC1 ((float*)(KP->ws + OFF_SC1))
#define G ((AT*)(KP->ws + OFF_G))
#define A ((AT*)(KP->ws + OFF_A))
#define DEC ((AT*)(KP->ws + OFF_DEC))
#define RWOUT ((AT*)(KP->ws + OFF_DEC))
#define T1 ((AT*)(KP->ws + OFF_T1))
#define T2 ((AT*)(KP->ws + OFF_T2))
#define HX ((AT*)(KP->ws + OFF_HX))
#define WL1 ((AT*)(KP->ws + OFF_WL1))
#define WL2A ((AT*)(KP->ws + OFF_WL2A))
#define WL2B ((AT*)(KP->ws + OFF_WL2B))
#define MOD0 ((const float*)MOD)
#define MOD1 ((const float*)(MOD + (size_t)(B_ + 1) * D6))
__global__ void __launch_bounds__(NT, 2) mega(Params p) {
#ifdef CPU_EMU
    static unsigned char lds_raw[LDS_BYTES]; unsigned char* lds = lds_raw;
#else
    extern __shared__ __attribute__((aligned(16))) unsigned char lds[];
#endif
    float* ldsf = (float*)lds;
    const size_t PE = (size_t)16384 * D_;
    const int lo = p.ph_lo, hi = p.ph_hi;
#ifndef CPU_EMU
    volatile LAS unsigned* st = (volatile LAS unsigned*)(lds + LDS_BYTES - 16);
    if (threadIdx.x < 4) st[threadIdx.x] = 0u;
    if ((threadIdx.x & 63u) == 0u) *(volatile LAS unsigned*)(lds + TID_TAB_OFF + 4 * hw_slot()) = threadIdx.x >> 6;
    __syncthreads();
    XcdBarrier bar = xcd_barrier_post((unsigned*)(KP->ws + OFF_CTL), st);
#define SEAM(k) do { if (hi - lo > 1) xcd_barrier(bar); } while (0)
#else
#define SEAM(k) do { } while (0)
#endif
#define IN(k) (lo <= (k) && (k) < hi)
#ifdef CPU_EMU
    if (IN(0)) { ph_adaln(c_in, c_ctx, ada_w, ada_b, MOD);
        ph_wprep(w_in, D_, 2336, PROJW, WIN); ph_wprep(w_out, D_, D_, D_, WOUT); ph_wc(peer_wq, peer_k1, peer_k2, WQ0); ph_wc(peer_wq + (size_t)D_ * 2048, peer_k1 + (size_t)8 * 128 * 128, peer_k2 + (size_t)8 * 128 * 128, WQ1);
        ph_cvt_tab(peer_u, TAB0, PE, 32.f); ph_cvt_tab(peer_v, TAB0 + PE, PE, 1.f);
        for (int j = 0; j < 3; ++j) ph_wprep(w_rkv + (size_t)j * D_ * D_, D_, D_, D_, WRKV + (size_t)j * D_ * D_);
        ph_wprep(w_o, D_, D_, D_, WO); ph_wlora(rw_mu, rw_w1, rw_a1, rw_g1, rw_w2, rw_a2, rw_g2, WL1, WL2A, WL2B); SEAM(0); }
#else
    if (IN(0)) {
        ph_wc2(ldsf, peer_wq, peer_k1, peer_k2, WQ0);
        ph_adaln2(ldsf, c_in, c_ctx, ada_w, ada_b, MOD);
        { const int tn_ = (int)tid_now(), lane = tn_ & 63, wv = tn_ >> 6, gw = blockIdx.x * 8 + wv, nw = gridDim.x * 8; float* scr = ldsf + wv * (64 * 33);
          wprep_items(scr, lane, gw, nw, w_in, D_, 2336, PROJW, WIN); wprep_items(scr, lane, gw, nw, w_out, D_, D_, D_, WOUT);
          if ((int)gridDim.x * 3 <= (NTOK / 256) * (PROJW / 256) || (int)gridDim.x * 2 >= (NTOK / 256) * (PROJW / 256)) {
              for (int j = 0; j < 3; ++j) wprep_items(scr, lane, gw, nw, w_rkv + (size_t)j * D_ * D_, D_, D_, D_, WRKV + (size_t)j * D_ * D_);
              wprep_items(scr, lane, gw, nw, w_o, D_, D_, D_, WO); } }
        ph_wlora(rw_mu, rw_w1, rw_a1, rw_g1, rw_w2, rw_a2, rw_g2, WL1, WL2A, WL2B, 0, (int)gridDim.x);
        SEAM(0); }
#endif
#ifdef CPU_EMU
    if (IN(1)) { ph_modnorm(ldsf, NTOK, XC, norm1_g, MOD0, 0, 1, U, nullptr, x_in, ctx); SEAM(1); }
#else
    if (IN(1)) { ph_modnorm2(NTOK, XC, norm1_g, MOD0, 0, 1, U, nullptr, x_in, ctx); SEAM(1); }
#endif
    if (IN(2)) { run_gemm(lds, U, WIN, NTOK, PROJW, D_, EpiStore16{PROJ, PROJW});
#ifndef CPU_EMU
        { const int nun_ = (NTOK / 256) * (PROJW / 256), ngr_ = (int)gridDim.x, first_ = nun_ - 2 * ngr_;
          if (ngr_ * 3 > nun_ && ngr_ * 2 < nun_ && (int)blockIdx.x >= first_) {
              __syncthreads();
              const int tn_ = (int)tid_now(), lane = tn_ & 63, wv = tn_ >> 6, gw = ((int)blockIdx.x - first_) * 8 + wv, nw = (ngr_ - first_) * 8; float* scr = ldsf + wv * (64 * 33);
              for (int j = 0; j < 3; ++j) wprep_items(scr, lane, gw, nw, w_rkv + (size_t)j * D_ * D_, D_, D_, D_, WRKV + (size_t)j * D_ * D_);
              wprep_items(scr, lane, gw, nw, w_o, D_, D_, D_, WO); } }
#endif
        SEAM(2); }
    #ifdef CPU_EMU
    if (IN(3)) { ph_rope(PROJ); ph_gla_loga(PROJ, dec_w2, dec_b, LOGA); SEAM(3); }
    if (IN(4)) { ph_gla_scan(PROJ, LOGA, GLAO); ph_swa(PROJ, sink, MIX, GLA_THREADS); SEAM(4); }
#else
    if (IN(3)) { ph_gla_pre(ldsf, PROJ, dec_w2, dec_b, (unsigned short*)(KP->ws + OFF_GIMG)); SEAM(3); }
    if (IN(4)) { ph_gla_chunk(lds, PROJ, (const unsigned short*)(KP->ws + OFF_GIMG), GLAO); ph_swa2(lds, PROJ, sink, MIX); SEAM(4); }
#endif
#ifdef CPU_EMU
    if (IN(5)) { ph_gla_out(PROJ, GLAO, gla_g, MIX); SEAM(5); }
#else
    if (IN(5)) { ph_gla_out2(PROJ, GLAO, gla_g, MIX); SEAM(5); }
#endif
    if (IN(6)) { run_gemm(lds, MIX, WOUT, NTOK, D_, D_, EpiResid{XC, MOD0 + 2 * D_, x_in, ctx});
#ifndef CPU_EMU
        { const int w0_ = (int)gridDim.x > 32 ? 32 : 0;
          if ((int)blockIdx.x >= w0_) ph_cvt_tab_i8(peer_u, TAB0, USC, w0_, (int)gridDim.x - w0_); }
#endif
        SEAM(6); }
#ifdef CPU_EMU
    if (IN(7)) { ph_modnorm(ldsf, NTOK, XC, norm2_g, MOD0, 3, 4, U, nullptr); SEAM(7); }
#else
    if (IN(7)) { ph_modnorm2(NTOK, XC, norm2_g, MOD0, 3, 4, U, nullptr); SEAM(7); }
#endif
    if (IN(8)) { run_gemm(lds, U, WQ0, NTOK, 2048, D_, EpiStoreKey{SC, 2048});
#ifndef CPU_EMU
        { const int w0_ = (int)gridDim.x > 64 ? 64 : 0;
          if ((int)blockIdx.x >= w0_) ph_cvt_tab(peer_v, TAB0 + PE, PE, 1.f, w0_, (int)gridDim.x - w0_); }
#endif
        SEAM(8); }
    #ifdef CPU_EMU
    if (IN(9)) { ph_peer_topk(ldsf, NTOK, SC, PIDX, PGATE); SEAM(9); }
    if (IN(10)) { ph_peer_apply(ldsf, NTOK, U, PIDX, PGATE, TAB0, TAB0 + PE, MOD0, XC); SEAM(10); }
#else
    if (IN(9)) { ph_topk2(NTOK, SC, PIDX, PGATE); SEAM(9); }
    if (IN(10)) { ph_peer_apply4<3>(lds, NTOK, U, PIDX, PGATE, TAB0, USC, TAB0 + PE, MOD0, XC, 1.f); SEAM(10); }
#endif
#ifdef CPU_EMU
    if (IN(11)) { ph_modnorm(ldsf, NTOK, XC, norm1_g + D_, MOD1, 0, 1, H, nullptr); SEAM(11); }
    if (IN(22)) { ph_xs(H, rw_mu, XS, HX); SEAM(22); }
#else
    if (IN(11)) { ph_norm_mix(XC, norm1_g + D_, MOD1, rw_mu, XS, HX); SEAM(11); }
#endif
    if (IN(12)) {
        for (int j = 0; j < 3; ++j) run_gemm(lds, XS + (size_t)j * (ROWB / SA), WRKV + (size_t)j * D_ * D_, j == 0 ? NLAT : NTOK, D_, D_, EpiStore16{j == 0 ? R : (j == 1 ? K : V), D_}, j == 2 ? 224 : 0);
        run_gemm(lds, HX, WL1, NTOK, 512, 2048, EpiLora1{T1, T2}, 144);
        SEAM(12); }
    if (IN(13)) {
        run_gemm(lds, T1, WL2A, NTOK, 2048, 256, EpiStore16{DEC, 2048});
        run_gemm(lds, T1, WL2A + (size_t)2048 * 256, NTOK, 2048, 256, EpiStore16{A, 2048}, 192);
        run_gemm(lds, T2, WL2B, NLAT, D_, 256, EpiStore16{G, D_});
#ifdef CPU_EMU
        ph_rw_kk(K, k_k, KK);
#else

#endif
        SEAM(13); }
    #ifdef CPU_EMU
    if (IN(14)) { ph_rw_scan(R, K, V, KK, A, DEC, rw_w0, rw_a0, k_a, Y0, Y1); SEAM(14); }
#else
    if (IN(14)) { ph_rw_scan3(lds, R, K, V, k_k, A, DEC, rw_w0, rw_a0, k_a, Y0, Y1, peer_u + PE, peer_v + PE, TAB1, USC + 16384, r_k, (float*)(KP->ws + OFF_BON)); SEAM(14); }
#endif
#ifdef CPU_EMU
    if (IN(15)) { ph_rw_out(Y0, Y1, R, K, V, A, rw_a0, G, k_a, r_k, ln_g, ln_b, RWOUT); SEAM(15); }
#else
    if (IN(15)) { ph_rw_out2(Y0, Y1, V, G, (const float*)(KP->ws + OFF_BON), ln_g, ln_b, RWOUT); SEAM(15); }
#endif
#ifdef CPU_EMU
    if (IN(16)) { ph_cvt_tab(peer_u + PE, TAB1, PE, 32.f); ph_cvt_tab(peer_v + PE, TAB1 + PE, PE, 1.f); run_gemm(lds, RWOUT, WO, NLAT, D_, D_, EpiResid{XC, MOD1 + 2 * D_, nullptr, nullptr}); SEAM(16); }
#else
    if (IN(16)) { run_gemm(lds, RWOUT, WO, NLAT, D_, D_, EpiResid{XC, MOD1 + 2 * D_, nullptr, nullptr}); SEAM(16); }
#endif
#ifdef CPU_EMU
    if (IN(17)) { ph_modnorm(ldsf, NLAT, XC, norm2_g + D_, MOD1, 3, 4, U1, nullptr); SEAM(17); }
#else
    if (IN(17)) { ph_modnorm2(NLAT, XC, norm2_g + D_, MOD1, 3, 4, U1, nullptr); SEAM(17); }
#endif
    if (IN(18)) { run_gemm(lds, U1, WQ1, NLAT, 2048, D_, EpiStoreKey{SC1, 2048}); SEAM(18); }
    #ifdef CPU_EMU
    if (IN(19)) { ph_peer_topk(ldsf, NLAT, SC1, PIDX, PGATE); SEAM(19); }
    if (IN(20)) { ph_peer_apply(ldsf, NLAT, U1, PIDX, PGATE, TAB1, TAB1 + PE, MOD1, XC); SEAM(20); }
#else
    if (IN(19)) { ph_topk2(NLAT, SC1, PIDX, PGATE); SEAM(19); }
    if (IN(20)) { ph_peer_apply4<4>(lds, NLAT, U1, PIDX, PGATE, TAB1, USC + 16384, TAB1 + PE, MOD1, XC, 1.f, final_g, KP->out); }
#endif
#ifdef CPU_EMU
    if (IN(21)) { ph_modnorm(ldsf, NLAT, XC, final_g, nullptr, 0, 0, nullptr, p.out); }
#endif
}

#undef x_in
#undef c_in
#undef ctx
#undef c_ctx
#undef ada_w
#undef ada_b
#undef norm1_g
#undef norm2_g
#undef w_in
#undef dec_w2
#undef dec_b
#undef gla_g
#undef sink
#undef w_out
#undef rw_mu
#undef w_rkv
#undef w_o
#undef rw_w0
#undef rw_w1
#undef rw_w2
#undef rw_a0
#undef rw_a1
#undef rw_a2
#undef rw_g1
#undef rw_g2
#undef k_k
#undef k_a
#undef r_k
#undef ln_g
#undef ln_b
#undef peer_wq
#undef peer_k1
#undef peer_k2
#undef peer_u
#undef peer_v
#undef final_g
#undef MOD
#undef XC
#undef U
#undef MIX
#undef WIN
#undef WOUT
#undef WQ0
#undef WQ1
#undef WRKV
#undef WO
#undef H
#undef XS
#undef Y0
#undef Y1
#undef PROJ
#undef LOGA
#undef GLAO
#undef SC
#undef TAB0
#undef TAB1
#undef USC
#undef PIDX
#undef PGATE
#undef R
#undef K
#undef V
#undef KK
#undef U1
#undef SC1
#undef G
#undef A
#undef DEC
#undef RWOUT
#undef T1
#undef T2
#undef HX
#undef WL1
#undef WL2A
#undef WL2B
#undef MOD0
#undef MOD1

extern "C" void kernel_launch(void* const* d_in, const int* in_sizes, int n_in, void* d_out, int out_size, void* d_ws, size_t ws_size, hipStream_t stream) {
    if (ws_size < WS_TOTAL || n_in != 36) { fprintf(stderr, "kernel_launch: ws too small (%zu < %zu) or n_in %d != 36\n", ws_size, (size_t)WS_TOTAL, n_in); return; }
    Params p{};
    for (int i = 0; i < 36; ++i) p.in[i] = (const float*)d_in[i];
    p.out = (float*)d_out; p.ws = (char*)d_ws;
#ifdef CPU_EMU
    { const int order[N_PHASES] = {0,1,2,3,4,5,6,7,8,9,10,11,22,12,13,14,15,16,17,18,19,20,21};
      for (int i = 0; i < N_PHASES; ++i) { int ph = order[i]; p.ph_lo = ph; p.ph_hi = ph + 1; emu_launch(true, 8, NT, [=] { mega(p); }); emu_phase_hook(ph, (char*)d_ws); } }
#else
    static int grid = 0;
    if (grid == 0) {
        int dev = 0, cus = 0;
        if (hipGetDevice(&dev) != hipSuccess || hipDeviceGetAttribute(&cus, hipDeviceAttributeMultiprocessorCount, dev) != hipSuccess) { grid = -1; return; }
        if (hipFuncSetAttribute((const void*)mega, hipFuncAttributeMaxDynamicSharedMemorySize, LDS_BYTES) != hipSuccess) { grid = -1; return; }
        grid = cus;
    }
    if (grid < 0) return;
    (void)hipMemsetAsync((char*)d_ws + OFF_CTL, 0, CTL_BYTES, stream);
    p.ph_lo = 0; p.ph_hi = N_PHASES;
    hipLaunchKernelGGL(mega, dim3(grid), dim3(NT), LDS_BYTES, stream, p);
#endif
}
```
